# Optimizing an MI355X kernel written in HIP

```python
import jax
import jax.numpy as jnp
from jax import lax
import numpy as np

D_MODEL = 1024
BATCH = 16
SEQ = 256
DEPTH = 2
DEC_BATCH = 8
DEC_SEQ = 1024
PAST_LEN = 256

GRID_W = 64
HEAD_DIM = 64
N_Q_HEADS = 8
N_KV_HEADS = 4
ATTN_WIDTH = N_Q_HEADS * HEAD_DIM
KV_WIDTH = N_KV_HEADS * HEAD_DIM
Q_BLOCK = 128
ROPE_THETA = 10000.0
M_HEADS = 4
M_DK = 64
M_DV = 64
M_WIDTH = M_HEADS * M_DV
M_CHUNK = 64
M_CONV = 3
F_GROUPS = 4
F_GROUP_CH = 64
F_WIDTH = F_GROUPS * F_GROUP_CH
FF_HIDDEN = -(-8 * D_MODEL // (3 * 256)) * 256
EPS = 1e-6
IN_SIZES = (ATTN_WIDTH, KV_WIDTH, KV_WIDTH, M_HEADS * M_DK, M_HEADS * M_DK, M_WIDTH, M_WIDTH, 4 * M_HEADS, F_WIDTH, 3 * D_MODEL)
IN_COLS = sum(IN_SIZES)

kernel_name = 'hybrid_mlstm_gqa_fourier_diffusion_step'


def _rmsnorm(x, g):
    xf = x.astype(jnp.float32)
    y = xf * lax.rsqrt(jnp.mean(xf * xf, axis=-1, keepdims=True) + EPS)
    return (y * g.astype(jnp.float32)).astype(x.dtype)


def _modulation(cvec, w_ada, b_ada):
    mod = jax.nn.silu(cvec) @ w_ada + b_ada
    return jnp.split(mod, 6, axis=-1)


def _rope_1d(x, pos):
    n = x.shape[-1] // 2
    inv = 1.0 / (ROPE_THETA ** (jnp.arange(n, dtype=jnp.float32) / n))
    ang = pos.astype(jnp.float32)[:, None] * inv[None, :]
    cos = jnp.cos(ang)[:, None, :]
    sin = jnp.sin(ang)[:, None, :]
    xf = x.astype(jnp.float32)
    x1, x2 = xf[..., :n], xf[..., n:]
    return jnp.concatenate([x1 * cos - x2 * sin, x2 * cos + x1 * sin], axis=-1).astype(x.dtype)


def _rope_2d(x, row, col):
    half = x.shape[-1] // 2
    return jnp.concatenate([_rope_1d(x[..., :half], row), _rope_1d(x[..., half:], col)], axis=-1)


def _attend(q, k, v):
    B, Tq, Hq, hd = q.shape
    G = Hq // N_KV_HEADS
    nb = Tq // Q_BLOCK
    qb = q.reshape(B, nb, Q_BLOCK, N_KV_HEADS, G, hd).transpose(1, 0, 2, 3, 4, 5)
    scale = hd ** -0.5

    def block(qi):
        s = jnp.einsum('bqhgd,bkhd->bhgqk', qi, k, preferred_element_type=jnp.float32) * scale
        p = jax.nn.softmax(s, axis=-1).astype(v.dtype)
        return jnp.einsum('bhgqk,bkhd->bqhgd', p, v)

    o = lax.map(block, qb)
    return o.transpose(1, 0, 2, 3, 4, 5).reshape(B, Tq, Hq * hd)


def _short_conv(x, w):
    T = x.shape[1]
    pad = M_CONV // 2
    xp = jnp.pad(x, ((0, 0), (pad, pad), (0, 0)))
    return sum(xp[:, j:j + T] * w[j] for j in range(M_CONV))


def _fourier(u):
    B, T, _ = u.shape
    ug = u.reshape(B, T, F_GROUPS, F_GROUP_CH).astype(jnp.float32)
    y = jnp.fft.fft2(ug, axes=(1, 3), norm='ortho').real
    return y.reshape(B, T, F_WIDTH).astype(u.dtype)


def _mlstm_scan(q, k, v, li, lf, C0, n0, m0):
    B, T, H, _ = q.shape
    nc = T // M_CHUNK
    tril = jnp.tril(jnp.ones((M_CHUNK, M_CHUNK), dtype=bool))

    def chunks(a):
        return a.reshape((B, nc, M_CHUNK) + a.shape[2:]).swapaxes(0, 1)

    def step(carry, inp):
        C, n, m = carry
        qc, kc, vc, lic, lfc = inp
        b = jnp.cumsum(lfc, axis=1).swapaxes(1, 2)
        ig = lic.swapaxes(1, 2)
        inter = b + m[..., None]
        dmat = b[..., :, None] - b[..., None, :] + ig[..., None, :]
        dmat = jnp.where(tril, dmat, -jnp.inf)
        mj = jnp.maximum(inter, dmat.max(axis=-1))
        w = jnp.exp(dmat - mj[..., None])
        wi = jnp.exp(inter - mj)
        s = jnp.einsum('blhd,bshd->bhls', qc, kc) * w
        num = jnp.einsum('bhls,bshe->bhle', s, vc) + wi[..., None] * jnp.einsum('blhd,bhde->bhle', qc, C)
        den = s.sum(axis=-1) + wi * jnp.einsum('blhd,bhd->bhl', qc, n)
        h = num / jnp.maximum(jnp.abs(den), jnp.exp(-mj))[..., None]
        bl = b[..., -1]
        g = bl[..., None] - b + ig
        m_new = jnp.maximum(bl + m, g.max(axis=-1))
        wk = jnp.exp(g - m_new[..., None])
        decay = jnp.exp(bl + m - m_new)
        C_new = decay[..., None, None] * C + jnp.einsum('bhs,bshd,bshe->bhde', wk, kc, vc)
        n_new = decay[..., None] * n + jnp.einsum('bhs,bshd->bhd', wk, kc)
        return (C_new, n_new, m_new), h.swapaxes(1, 2)

    (C, n, m), h = lax.scan(step, (C0, n0, m0), (chunks(q), chunks(k), chunks(v), chunks(li), chunks(lf)))
    h = h.swapaxes(0, 1).reshape(B, T, H, v.shape[-1])
    return h, (C, n, m)


def _mlstm_bidir(q, k, v, gates, st_fw, st_bw):
    li_f, lf_f, li_b, lf_b = jnp.split(gates, 4, axis=-1)
    lf_f = jax.nn.log_sigmoid(lf_f)
    lf_b = jax.nn.log_sigmoid(lf_b)
    h_f, s_f = _mlstm_scan(q, k, v, li_f, lf_f, *st_fw)
    fl = lambda a: jnp.flip(a, axis=1)
    h_b, s_b = _mlstm_scan(fl(q), fl(k), fl(v), fl(li_b), fl(lf_b), *st_bw)
    return h_f + fl(h_b), s_f, s_b


def _layer(x, mod, pos, ctx, norm1_g, w_in, q_norm_g, k_norm_g, conv_w, gate_b, m_norm_g,
           w_pa, w_pm, w_pf, w_out, norm2_g, w_ffn_in, w_ffn_out):
    shift1, scale1, gate1, shift2, scale2, gate2 = mod
    B, T, _ = x.shape
    f32 = jnp.float32
    h = _rmsnorm(x, norm1_g) * (1 + scale1) + shift1
    z = h @ w_in
    qa, ka, va, qm, km, vm, om, gm, fu, bg = jnp.split(z, np.cumsum(IN_SIZES)[:-1].tolist(), axis=-1)
    qa = _rmsnorm(qa.reshape(B, T, N_Q_HEADS, HEAD_DIM), q_norm_g)
    ka = _rmsnorm(ka.reshape(B, T, N_KV_HEADS, HEAD_DIM), k_norm_g)
    va = va.reshape(B, T, N_KV_HEADS, HEAD_DIM)
    if ctx is None:
        keys, vals = ka, va
        zero_state = (jnp.zeros((B, M_HEADS, M_DK, M_DV), f32), jnp.zeros((B, M_HEADS, M_DK), f32),
                      jnp.zeros((B, M_HEADS), f32))
        st_fw, st_bw = zero_state, zero_state
    else:
        row, col = pos
        qa = _rope_2d(qa, row, col)
        keys = jnp.concatenate([ctx[0].astype(ka.dtype), _rope_2d(ka, row, col)], axis=1)
        vals = jnp.concatenate([ctx[1].astype(va.dtype), va], axis=1)
        st_fw, st_bw = ctx[2], ctx[3]
    attn = _attend(qa, keys, vals)
    qk = jax.nn.silu(_short_conv(jnp.concatenate([qm, km], axis=-1), conv_w))
    qm, km = jnp.split(qk, 2, axis=-1)
    qm = qm.reshape(B, T, M_HEADS, M_DK).astype(f32)
    km = km.reshape(B, T, M_HEADS, M_DK).astype(f32) * (M_DK ** -0.5)
    vm = vm.reshape(B, T, M_HEADS, M_DV).astype(f32)
    gm = gm.astype(f32) + gate_b.astype(f32)
    hm, st_f, st_b = _mlstm_bidir(qm, km, vm, gm, st_fw, st_bw)
    hm = _rmsnorm(hm, m_norm_g.reshape(M_HEADS, M_DV)).reshape(B, T, M_WIDTH).astype(x.dtype)
    hm = jax.nn.sigmoid(om) * hm
    fo = _fourier(fu)
    g_a, g_m, g_f = jnp.split(jax.nn.sigmoid(bg), 3, axis=-1)
    merged = g_a * (attn @ w_pa) + g_m * (hm @ w_pm) + g_f * (fo @ w_pf)
    x = x + gate1 * (merged @ w_out)
    h2 = _rmsnorm(x, norm2_g) * (1 + scale2) + shift2
    fg, fv = jnp.split(h2 @ w_ffn_in, 2, axis=-1)
    x = x + gate2 * ((jax.nn.silu(fg) * fv) @ w_ffn_out)
    return x, ka, va, st_f, st_b


def setup_inputs(seed: int = 0) -> dict:
    key = jax.random.key(seed)
    ks = jax.random.split(key, 32)
    f32 = jnp.float32

    def nrm(k, shape, s):
        return s * jax.random.normal(k, shape, f32)

    D = D_MODEL
    f_bias = jnp.linspace(3.0, 6.0, M_HEADS, dtype=f32)
    zh = jnp.zeros((M_HEADS,), f32)
    gate_base = jnp.concatenate([zh, f_bias, zh, f_bias])
    return {
        'x_prompt': nrm(ks[0], (BATCH, SEQ, D), 1.0),
        'x_sample': nrm(ks[1], (DEC_BATCH, DEC_SEQ, D), 1.0),
        'cache_k': nrm(ks[2], (DEC_BATCH, DEPTH, PAST_LEN, N_KV_HEADS, HEAD_DIM), 1.0),
        'cache_v': nrm(ks[3], (DEC_BATCH, DEPTH, PAST_LEN, N_KV_HEADS, HEAD_DIM), 1.0),
        'state_C': nrm(ks[4], (DEC_BATCH, DEPTH, 2, M_HEADS, M_DK, M_DV), 0.1),
        'state_n': nrm(ks[5], (DEC_BATCH, DEPTH, 2, M_HEADS, M_DK), 0.5),
        'state_m': 1.0 + nrm(ks[6], (DEC_BATCH, DEPTH, 2, M_HEADS), 0.5),
        'c': nrm(ks[7], (DEC_BATCH, D), 1.0),
        'c_ctx': nrm(ks[8], (D,), 1.0),
        'w_ada': nrm(ks[9], (DEPTH, D, 6 * D), D ** -0.5),
        'b_ada': nrm(ks[10], (DEPTH, 6 * D), 0.01),
        'norm1_g': 1.0 + nrm(ks[11], (DEPTH, D), 0.02),
        'w_in': nrm(ks[12], (DEPTH, D, IN_COLS), D ** -0.5),
        'q_norm_g': 1.0 + nrm(ks[13], (DEPTH, HEAD_DIM), 0.02),
        'k_norm_g': 1.0 + nrm(ks[14], (DEPTH, HEAD_DIM), 0.02),
        'm_conv_w': nrm(ks[15], (DEPTH, M_CONV, 2 * M_HEADS * M_DK), M_CONV ** -0.5),
        'm_gate_b': gate_base + nrm(ks[16], (DEPTH, 4 * M_HEADS), 0.1),
        'm_norm_g': 1.0 + nrm(ks[17], (DEPTH, M_WIDTH), 0.02),
        'w_proj_attn': nrm(ks[18], (DEPTH, ATTN_WIDTH, D), ATTN_WIDTH ** -0.5),
        'w_proj_mlstm': nrm(ks[19], (DEPTH, M_WIDTH, D), M_WIDTH ** -0.5),
        'w_proj_fourier': nrm(ks[20], (DEPTH, F_WIDTH, D), F_WIDTH ** -0.5),
        'w_out': nrm(ks[21], (DEPTH, D, D), D ** -0.5),
        'norm2_g': 1.0 + nrm(ks[22], (DEPTH, D), 0.02),
        'w_ffn_in': nrm(ks[23], (DEPTH, D, 2 * FF_HIDDEN), D ** -0.5),
        'w_ffn_out': nrm(ks[24], (DEPTH, FF_HIDDEN, D), FF_HIDDEN ** -0.5),
    }


def reference(x_prompt, x_sample, cache_k, cache_v, state_C, state_n, state_m, c, c_ctx,
              w_ada, b_ada, norm1_g, w_in, q_norm_g, k_norm_g, m_conv_w, m_gate_b, m_norm_g,
              w_proj_attn, w_proj_mlstm, w_proj_fourier, w_out, norm2_g, w_ffn_in, w_ffn_out):
    f32 = jnp.float32
    t_lat = x_sample.shape[1]
    rows = t_lat // GRID_W
    row = jnp.repeat(jnp.arange(rows, dtype=jnp.int32), GRID_W)
    col = jnp.tile(jnp.arange(GRID_W, dtype=jnp.int32), rows)
    xp = x_prompt
    xs = x_sample
    ks_, vs_, Cs, ns, ms = [], [], [], [], []
    for l in range(DEPTH):
        wts = (norm1_g[l], w_in[l], q_norm_g[l], k_norm_g[l], m_conv_w[l], m_gate_b[l], m_norm_g[l],
               w_proj_attn[l], w_proj_mlstm[l], w_proj_fourier[l], w_out[l], norm2_g[l],
               w_ffn_in[l], w_ffn_out[l])
        mod_ctx = _modulation(c_ctx, w_ada[l], b_ada[l])
        xp, k_l, v_l, st_f, st_b = _layer(xp, mod_ctx, None, None, *wts)
        ks_.append(k_l)
        vs_.append(v_l)
        Cs.append(jnp.stack([st_f[0], st_b[0]], axis=1))
        ns.append(jnp.stack([st_f[1], st_b[1]], axis=1))
        ms.append(jnp.stack([st_f[2], st_b[2]], axis=1))
        mod_lat = [m[:, None, :] for m in _modulation(c, w_ada[l], b_ada[l])]
        ctx_fw = (state_C[:, l, 0].astype(f32), state_n[:, l, 0].astype(f32), state_m[:, l, 0].astype(f32))
        ctx_bw = (state_C[:, l, 1].astype(f32), state_n[:, l, 1].astype(f32), state_m[:, l, 1].astype(f32))
        ctx = (cache_k[:, l], cache_v[:, l], ctx_fw, ctx_bw)
        xs = _layer(xs, mod_lat, (row, col), ctx, *wts)[0]
    new_k = jnp.stack(ks_, axis=1)
    new_v = jnp.stack(vs_, axis=1)
    new_C = jnp.stack(Cs, axis=1)
    new_n = jnp.stack(ns, axis=1)
    new_m = jnp.stack(ms, axis=1)
    return (xp, xs, new_k, new_v, new_C, new_n, new_m)
```

```cpp
#include <hip/hip_runtime.h>
#include <hip/hip_bf16.h>
#include <cstdio>
#include <cstdint>
#include <cmath>

#ifndef MK_N_LAUNCHES
#define MK_N_LAUNCHES 17
#endif
#ifndef T_MASK
#define T_MASK 0xFFFF
#endif

constexpr int DM = 1024, MC = 4096, ML = 8192, MTOT = 12288;
constexpr int INC = 5392, NIN = 5376, KMRG = 1280, FF = 2816, NF1 = 5632, NBG = 3072;
constexpr float RMS_EPS = 1e-6f;
constexpr float LOG2E = 1.4426950408889634f;
constexpr float ATT_C2 = 0.125f * 1.4426950408889634f;
constexpr size_t OFF_YP = 0, OFF_YS = 4194304, OFF_NK = 12582912, OFF_NV = 14680064, OFF_NC = 16777216, OFF_NN = 17825792, OFF_NM = 17842176;
constexpr size_t MiB = 1u << 20;
constexpr size_t WS_CTL = 0, CTL_ZERO_BYTES = 2 * MiB;
constexpr size_t WS_MOD = 1 * MiB;
constexpr size_t WS_WIN = 2 * MiB;
constexpr size_t WS_WMRG = WS_WIN + 11010048;
constexpr size_t WS_WOUT = WS_WMRG + 2621440;
constexpr size_t WS_WF1 = WS_WOUT + 2097152;
constexpr size_t WS_WF2 = WS_WF1 + 11534336;
constexpr size_t WS_ROPE = WS_WF2 + 5767168;
constexpr size_t WS_DFTC = WS_ROPE + 65536;
constexpr size_t WS_DFTL = WS_DFTC + 262144;
constexpr size_t WS_GATES = WS_DFTL + 4194304;
constexpr size_t WS_XN = 40 * MiB;
constexpr size_t WS_CT = WS_XN;
constexpr size_t WS_HF = WS_XN + 12 * MiB;
constexpr size_t WS_BG = 64 * MiB;
constexpr size_t WS_HID = WS_BG;
constexpr size_t WS_Q = 136 * MiB;
constexpr size_t WS_KC = WS_Q + 12 * MiB, WS_VC = WS_KC + 2 * MiB, WS_KL = WS_VC + 2 * MiB, WS_VL = WS_KL + 5 * MiB;
constexpr size_t WS_MRGD = WS_Q;
constexpr size_t WS_QM = 162 * MiB, WS_KM = WS_QM + 6 * MiB, WS_KMT = WS_KM + 6 * MiB, WS_VT = WS_KMT + 6 * MiB, WS_OM = WS_VT + 6 * MiB, WS_UT = WS_OM + 6 * MiB;
constexpr size_t WS_ACAT = 198 * MiB;
constexpr size_t WS_QN = 228 * MiB, WS_KN = 234 * MiB, WS_KNT = 240 * MiB;
constexpr size_t WS_END = 246 * MiB;
static_assert(WS_GATES + 786432 <= WS_XN && WS_VL + 5 * MiB <= WS_QM && WS_UT + 6 * MiB <= WS_ACAT, "ws map");
constexpr int CW_TMO = 0, CW_CODE = 1;
constexpr int CW_BAR = 4096;
constexpr int CW_QUEUE = 65536;
constexpr int RING_OFF = 0, RING_BYTES = 131072;
constexpr int LDSCTL_OFF = RING_BYTES, MISC_OFF = LDSCTL_OFF + 320;
constexpr int LDS_BYTES = 147456;


namespace pg8 {
#define PG8_LAS __attribute__((address_space(3)))
typedef unsigned short bf16_t;
typedef short bf16x8 __attribute__((ext_vector_type(8)));
typedef float f32x4 __attribute__((ext_vector_type(4)));
typedef unsigned u32x4 __attribute__((ext_vector_type(4)));
constexpr int BM = 256, BK = 64, HALF = 128, HTB = HALF * BK * 2  , STAGE_BYTES = 8 * HTB, NXCD = 8, WGM = 8;

__host__ __device__ __forceinline__ int lds_byte(int r, int c) { const int st = (r >> 4) * 2 + (c >> 5), rr = r & 15, cc = c & 31, ob = rr * 64 + cc * 2; return st * 1024 + (ob ^ (((ob >> 9) & 1) << 5)); }
__host__ __device__ __forceinline__ void stage_rc(int b, int& R, int& C) { const int st = b / 1024, sb = b % 1024, swz = sb ^ (((sb >> 9) & 1) << 5); R = (st >> 1) * 16 + swz / 64; C = (st & 1) * 32 + (swz % 64) / 2; }
__host__ __device__ __forceinline__ int perm32(int rho) { const int n = rho >> 4, i = rho & 15; return 8 * (i >> 2) + 4 * n + (i & 3); }

struct Unit { int pm, pn; };
struct Gemm { const bf16_t* A; const bf16_t* Bt; int M, N, K; };

struct StaticOrder {
    int nM, nN, nwg, G, c;
    __host__ __device__ void init(int M, int N, int G_, int c_) { nM = M / BM; nN = N / BM; nwg = nM * nN; G = G_; c = c_; }
    __host__ __device__ bool next(int i, Unit& u) const {
        const long L = (long)i * G + c; if (L >= nwg) return false;
        int wgid = (int)L; { const int q = nwg / NXCD, r = nwg % NXCD, xcd = wgid % NXCD, off = wgid / NXCD; wgid = (xcd < r ? xcd * (q + 1) : r * (q + 1) + (xcd - r) * q) + off; }
        const int nig = WGM * nN, gid = wgid / nig, fm = gid * WGM, gsz = (nM - fm) < WGM ? (nM - fm) : WGM;
        u.pm = fm + ((wgid % nig) % gsz); u.pn = (wgid % nig) / gsz; return true;
    }
    __device__ __forceinline__ void a_ready(const Unit&) const {}
    __device__ __forceinline__ void done(const Unit&) const {}
};

__device__ __forceinline__ unsigned cvt_pk_bf16(float lo, float hi) { unsigned r; asm volatile("v_cvt_pk_bf16_f32 %0, %1, %2" : "=v"(r) : "v"(lo), "v"(hi)); return r; }
typedef float f32x2 __attribute__((ext_vector_type(2)));

typedef float f32x2v __attribute__((ext_vector_type(2)));
typedef unsigned u32x2 __attribute__((ext_vector_type(2)));
__device__ __forceinline__ unsigned f2bf_(float f) { unsigned u = __builtin_bit_cast(unsigned, f); return (u + 0x7fffu + ((u >> 16) & 1u)) >> 16; }
__device__ __forceinline__ unsigned pk2_(float lo, float hi) { return f2bf_(lo) | (f2bf_(hi) << 16); }
__device__ __forceinline__ u32x2 pk4_(f32x4 v) { u32x2 w; w.x = pk2_(v[0], v[1]); w.y = pk2_(v[2], v[3]); return w; }
__device__ __forceinline__ float bf2f_(unsigned short h) { return __builtin_bit_cast(float, (unsigned)h << 16); }
__device__ __forceinline__ f32x4 bf4_to_f32(u32x2 w) { f32x4 r; r[0] = __builtin_bit_cast(float, w.x << 16); r[1] = __builtin_bit_cast(float, w.x & 0xffff0000u); r[2] = __builtin_bit_cast(float, w.y << 16); r[3] = __builtin_bit_cast(float, w.y & 0xffff0000u); return r; }

struct OneUnit { Unit u;
    __device__ __forceinline__ bool next(int i, Unit& o) const { if (i != 0) return false; o = u; return true; }
    __device__ __forceinline__ void a_ready(const Unit&) const {}
    __device__ __forceinline__ void done(const Unit&) const {} };

struct EpiIn {
    static constexpr bool PERM = false, AFTER_DRAIN = false, HAS_MID = false;
    int layer;
    bf16_t *Q, *KC, *VC, *KL, *VL, *QM, *KM, *KMT, *VT, *OM, *UT, *BG;
    float *onk, *onv;
    const float *qg, *kg;
    const f32x2v* rope;
    __device__ __forceinline__ void operator()(const f32x4 (&acc)[2][2][4][2], const Unit& u, int wr, int wc, int fr0, int fq0) const {
        int fr = fr0, fq = fq0; asm volatile("" : "+v"(fr), "+v"(fq));
        const int pn = u.pn, pm = u.pm;
        const bool ctx = pm < 16;
        const int b = ctx ? pm : ((pm - 16) >> 2);
        const int tb = ctx ? 0 : ((pm - 16) & 3) * 256;
        const int T = ctx ? 256 : 1024;
        const int rl0 = wr * 64 + fr;
        if (pn <= 3) {
            const float* gv = (pn == 2) ? kg : qg;
            f32x4 g4[2][2];
#pragma unroll
            for (int bj = 0; bj < 2; ++bj)
#pragma unroll
                for (int n = 0; n < 2; ++n) g4[bj][n] = *(const f32x4*)(gv + 32 * bj + 16 * n + 4 * fq);
#pragma unroll
            for (int ai = 0; ai < 2; ++ai)
#pragma unroll
                for (int m = 0; m < 4; ++m) {
                    asm volatile("" ::: "memory"); const int rl = rl0 + ai * 128 + m * 16; const int t = tb + rl; const size_t row = (size_t)pm * 256 + rl;
                    f32x4 v[2][2];
#pragma unroll
                    for (int bj = 0; bj < 2; ++bj)
#pragma unroll
                        for (int n = 0; n < 2; ++n) v[bj][n] = acc[ai][bj][m][n];
                    if (pn != 3) {
                        float ss = 0.f;
#pragma unroll
                        for (int bj = 0; bj < 2; ++bj)
#pragma unroll
                            for (int n = 0; n < 2; ++n) { const f32x4 x = v[bj][n]; ss += (x[0] * x[0] + x[1] * x[1]) + (x[2] * x[2] + x[3] * x[3]); }
                        ss += __shfl_xor(ss, 16); ss += __shfl_xor(ss, 32);
                        const float rs = 1.0f / sqrtf(ss * (1.0f / 64.0f) + RMS_EPS);
#pragma unroll
                        for (int bj = 0; bj < 2; ++bj)
#pragma unroll
                            for (int n = 0; n < 2; ++n) v[bj][n] = v[bj][n] * rs * g4[bj][n];
                        if (!ctx) {
#pragma unroll
                            for (int bj = 0; bj < 2; ++bj) {
                                const int pos = bj == 0 ? (t >> 6) : (t & 63);
                                const f32x2v* rp = rope + pos * 16 + 4 * fq;
#pragma unroll
                                for (int j = 0; j < 4; ++j) { const f32x2v cs = rp[j]; const float x1 = v[bj][0][j], x2 = v[bj][1][j];
                                    v[bj][0][j] = x1 * cs.x - x2 * cs.y; v[bj][1][j] = x2 * cs.x + x1 * cs.y; }
                            }
                        }
                    }
                    if (pn <= 1) {
                        bf16_t* dst = Q + row * 512 + (4 * pn + wc) * 64 + 4 * fq;
#pragma unroll
                        for (int bj = 0; bj < 2; ++bj)
#pragma unroll
                            for (int n = 0; n < 2; ++n) *(u32x2*)(dst + 32 * bj + 16 * n) = pk4_(v[bj][n] * ATT_C2);
                    } else {
                        const int hc = wc * 64 + 4 * fq;
                        if (ctx) {
                            float* of = (pn == 2 ? onk : onv) + ((size_t)((b * 2 + layer) * 256 + t)) * 256 + hc;
                            bf16_t* dst = (pn == 2 ? KC : VC) + ((size_t)(b * 256 + t)) * 256 + hc;
#pragma unroll
                            for (int bj = 0; bj < 2; ++bj)
#pragma unroll
                                for (int n = 0; n < 2; ++n) { *(f32x4*)(of + 32 * bj + 16 * n) = v[bj][n]; *(u32x2*)(dst + 32 * bj + 16 * n) = pk4_(v[bj][n]); }
                        } else {
                            bf16_t* dst = (pn == 2 ? KL : VL) + ((size_t)(b * 1280 + 256 + t)) * 256 + hc;
#pragma unroll
                            for (int bj = 0; bj < 2; ++bj)
#pragma unroll
                                for (int n = 0; n < 2; ++n) *(u32x2*)(dst + 32 * bj + 16 * n) = pk4_(v[bj][n]);
                        }
                    }
                }
        } else {
            const int c0 = 32 * wc + 4 * fq;
            const size_t tbase = ctx ? (size_t)b * 65536 : (size_t)16 * 65536 + (size_t)b * 262144;
#pragma unroll
            for (int ai = 0; ai < 2; ++ai)
#pragma unroll
                for (int m = 0; m < 4; ++m) {
                    asm volatile("" ::: "memory"); const int rl = rl0 + ai * 128 + m * 16; const int t = tb + rl; const size_t row = (size_t)pm * 256 + rl;
#pragma unroll
                    for (int bj = 0; bj < 2; ++bj)
#pragma unroll
                        for (int n = 0; n < 2; ++n) {
                            const f32x4 x = acc[ai][bj][m][n]; const int c = c0 + 128 * bj + 16 * n;
                            if (pn == 4) { *(u32x2*)(QM + row * 256 + c) = pk4_(x); }
                            else if (pn == 5 || pn == 6 || pn == 8) {
                                if (pn == 5) *(u32x2*)(KM + row * 256 + c) = pk4_(x);
                                bf16_t* tp = (pn == 5 ? KMT : (pn == 6 ? VT : UT)) + tbase + (size_t)c * T + t;
#pragma unroll
                                for (int j = 0; j < 4; ++j) tp[(size_t)j * T] = (bf16_t)f2bf_(x[j]);
                            }
                            else if (pn == 7) { f32x4 s;
#pragma unroll
                                for (int j = 0; j < 4; ++j) s[j] = 1.0f / (1.0f + __expf(-x[j]));
                                *(u32x2*)(OM + row * 256 + c) = pk4_(s); }
                            else { f32x4 e;
#pragma unroll
                                for (int j = 0; j < 4; ++j) e[j] = __expf(-fminf(fmaxf(x[j], -30.f), 30.f));
                                *(u32x2*)(BG + row * 3072 + (size_t)(pn - 9) * 256 + c) = pk4_(e); }
                        }
                }
        }
    }
};

struct EpiMerge {
    static constexpr bool PERM = false, AFTER_DRAIN = false, HAS_MID = true;
    const bf16_t* BG; bf16_t* O;
    __device__ __forceinline__ void mid(f32x4 (&acc)[2][2][4][2], const Unit& u, int t, int wr, int wc, int fr0, int fq0) const {
        if (t != 8 && t != 12) return;
        int fr = fr0, fq = fq0; asm volatile("" : "+v"(fr), "+v"(fq));
        const int gn = (t == 8) ? 1024 : 2048, gd = (t == 8) ? 0 : 1024;
        const int c0 = u.pn * 256 + 32 * wc + 4 * fq;
#pragma unroll
        for (int ai = 0; ai < 2; ++ai)
#pragma unroll
            for (int m = 0; m < 4; ++m) {
                asm volatile("" ::: "memory"); const size_t row = (size_t)u.pm * 256 + ai * 128 + wr * 64 + m * 16 + fr; const bf16_t* bp = BG + row * 3072 + c0;
#pragma unroll
                for (int bj = 0; bj < 2; ++bj)
#pragma unroll
                    for (int n = 0; n < 2; ++n) {
                        const f32x4 en = bf4_to_f32(*(const u32x2*)(bp + gn + 128 * bj + 16 * n)), ed = bf4_to_f32(*(const u32x2*)(bp + gd + 128 * bj + 16 * n));
                        f32x4 f;
#pragma unroll
                        for (int j = 0; j < 4; ++j) f[j] = (1.0f + en[j]) * __builtin_amdgcn_rcpf(1.0f + ed[j]);
                        acc[ai][bj][m][n] = acc[ai][bj][m][n] * f;
                    }
            }
    }
    __device__ __forceinline__ void operator()(const f32x4 (&acc)[2][2][4][2], const Unit& u, int wr, int wc, int fr0, int fq0) const {
        int fr = fr0, fq = fq0; asm volatile("" : "+v"(fr), "+v"(fq));
        const int c0 = u.pn * 256 + 32 * wc + 4 * fq;
#pragma unroll
        for (int ai = 0; ai < 2; ++ai)
#pragma unroll
            for (int m = 0; m < 4; ++m) {
                asm volatile("" ::: "memory"); const size_t row = (size_t)u.pm * 256 + ai * 128 + wr * 64 + m * 16 + fr; const bf16_t* bp = BG + row * 3072 + 2048 + c0; bf16_t* op = O + row * 1024 + c0;
#pragma unroll
                for (int bj = 0; bj < 2; ++bj)
#pragma unroll
                    for (int n = 0; n < 2; ++n) {
                        const f32x4 ef = bf4_to_f32(*(const u32x2*)(bp + 128 * bj + 16 * n)); f32x4 o;
#pragma unroll
                        for (int j = 0; j < 4; ++j) o[j] = acc[ai][bj][m][n][j] * __builtin_amdgcn_rcpf(1.0f + ef[j]);
                        *(u32x2*)(op + 128 * bj + 16 * n) = pk4_(o);
                    }
            }
    }
};

struct EpiRes {
    static constexpr bool PERM = false, AFTER_DRAIN = false, HAS_MID = false;
    const float *xin_p, *xin_s;
    float* xout;
    const float* gate;
    __device__ __forceinline__ void operator()(const f32x4 (&acc)[2][2][4][2], const Unit& u, int wr, int wc, int fr0, int fq0) const {
        int fr = fr0, fq = fq0; asm volatile("" : "+v"(fr), "+v"(fq));
        const int pm = u.pm; const int v = pm < 16 ? 0 : 1 + ((pm - 16) >> 2);
        const float* xin = pm < 16 ? xin_p + (size_t)pm * 256 * 1024 : xin_s + (size_t)(pm - 16) * 256 * 1024;
        const int c0 = u.pn * 256 + 32 * wc + 4 * fq;
        f32x4 g4[2][2];
#pragma unroll
        for (int bj = 0; bj < 2; ++bj)
#pragma unroll
            for (int n = 0; n < 2; ++n) g4[bj][n] = *(const f32x4*)(gate + (size_t)v * 6144 + c0 + 128 * bj + 16 * n);
#pragma unroll
        for (int ai = 0; ai < 2; ++ai)
#pragma unroll
            for (int m = 0; m < 4; ++m) {
                asm volatile("" ::: "memory"); const int rl = ai * 128 + wr * 64 + m * 16 + fr; const float* xp = xin + (size_t)rl * 1024 + c0; float* op = xout + ((size_t)pm * 256 + rl) * 1024 + c0;
#pragma unroll
                for (int bj = 0; bj < 2; ++bj)
#pragma unroll
                    for (int n = 0; n < 2; ++n) { const f32x4 x = *(const f32x4*)(xp + 128 * bj + 16 * n); *(f32x4*)(op + 128 * bj + 16 * n) = x + g4[bj][n] * acc[ai][bj][m][n]; }
            }
    }
};

struct EpiSwiGLU {
    static constexpr bool PERM = false, AFTER_DRAIN = false, HAS_MID = false;
    bf16_t* H;
    __device__ __forceinline__ void operator()(const f32x4 (&acc)[2][2][4][2], const Unit& u, int wr, int wc, int fr0, int fq0) const {
        int fr = fr0, fq = fq0; asm volatile("" : "+v"(fr), "+v"(fq));
        const int c0 = u.pn * 128 + 32 * wc + 4 * fq;
#pragma unroll
        for (int ai = 0; ai < 2; ++ai)
#pragma unroll
            for (int m = 0; m < 4; ++m) {
                asm volatile("" ::: "memory"); const size_t row = (size_t)u.pm * 256 + ai * 128 + wr * 64 + m * 16 + fr; bf16_t* op = H + row * FF + c0;
#pragma unroll
                for (int n = 0; n < 2; ++n) { const f32x4 g = acc[ai][0][m][n], v = acc[ai][1][m][n]; f32x4 o;
#pragma unroll
                    for (int j = 0; j < 4; ++j) o[j] = g[j] * __builtin_amdgcn_rcpf(1.0f + __expf(-g[j])) * v[j];
                    *(u32x2*)(op + 16 * n) = pk4_(o); }
            }
    }
};

struct EpiFourier {
    static constexpr bool PERM = false, AFTER_DRAIN = false, HAS_MID = false;
    bf16_t* AC; int lat;
    __device__ __forceinline__ void operator()(const f32x4 (&acc)[2][2][4][2], const Unit& u, int wr, int wc, int fr0, int fq0) const {
        int fr = fr0, fq = fq0; asm volatile("" : "+v"(fr), "+v"(fq));
        const size_t rbase = lat ? (size_t)4096 + (size_t)u.pn * 1024 + (size_t)(u.pm & 3) * 256 : (size_t)u.pn * 256;
        const int cb = 768 + (lat ? (u.pm >> 2) : u.pm) * 256 + 32 * wc + 4 * fq;
#pragma unroll
        for (int ai = 0; ai < 2; ++ai)
#pragma unroll
            for (int m = 0; m < 4; ++m) {
                asm volatile("" ::: "memory"); const size_t row = rbase + ai * 128 + wr * 64 + m * 16 + fr; bf16_t* op = AC + row * KMRG + cb;
#pragma unroll
                for (int bj = 0; bj < 2; ++bj)
#pragma unroll
                    for (int n = 0; n < 2; ++n) *(u32x2*)(op + 128 * bj + 16 * n) = pk4_(acc[ai][bj][m][n]);
            }
    }
};

template <class Epi, class Sched, bool ALIGN_EPI = false, bool SP2 = false>
__device__ __forceinline__ void gemm_phase(PG8_LAS unsigned char* lds, const Gemm g, const Sched& S, const Epi& E, const int tid_in) {
    const int tid = tid_in, wid = __builtin_amdgcn_readfirstlane(tid >> 6), lane = tid & 63, wr = wid >> 2, wc = wid & 3, fr = lane & 15, fq = lane >> 4;
    const int K = g.K, nt = K / BK;
    unsigned voffA[2], voffB[2];
#pragma unroll
    for (int i = 0; i < 2; ++i) { int R, C; stage_rc(tid * 16 + i * 8192, R, C); const int Rb = Epi::PERM ? ((R & ~31) + perm32(R & 31)) : R;
        voffA[i] = (unsigned)(R * K + C) * 2u; voffB[i] = (unsigned)(Rb * K + C) * 2u; }
    const size_t kstep = (size_t)(BK * 2);
    const size_t hstep = (size_t)HALF * K * 2;
    const size_t tstep = 2 * hstep;
    const unsigned ldsw = (unsigned)wid * 1024u;
    const int aoff = lds_byte(wr * 64 + fr, fq * 8), boff = lds_byte(wc * 32 + fr, fq * 8);
#define PG8_SA(b, h) (((b) * 2 + (h)) * HTB)
#define PG8_SB(b, h) ((4 + (b) * 2 + (h)) * HTB)
#define PG8_STAGE(bufoff, gbase, voff) do { _Pragma("unroll") for (int _i = 0; _i < 2; ++_i) \
        __builtin_amdgcn_global_load_lds((const unsigned*)((const char*)(gbase) + (voff)[_i]), (PG8_LAS unsigned*)(lds + (bufoff) + ldsw + _i * 8192), 16, 0, 0); } while (0)
#define PG8_LDA(dst, b, h) do { _Pragma("unroll") for (int m = 0; m < 4; ++m) _Pragma("unroll") for (int k = 0; k < 2; ++k) dst[m][k] = *(const PG8_LAS bf16x8*)(lds + PG8_SA(b, h) + aoff + m * 2048 + k * 1024); } while (0)
#define PG8_LDB(dst, b, h) do { _Pragma("unroll") for (int n = 0; n < 2; ++n) _Pragma("unroll") for (int k = 0; k < 2; ++k) dst[n][k] = *(const PG8_LAS bf16x8*)(lds + PG8_SB(b, h) + boff + n * 2048 + k * 1024); } while (0)
#define PG8_MMA(ai, bj, At, Bt) do { __builtin_amdgcn_s_setprio(1); _Pragma("unroll") for (int m = 0; m < 4; ++m) _Pragma("unroll") for (int n = 0; n < 2; ++n) _Pragma("unroll") for (int k = 0; k < 2; ++k) \
        acc[ai][bj][m][n] = __builtin_amdgcn_mfma_f32_16x16x32_bf16(Bt[n][k], At[m][k], acc[ai][bj][m][n], 0, 0, 0); __builtin_amdgcn_s_setprio(0); } while (0)
#define PG8_WAIT_V(n) asm volatile("s_waitcnt vmcnt(" #n ")" ::: "memory")
#define PG8_WAIT_L(n) asm volatile("s_waitcnt lgkmcnt(" #n ")" ::: "memory")
#define PG8_BAR __builtin_amdgcn_s_barrier()
#define PG8_SCHED __builtin_amdgcn_sched_barrier(0)
    Unit cur, nxt; int ui = 0;
    if (!S.next(0, cur)) return;
    f32x4 acc[2][2][4][2];
#pragma unroll
    for (int a = 0; a < 2; ++a)
#pragma unroll
        for (int b = 0; b < 2; ++b)
#pragma unroll
            for (int m = 0; m < 4; ++m)
#pragma unroll
                for (int n = 0; n < 2; ++n) acc[a][b][m][n] = (f32x4){0.f, 0.f, 0.f, 0.f};
    bf16x8 At[4][2], B0[2][2], B1[2][2];
    const char* cA = (const char*)g.A + (size_t)cur.pm * tstep; const char* cB = (const char*)g.Bt + (size_t)cur.pn * tstep;
    S.a_ready(cur);
    if constexpr (SP2) {
        PG8_STAGE(PG8_SB(0, 0), cB, voffB); PG8_STAGE(PG8_SB(0, 1), cB + hstep, voffB); PG8_STAGE(PG8_SA(0, 0), cA, voffA); PG8_STAGE(PG8_SA(0, 1), cA + hstep, voffA);
        if (wr == 1) PG8_BAR;
        PG8_WAIT_V(2); PG8_BAR;
        PG8_STAGE(PG8_SB(1, 0), cB + kstep, voffB); PG8_STAGE(PG8_SA(1, 0), cA + kstep, voffA); PG8_STAGE(PG8_SB(1, 1), cB + hstep + kstep, voffB);
        PG8_WAIT_V(6); PG8_BAR;
    } else {
        PG8_STAGE(PG8_SB(0, 0), cB, voffB); PG8_STAGE(PG8_SA(0, 0), cA, voffA); PG8_STAGE(PG8_SB(0, 1), cB + hstep, voffB); PG8_STAGE(PG8_SA(0, 1), cA + hstep, voffA);
        if (wr == 1) PG8_BAR;
        PG8_WAIT_V(4); PG8_BAR;
        PG8_STAGE(PG8_SB(1, 0), cB + kstep, voffB); PG8_STAGE(PG8_SA(1, 0), cA + kstep, voffA); PG8_STAGE(PG8_SB(1, 1), cB + hstep + kstep, voffB);
        PG8_WAIT_V(6); PG8_BAR;
    }
    for (;;) {
        const bool has_next = S.next(ui + 1, nxt);
        const char* nA = has_next ? (const char*)g.A + (size_t)nxt.pm * tstep : cA; const char* nB = has_next ? (const char*)g.Bt + (size_t)nxt.pn * tstep : cB;
        for (int t = 0; t < nt; t += 2) {
            if constexpr (Epi::HAS_MID) { E.mid(acc, cur, t, wr, wc, fr, fq); }
            const bool last = (t == nt - 2);
            const char* a1 = cA + (size_t)(t + 1) * kstep;
            const char* a2 = last ? nA : cA + (size_t)(t + 2) * kstep; const char* b2 = last ? nB : cB + (size_t)(t + 2) * kstep;
            const char* a3 = a2 + kstep; const char* b3 = b2 + kstep;
            if (last && has_next) S.a_ready(nxt);
            if constexpr (SP2) {
            PG8_LDB(B0, 0, 0); PG8_LDB(B1, 0, 1); PG8_SCHED; PG8_LDA(At, 0, 0); PG8_STAGE(PG8_SA(1, 1), a1 + hstep, voffA);
            PG8_WAIT_V(8); PG8_WAIT_L(0); PG8_BAR; PG8_MMA(0, 0, At, B0); PG8_MMA(0, 1, At, B1); PG8_BAR; PG8_SCHED;
            PG8_LDA(At, 0, 1); PG8_STAGE(PG8_SB(0, 0), b2, voffB); PG8_STAGE(PG8_SB(0, 1), b2 + hstep, voffB); PG8_STAGE(PG8_SA(0, 0), a2, voffA);
            PG8_WAIT_V(8); PG8_WAIT_L(0); PG8_BAR; PG8_MMA(1, 0, At, B0); PG8_MMA(1, 1, At, B1); PG8_BAR; PG8_SCHED;
            PG8_LDB(B0, 1, 0); PG8_LDB(B1, 1, 1); PG8_SCHED; PG8_LDA(At, 1, 0); PG8_STAGE(PG8_SA(0, 1), a2 + hstep, voffA);
            PG8_WAIT_V(8); PG8_WAIT_L(0); PG8_BAR; PG8_MMA(0, 0, At, B0); PG8_MMA(0, 1, At, B1); PG8_BAR; PG8_SCHED;
            PG8_LDA(At, 1, 1); PG8_STAGE(PG8_SB(1, 0), b3, voffB); PG8_STAGE(PG8_SB(1, 1), b3 + hstep, voffB); PG8_STAGE(PG8_SA(1, 0), a3, voffA);
            PG8_WAIT_V(8); PG8_WAIT_L(0); PG8_BAR; PG8_MMA(1, 0, At, B0); PG8_MMA(1, 1, At, B1); PG8_BAR; PG8_SCHED;
            } else {
            PG8_LDB(B0, 0, 0); PG8_SCHED; PG8_LDA(At, 0, 0); PG8_STAGE(PG8_SA(1, 1), a1 + hstep, voffA);
            PG8_WAIT_L(8); PG8_BAR; PG8_WAIT_L(0); PG8_MMA(0, 0, At, B0); PG8_BAR; PG8_SCHED;
            PG8_LDB(B1, 0, 1); PG8_STAGE(PG8_SB(0, 0), b2, voffB);
            PG8_BAR; PG8_WAIT_L(0); PG8_MMA(0, 1, At, B1); PG8_BAR;
            PG8_LDA(At, 0, 1); PG8_STAGE(PG8_SA(0, 0), a2, voffA);
            PG8_BAR; PG8_WAIT_L(0); PG8_MMA(1, 0, At, B0); PG8_BAR; PG8_SCHED;
            PG8_STAGE(PG8_SB(0, 1), b2 + hstep, voffB);
            PG8_WAIT_V(6); PG8_BAR; PG8_MMA(1, 1, At, B1); PG8_BAR;
            PG8_LDB(B0, 1, 0); PG8_SCHED; PG8_LDA(At, 1, 0); PG8_STAGE(PG8_SA(0, 1), a2 + hstep, voffA);
            PG8_WAIT_L(8); PG8_BAR; PG8_WAIT_L(0); PG8_MMA(0, 0, At, B0); PG8_BAR; PG8_SCHED;
            PG8_LDB(B1, 1, 1); PG8_STAGE(PG8_SB(1, 0), b3, voffB);
            PG8_BAR; PG8_WAIT_L(0); PG8_MMA(0, 1, At, B1); PG8_BAR;
            PG8_LDA(At, 1, 1); PG8_STAGE(PG8_SA(1, 0), a3, voffA);
            PG8_BAR; PG8_WAIT_L(0); PG8_MMA(1, 0, At, B0); PG8_BAR; PG8_SCHED;
            PG8_STAGE(PG8_SB(1, 1), b3 + hstep, voffB);
            PG8_WAIT_V(6); PG8_BAR; PG8_MMA(1, 1, At, B1); PG8_BAR;
            }
        }
        if constexpr (ALIGN_EPI) { if (wr == 0) PG8_BAR; }
        if constexpr (!Epi::AFTER_DRAIN) { E(acc, cur, wr, wc, fr, fq); S.done(cur); }
        if (!has_next) break;
#pragma unroll
        for (int a = 0; a < 2; ++a)
#pragma unroll
            for (int b = 0; b < 2; ++b)
#pragma unroll
                for (int m = 0; m < 4; ++m)
#pragma unroll
                    for (int n = 0; n < 2; ++n) acc[a][b][m][n] = (f32x4){0.f, 0.f, 0.f, 0.f};
        cur = nxt; cA = nA; cB = nB; ++ui;
        if constexpr (ALIGN_EPI) { if (wr == 1) PG8_BAR; }
    }
    PG8_WAIT_V(0);
    if constexpr (!ALIGN_EPI) { if (wr == 0) PG8_BAR; }
    PG8_BAR;
    if constexpr (Epi::AFTER_DRAIN) { E.fused(acc, cur, wr, wc, fr, fq, lds, wid, lane); S.done(cur); }
#undef PG8_SA
#undef PG8_SB
#undef PG8_STAGE
#undef PG8_LDA
#undef PG8_LDB
#undef PG8_MMA
#undef PG8_WAIT_V
#undef PG8_WAIT_L
#undef PG8_BAR
#undef PG8_SCHED
}
}

#define ATTN_STORE16(p,v) (*(u32x4*)(p)=(v))

#include <hip/hip_bf16.h>
#include <cmath>
namespace attn_body {
using bf16=__hip_bfloat16;
using bf16x8=__attribute__((ext_vector_type(8)))short;
using s16x4=__attribute__((ext_vector_type(4)))short;
using f32x16=__attribute__((ext_vector_type(16)))float;
using u32x4=__attribute__((ext_vector_type(4)))unsigned;
constexpr int D=64;
constexpr int NW=8,QBLK=32,QB=QBLK*NW,KVBLK=64;
constexpr int ATTN_UNIT_ROWS=QB;
__device__ __forceinline__ int crow(int r,int hi){return (r&3)+8*(r>>2)+4*hi;}
#define SBAR() __builtin_amdgcn_sched_barrier(0)
__device__ __forceinline__ void cmask(f32x16&p0,f32x16&p1,int jb,int qrel,int hi){
  const float NEG=-INFINITY; int kb=64*jb+4*hi;
  #pragma unroll
  for(int r=0;r<16;++r){int kv=kb+(r&3)+8*(r>>2); if(kv>qrel)p0[r]=NEG; if(kv+32>qrel)p1[r]=NEG;}
}

constexpr int NSLOT=3, SLOTB=8192;
constexpr int LDS_K=0, LDS_V=NSLOT*SLOTB, LDS_WS=2*NSLOT*SLOTB, LDS_OST=LDS_WS+NW*64*4, LDS_BYTES=LDS_OST+NW*4096;
constexpr float C2=0.125f*1.4426950408889634f;
__device__ __forceinline__ void glds16(const void*gsrc,unsigned lds_dst){unsigned keep;
  asm volatile("s_mov_b32 %0, m0\n\ts_mov_b32 m0, %2\n\ts_nop 0\n\tglobal_load_lds_dwordx4 %1, off\n\ts_mov_b32 m0, %0":"=&s"(keep):"v"(gsrc),"s"(lds_dst):"memory");}
__device__ __forceinline__ float max3f(float a,float b,float c){float r;asm("v_max3_f32 %0, %1, %2, %3":"=v"(r):"v"(a),"v"(b),"v"(c));return r;}
__device__ __forceinline__ float max2f(float a,float b){float r;asm("v_max_f32_e32 %0, %1, %2":"=v"(r):"v"(a),"v"(b));return r;}
__device__ __forceinline__ float fadd_s(float a,float b){float r;asm("v_add_f32_e32 %0, %1, %2":"=v"(r):"v"(a),"v"(b));return r;}
__device__ __forceinline__ float fsub_s(float a,float b){float r;asm("v_sub_f32_e32 %0, %1, %2":"=v"(r):"v"(a),"v"(b));return r;}
typedef float f32x2_t __attribute__((ext_vector_type(2))); typedef __bf16 bf16x2_t __attribute__((ext_vector_type(2)));
__device__ __forceinline__ unsigned cvtpk_s(float lo,float hi){f32x2_t v={lo,hi};bf16x2_t b=__builtin_convertvector(v,bf16x2_t);return __builtin_bit_cast(unsigned,b);}
#define WAIT_BAR(N) asm volatile("s_waitcnt vmcnt(" #N ") lgkmcnt(0)\n\ts_barrier":::"memory")

__device__ __forceinline__ void qkt(f32x16&p0,f32x16&p1,const char*Kslot,const bf16x8*qr,const f32x16&negm,int r32,int hi){
  const char*kb=Kslot+hi*1024+r32*16;
  #pragma unroll
  for(int d0=0;d0<4;++d0){
    const bf16x8 b0=*reinterpret_cast<const bf16x8*>(kb+d0*2048);
    const bf16x8 b1=*reinterpret_cast<const bf16x8*>(kb+d0*2048+512);
    if(d0==0){p0=__builtin_amdgcn_mfma_f32_32x32x16_bf16(b0,qr[0],negm,0,0,0);p1=__builtin_amdgcn_mfma_f32_32x32x16_bf16(b1,qr[0],negm,0,0,0);}
    else{p0=__builtin_amdgcn_mfma_f32_32x32x16_bf16(b0,qr[d0],p0,0,0,0);p1=__builtin_amdgcn_mfma_f32_32x32x16_bf16(b1,qr[d0],p1,0,0,0);}}
}
typedef __attribute__((address_space(3))) const char* lds_cptr;
typedef short v4i16_t __attribute__((ext_vector_type(4)));
__device__ __forceinline__ void kload8(bf16x8*kf,lds_cptr kp){
  kf[0]=*(const __attribute__((address_space(3))) bf16x8*)(kp);      kf[1]=*(const __attribute__((address_space(3))) bf16x8*)(kp+512);
  kf[2]=*(const __attribute__((address_space(3))) bf16x8*)(kp+2048); kf[3]=*(const __attribute__((address_space(3))) bf16x8*)(kp+2560);
  kf[4]=*(const __attribute__((address_space(3))) bf16x8*)(kp+4096); kf[5]=*(const __attribute__((address_space(3))) bf16x8*)(kp+4608);
  kf[6]=*(const __attribute__((address_space(3))) bf16x8*)(kp+6144); kf[7]=*(const __attribute__((address_space(3))) bf16x8*)(kp+6656);
}
__device__ __forceinline__ void kload2(bf16x8*kf,lds_cptr kp,int j){ kf[2*j]=*(const __attribute__((address_space(3))) bf16x8*)(kp+j*2048); kf[2*j+1]=*(const __attribute__((address_space(3))) bf16x8*)(kp+j*2048+512); }
__device__ __forceinline__ s16x4 vtr(lds_cptr p){ return __builtin_bit_cast(s16x4,__builtin_amdgcn_ds_read_tr16_b64_v4i16((__attribute__((address_space(3))) v4i16_t*)p)); }
__device__ __forceinline__ float rowmax(const f32x16&p0,const f32x16&p1){
  float a=max3f(p0[0],p0[1],p1[0]),b=max3f(p0[2],p0[3],p1[1]);a=max3f(a,p1[2],p1[3]);
  #pragma unroll
  for(int r=4;r<16;r+=4){a=max3f(a,p0[r],p0[r+1]);b=max3f(b,p0[r+2],p0[r+3]);a=max3f(a,p1[r],p1[r+1]);b=max3f(b,p1[r+2],p1[r+3]);}
  const float m=max2f(a,b);
  auto rr=__builtin_amdgcn_permlane32_swap(__float_as_uint(m),__float_as_uint(m),false,false);
  return max2f(__uint_as_float(rr[0]),__uint_as_float(rr[1]));
}
__device__ __forceinline__ void pv(f32x16*o,int vb,bf16x8 pa0,bf16x8 pa1,bf16x8 pa2,bf16x8 pa3){
  #pragma unroll
  for(int d0=0;d0<2;++d0){s16x4 lo[4],hi[4];
    #pragma unroll
    for(int ks=0;ks<4;++ks){
      asm volatile("ds_read_b64_tr_b16 %0,%1 offset:%c2":"=&v"(lo[ks]):"v"(vb),"i"(d0*4096+ks*1024):"memory");
      asm volatile("ds_read_b64_tr_b16 %0,%1 offset:%c2":"=&v"(hi[ks]):"v"(vb),"i"(d0*4096+ks*1024+512):"memory");}
    asm volatile("s_waitcnt lgkmcnt(0)":::"memory");SBAR();
    #define PK(k) (bf16x8){lo[k][0],lo[k][1],lo[k][2],lo[k][3],hi[k][0],hi[k][1],hi[k][2],hi[k][3]}
    o[d0]=__builtin_amdgcn_mfma_f32_32x32x16_bf16(pa0,PK(0),o[d0],0,0,0);
    o[d0]=__builtin_amdgcn_mfma_f32_32x32x16_bf16(pa1,PK(1),o[d0],0,0,0);
    o[d0]=__builtin_amdgcn_mfma_f32_32x32x16_bf16(pa2,PK(2),o[d0],0,0,0);
    o[d0]=__builtin_amdgcn_mfma_f32_32x32x16_bf16(pa3,PK(3),o[d0],0,0,0);
    #undef PK
  }
}

#ifndef ATTN_STORE16
#define ATTN_STORE16(p,v) (*(u32x4*)(p)=(v))
#endif
template<int THRL> __device__ __forceinline__ void attn_unit(const bf16*Qb,int QP,const bf16*__restrict__ Kh,const bf16*__restrict__ Vh,int KP,int NT,bf16*Ob,int OP,char*shm,const int tid_in){
  const int tid=tid_in,lane=tid&63,r32=lane&31,hi=lane>>5; const int wid=__builtin_amdgcn_readfirstlane(tid>>6);
  const bf16*Qw=Qb+(long)(wid*QBLK)*QP;
  const unsigned lds0=(unsigned)(uintptr_t)shm;
  float*wsf=(float*)(shm+LDS_WS)+wid*64;
  const bf16*ksrc=Kh+(long)lane*KP+wid*8;
  const bf16*vsrc=Vh+(long)(16*(wid&3)+(lane>>2))*KP+(wid>>2)*32+(lane&3)*8;
  const unsigned kdst=lds0+LDS_K+wid*1024, vdst=lds0+LDS_V+wid*1024;
  #define DMA_K(t,slot) glds16(ksrc+(long)(t)*KVBLK*KP,(unsigned)__builtin_amdgcn_readfirstlane(kdst+(slot)))
  #define DMA_V(t,slot) glds16(vsrc+(long)(t)*KVBLK*KP,(unsigned)__builtin_amdgcn_readfirstlane(vdst+(slot)))
  const int vb0=(int)(lds0+LDS_V)+((lane>>4)&1)*32+(lane&3)*8+(4*hi+((lane&15)>>2))*64;
  const char*Kbase=shm+LDS_K; bf16x8 kf[8];
  const lds_cptr shm3=(lds_cptr)shm; const lds_cptr kp0=shm3+LDS_K+hi*1024+r32*16; const lds_cptr vp0=shm3+LDS_V+((lane>>4)&1)*32+(lane&3)*8+(4*hi+((lane&15)>>2))*64;
  DMA_K(0,0);DMA_V(0,0);DMA_K(1,SLOTB);
  bf16x8 qr[4];
  #pragma unroll
  for(int d0=0;d0<4;++d0)qr[d0]=*reinterpret_cast<const bf16x8*>(&Qw[(long)r32*QP+d0*16+hi*8]);
  float mhat=0.f,l_reg=0.f;f32x16 o[2];o[0]=f32x16{};o[1]=f32x16{};f32x16 negm=f32x16{};asm volatile("":"+v"(negm));
  #define CMASK(P0,P1,t) do{}while(0)
  bool resc=false;
  #define START(P0,P1) do{ const float rm=rowmax(P0,P1); resc=false; \
    { const float dl=rm; mhat=fadd_s(mhat,dl); \
      _Pragma("unroll") for(int r=0;r<16;++r){P0[r]=fsub_s(P0[r],dl);P1[r]=fsub_s(P1[r],dl);} \
      _Pragma("unroll") for(int r=0;r<16;++r)negm[r]=-mhat; asm volatile("":"+v"(negm)); } \
    _Pragma("unroll") for(int r=0;r<16;++r)P0[r]=__builtin_amdgcn_exp2f(P0[r]); }while(0)
  #define RESC() do{ if(resc){ asm volatile("s_waitcnt lgkmcnt(0)":::"memory"); \
      _Pragma("unroll") for(int d_=0;d_<2;++d_) _Pragma("unroll") for(int r=0;r<16;++r)o[d_][r]*=wsf[crow(r,hi)]; } }while(0)
  f32x16 pA0,pA1,pB0,pB1;
  int sl_prev=0,sl_cur=0,sl_next=SLOTB;
  #define ROT() do{sl_prev=sl_cur;sl_cur=sl_next;sl_next=(sl_next==(NSLOT-1)*SLOTB)?0:sl_next+SLOTB;}while(0)
  DMA_K(2,2*SLOTB);
  WAIT_BAR(3);
  qkt(pA0,pA1,Kbase,qr,negm,r32,hi);asm volatile("s_nop 15\n\ts_nop 7":"+v"(pA0),"+v"(pA1));CMASK(pA0,pA1,0);
  START(pA0,pA1);
  _Pragma("unroll") for(int r=0;r<16;++r)pA1[r]=__builtin_amdgcn_exp2f(pA1[r]);
  WAIT_BAR(0);
  DMA_K(3,0);DMA_V(1,SLOTB);
  ROT();
  kload8(kf,kp0+sl_cur);
  WAIT_BAR(2);
  s16x4 vlo[8],vhi[8]; u32x4 pw0,pw1,pw2,pw3;
  #define PKW(P,B) cvtpk_s(P[B],P[B+1])
  #define PAF(k) __builtin_bit_cast(bf16x8,pw##k)
  #define VFR(i) (bf16x8){vlo[i][0],vlo[i][1],vlo[i][2],vlo[i][3],vhi[i][0],vhi[i][1],vhi[i][2],vhi[i][3]}
  #define PIN(x) asm volatile("":"+v"(x))
  #define MX3(a,b,c) __builtin_fmaxf(__builtin_fmaxf((a),(b)),(c))
  #define GAPA(MF,A0,A1,A2,A3,W0,W1,PW) do{ MF; sacc+=A0; sacc+=A1; sacc+=A2; sacc+=A3; PIN(sacc); W0; W1; PIN(PW); SBAR(); }while(0)
  #define EX(v) __builtin_amdgcn_exp2f(v)
  #define GAPB(MF,X,B) do{ MF; X[B]=EX(X[B]); X[B+1]=EX(X[B+1]); X[B+2]=EX(X[B+2]); X[B+3]=EX(X[B+3]); PIN(X); SBAR(); }while(0)
  #define VRD(i) do{ vlo[i]=vtr(vp_+(((i)>>2)*4096+((i)&3)*1024)); vhi[i]=vtr(vp_+(((i)>>2)*4096+((i)&3)*1024+512)); }while(0)
  #define KRD(G,j) do{ if(G){ kload2(kf,kp0+sl_next,j); SBAR(); } }while(0)
  #define STEP(C0,C1,P0,P1,t,GK,GV,GL) do{ SBAR(); \
    const lds_cptr vp_=vp0+sl_prev; \
    VRD(0); SBAR(); float sacc=(P0[0]+P0[1]); \
    GAPA(C0=__builtin_amdgcn_mfma_f32_32x32x16_bf16(kf[0],qr[0],negm,0,0,0), P0[2],P0[3],P0[4],P0[5],     pw0[0]=PKW(P0,0), pw0[1]=PKW(P0,2), pw0); \
    VRD(4); SBAR(); GAPA(C1=__builtin_amdgcn_mfma_f32_32x32x16_bf16(kf[1],qr[0],negm,0,0,0), P0[6],P0[7],P0[8],P0[9],     pw0[2]=PKW(P0,4), pw0[3]=PKW(P0,6), pw0); \
    VRD(1); SBAR(); GAPA(C0=__builtin_amdgcn_mfma_f32_32x32x16_bf16(kf[2],qr[1],C0,0,0,0),   P0[10],P0[11],P0[12],P0[13], pw1[0]=PKW(P0,8), pw1[1]=PKW(P0,10), pw1); \
    VRD(5); SBAR(); GAPA(C1=__builtin_amdgcn_mfma_f32_32x32x16_bf16(kf[3],qr[1],C1,0,0,0),   P0[14],P0[15],P1[0],P1[1],   pw1[2]=PKW(P0,12),pw1[3]=PKW(P0,14), pw1); \
    VRD(2); SBAR(); GAPA(C0=__builtin_amdgcn_mfma_f32_32x32x16_bf16(kf[4],qr[2],C0,0,0,0),   P1[2],P1[3],P1[4],P1[5],     pw2[0]=PKW(P1,0), pw2[1]=PKW(P1,2), pw2); \
    VRD(6); SBAR(); GAPA(C1=__builtin_amdgcn_mfma_f32_32x32x16_bf16(kf[5],qr[2],C1,0,0,0),   P1[6],P1[7],P1[8],P1[9],     pw2[2]=PKW(P1,4), pw2[3]=PKW(P1,6), pw2); \
    VRD(3); SBAR(); GAPA(C0=__builtin_amdgcn_mfma_f32_32x32x16_bf16(kf[6],qr[3],C0,0,0,0),   P1[10],P1[11],P1[12],P1[13], pw3[0]=PKW(P1,8), pw3[1]=PKW(P1,10), pw3); \
    VRD(7); SBAR(); GAPA(C1=__builtin_amdgcn_mfma_f32_32x32x16_bf16(kf[7],qr[3],C1,0,0,0),   P1[14],P1[15],0.f,0.f,       pw3[2]=PKW(P1,12),pw3[3]=PKW(P1,14), pw3); \
    l_reg+=sacc; \
    if(GK){DMA_K((t)+3,sl_cur);} if(GV){DMA_V((t)+1,sl_next);} \
    CMASK(C0,C1,t); \
    { float a=MX3(C0[0],C0[1],C1[0]),b=MX3(C0[2],C0[3],C1[1]); a=MX3(a,C1[2],C1[3]); \
      _Pragma("unroll") for(int r=4;r<16;r+=4){a=MX3(a,C0[r],C0[r+1]);b=MX3(b,C0[r+2],C0[r+3]);a=MX3(a,C1[r],C1[r+1]);b=MX3(b,C1[r+2],C1[r+3]);} \
      float rm=__builtin_fmaxf(a,b); { auto rr=__builtin_amdgcn_permlane32_swap(__float_as_uint(rm),__float_as_uint(rm),false,false); rm=__builtin_fmaxf(__uint_as_float(rr[0]),__uint_as_float(rr[1])); } \
      resc=false; \
      if(__builtin_expect(__any(rm>(float)THRL),0)){ const float dl=__builtin_fmaxf(rm,0.f); mhat+=dl; \
        _Pragma("unroll") for(int r=0;r<16;++r){C0[r]-=dl;C1[r]-=dl;} \
        _Pragma("unroll") for(int r=0;r<16;++r)negm[r]=-mhat; asm volatile("":"+v"(negm)); \
        const float f=__builtin_amdgcn_exp2f(-dl); l_reg*=f; if(hi==0)wsf[r32]=f; resc=true; } } \
    SBAR(); \
    GAPB(o[0]=__builtin_amdgcn_mfma_f32_32x32x16_bf16(PAF(0),VFR(0),o[0],0,0,0), C0,0); \
    GAPB(o[1]=__builtin_amdgcn_mfma_f32_32x32x16_bf16(PAF(0),VFR(4),o[1],0,0,0), C0,4); \
    KRD(GL,0); GAPB(o[0]=__builtin_amdgcn_mfma_f32_32x32x16_bf16(PAF(1),VFR(1),o[0],0,0,0), C0,8); \
    KRD(GL,1); GAPB(o[1]=__builtin_amdgcn_mfma_f32_32x32x16_bf16(PAF(1),VFR(5),o[1],0,0,0), C0,12); \
    KRD(GL,2); GAPB(o[0]=__builtin_amdgcn_mfma_f32_32x32x16_bf16(PAF(2),VFR(2),o[0],0,0,0), C1,0); \
    KRD(GL,3); GAPB(o[1]=__builtin_amdgcn_mfma_f32_32x32x16_bf16(PAF(2),VFR(6),o[1],0,0,0), C1,4); \
    GAPB(o[0]=__builtin_amdgcn_mfma_f32_32x32x16_bf16(PAF(3),VFR(3),o[0],0,0,0), C1,8); \
    GAPB(o[1]=__builtin_amdgcn_mfma_f32_32x32x16_bf16(PAF(3),VFR(7),o[1],0,0,0), C1,12); \
    }while(0)
  int t=1;
  #undef CMASK
  #define CMASK(P0,P1,t) do{}while(0)
  for(;t+5<NT;t+=2){
    STEP(pB0,pB1,pA0,pA1,t,true,true,true);     WAIT_BAR(2); RESC(); ROT();
    STEP(pA0,pA1,pB0,pB1,t+1,true,true,true);   WAIT_BAR(2); RESC(); ROT();
  }
  #undef CMASK
  #define CMASK(P0,P1,t) do{}while(0)
  #define ENDW(tt) do{ if((tt)+3<NT){WAIT_BAR(2);} else if((tt)+2<NT){WAIT_BAR(1);} else {WAIT_BAR(0);} }while(0)
  for(;t+1<NT;t+=2){
    STEP(pB0,pB1,pA0,pA1,t,(t+3<NT),(t+1<NT),(t+1<NT));       ENDW(t);   RESC(); ROT();
    STEP(pA0,pA1,pB0,pB1,t+1,(t+4<NT),(t+2<NT),(t+2<NT));     ENDW(t+1); RESC(); ROT();
  }
  STEP(pB0,pB1,pA0,pA1,NT-1,false,false,false); RESC();
  { float sacc=pB0[0]+pB0[1]; _Pragma("unroll") for(int r=2;r<16;++r)sacc+=pB0[r]; _Pragma("unroll") for(int r=0;r<16;++r)sacc+=pB1[r]; l_reg+=sacc;
    pw0=(u32x4){PKW(pB0,0),PKW(pB0,2),PKW(pB0,4),PKW(pB0,6)};pw1=(u32x4){PKW(pB0,8),PKW(pB0,10),PKW(pB0,12),PKW(pB0,14)};pw2=(u32x4){PKW(pB1,0),PKW(pB1,2),PKW(pB1,4),PKW(pB1,6)};pw3=(u32x4){PKW(pB1,8),PKW(pB1,10),PKW(pB1,12),PKW(pB1,14)};
    SBAR(); pv(o,vb0+sl_cur,PAF(0),PAF(1),PAF(2),PAF(3)); }
  #undef PKW
  #undef PAF
  #undef VFR
  #undef PIN
  #undef MX3
  #undef GAPA
  #undef GAPB
  #undef EX
  #undef VRD
  #undef KRD
  #undef STEP
  #undef ENDW
  {auto rr=__builtin_amdgcn_permlane32_swap(__float_as_uint(l_reg),__float_as_uint(l_reg),false,false);l_reg=__uint_as_float(rr[0])+__uint_as_float(rr[1]);}
  if(hi==0)wsf[32+r32]=l_reg;asm volatile("s_waitcnt lgkmcnt(0)":::"memory");
  float rli[16];
  #pragma unroll
  for(int r=0;r<16;++r)rli[r]=__builtin_amdgcn_rcpf(wsf[32+crow(r,hi)]);
  bf16*Ow=Ob+(long)(wid*QBLK)*OP;
  { bf16*stg=(bf16*)(shm+LDS_OST)+wid*2048;
    #pragma unroll
    for(int r=0;r<16;++r){const int orow=crow(r,hi);
      #pragma unroll
      for(int d0=0;d0<2;++d0)stg[orow*64+d0*32+r32]=__float2bfloat16(o[d0][r]*rli[r]);}
    asm volatile("s_waitcnt lgkmcnt(0)":::"memory");
    #pragma unroll
    for(int i=0;i<4;++i){const int row=i*8+(lane>>3),ch=lane&7; const u32x4 v=*(const u32x4*)(stg+row*64+ch*8); ATTN_STORE16(Ow+(long)row*OP+ch*8,v);} }
  asm volatile("s_waitcnt lgkmcnt(0)\n\ts_barrier":::"memory");
  #undef DMA_K
  #undef DMA_V
  #undef CMASK
  #undef START
  #undef RESC
  #undef ROT
}
constexpr int ATTN_LDS_BYTES=LDS_BYTES;
#undef SBAR
#undef WAIT_BAR
}

#define GAS __attribute__((address_space(1)))
#define LAS __attribute__((address_space(3)))
typedef unsigned short bf16;
typedef unsigned v4u __attribute__((ext_vector_type(4)));
typedef float f32x4 __attribute__((ext_vector_type(4)));
typedef short bf16x8 __attribute__((ext_vector_type(8)));
typedef GAS unsigned gu32;
typedef GAS unsigned long long gu64;
#define RLX_AGENT __ATOMIC_RELAXED, __HIP_MEMORY_SCOPE_AGENT
#define LDS_WAIT() asm volatile("s_waitcnt lgkmcnt(0)" ::: "memory")
#define VM_WAIT() asm volatile("s_waitcnt vmcnt(0)" ::: "memory")
__device__ __forceinline__ unsigned long long rt() { return __builtin_amdgcn_s_memrealtime(); }
__device__ __forceinline__ unsigned f2bf(float f) { unsigned u = __builtin_bit_cast(unsigned, f); return (u + 0x7fffu + ((u >> 16) & 1u)) >> 16; }
__device__ __forceinline__ unsigned pk2(float lo, float hi) { return f2bf(lo) | (f2bf(hi) << 16); }

#define XB_TMO      128
#define XB_XCNT(j)  (256  + 64 * (j))
#define XB_XSUB(j)  (1280 + 64 * (j))
#define XB_XGEN(j)  (2304 + 64 * (j))
#define XB_TOP      3328
#define XB_TOPGEN   3392
#define XCD_BAR_WORDS 3456
#define XB_SPIN_CAP (1u << 18)

__device__ __forceinline__ unsigned xb_ld(unsigned* p)              { return __hip_atomic_load(p, __ATOMIC_RELAXED, __HIP_MEMORY_SCOPE_AGENT); }
__device__ __forceinline__ unsigned xb_add(unsigned* p, unsigned v) { return __hip_atomic_fetch_add(p, v, __ATOMIC_RELAXED, __HIP_MEMORY_SCOPE_AGENT); }
__device__ __forceinline__ unsigned xb_xcc_id() { return (unsigned)__builtin_amdgcn_s_getreg((3 << 11) | 20) & 0xFu; }
#define XB_SPIN(cond, bar) do { unsigned _sp = 0; while (cond) { __builtin_amdgcn_s_sleep(1); \
    if ((++_sp & 255u) == 0u) { if (xb_ld(&(bar)[XB_TMO])) break; if (_sp > XB_SPIN_CAP) { atomicAdd(&(bar)[XB_TMO], 1u); break; } } } } while (0)

struct XcdBarrier {
    unsigned* bar; unsigned x;
    volatile LAS unsigned* st;
};

__device__ __forceinline__ XcdBarrier xcd_barrier_post(unsigned* bar, volatile LAS unsigned* st) {
    XcdBarrier b; b.bar = bar; b.x = xb_xcc_id(); b.st = st;
    if (threadIdx.x == 0) (void)xb_add(&bar[XB_XCNT(b.x)], 1u);
    return b;
}
__device__ __forceinline__ void xcd_barrier_complete(unsigned* bar, unsigned x, unsigned& nloc, unsigned& nx) {
    const unsigned G = gridDim.x * gridDim.y * gridDim.z;
    unsigned sum, cnt, mine, sp = 0u;
    for (;;) {
        sum = 0u; cnt = 0u; mine = 0u;
#pragma unroll
        for (unsigned j = 0; j < 16; ++j) { const unsigned c = xb_ld(&bar[XB_XCNT(j)]); sum += c; cnt += (c > 0u) ? 1u : 0u; mine = (j == x) ? c : mine; }
        if (sum == G) break;
        __builtin_amdgcn_s_sleep(1);
        if ((++sp & 255u) == 0u) { if (xb_ld(&bar[XB_TMO])) break; if (sp > XB_SPIN_CAP) { atomicAdd(&bar[XB_TMO], 1u); break; } }
    }
    nloc = mine > 0u ? mine : 1u; nx = cnt > 0u ? cnt : 1u;
}

__device__ __forceinline__ void xcd_barrier(const XcdBarrier& b) {
    asm volatile("s_waitcnt vmcnt(0)" ::: "memory");
    __syncthreads();
    if (threadIdx.x == 0) {
        unsigned* bar = b.bar;
        __builtin_amdgcn_s_waitcnt(0);
        unsigned nloc = b.st[0], nx = b.st[1];
        if (nloc == 0u) { xcd_barrier_complete(bar, b.x, nloc, nx); b.st[0] = nloc; b.st[1] = nx; }
        const unsigned old = xb_add(&bar[XB_XSUB(b.x)], 1u);
        const unsigned gen = old / nloc;
        if (old + 1u == (gen + 1u) * nloc) {
            __builtin_amdgcn_fence(__ATOMIC_RELEASE, "agent");
            asm volatile("s_waitcnt vmcnt(0)" ::: "memory");
            const unsigned og = xb_add(&bar[XB_TOP], 1u);
            const unsigned tg = og / nx;
            if (og + 1u == (tg + 1u) * nx) xb_add(&bar[XB_TOPGEN], 1u);
            else XB_SPIN(xb_ld(&bar[XB_TOPGEN]) == tg, bar);
            __builtin_amdgcn_fence(__ATOMIC_ACQUIRE, "agent");
            xb_add(&bar[XB_XGEN(b.x)], 1u);
            asm volatile("s_waitcnt vmcnt(0)" ::: "memory");
        } else {
            XB_SPIN(xb_ld(&bar[XB_XGEN(b.x)]) == gen, bar);
            __builtin_amdgcn_fence(__ATOMIC_ACQUIRE, "agent");
            asm volatile("s_waitcnt vmcnt(0)" ::: "memory");
        }
    }
    __syncthreads();
}

constexpr int NWAVES = 8;
constexpr int N_LAUNCHES = MK_N_LAUNCHES;
constexpr int N_PHASES = 17;
typedef unsigned u32x2 __attribute__((ext_vector_type(2)));
typedef float f32x2v __attribute__((ext_vector_type(2)));

struct Frame {
    unsigned char* lds;
    LAS unsigned char* ldsl;
    volatile LAS unsigned* MISC;
    gu32* ctl;
    int tid, lane, wave, vcu, G;
    unsigned char* ws; float* out;
};
struct Args { const float* in[25]; float* out; unsigned char* ws; int ph_lo, ph_hi, li, pad; };
#define F_x_prompt (A.in[0])
#define F_x_sample (A.in[1])
#define F_cache_k (A.in[2])
#define F_cache_v (A.in[3])
#define F_state_C (A.in[4])
#define F_state_n (A.in[5])
#define F_state_m (A.in[6])
#define F_c (A.in[7])
#define F_c_ctx (A.in[8])
#define F_w_ada (A.in[9])
#define F_b_ada (A.in[10])
#define F_norm1_g (A.in[11])
#define F_w_in (A.in[12])
#define F_q_norm_g (A.in[13])
#define F_k_norm_g (A.in[14])
#define F_m_conv_w (A.in[15])
#define F_m_gate_b (A.in[16])
#define F_m_norm_g (A.in[17])
#define F_w_pa (A.in[18])
#define F_w_pm (A.in[19])
#define F_w_pf (A.in[20])
#define F_w_out (A.in[21])
#define F_norm2_g (A.in[22])
#define F_w_f1 (A.in[23])
#define F_w_f2 (A.in[24])
#define F_out (F.out)
#define WSP(T, off) ((T*)(F.ws + (off)))

__device__ __forceinline__ float wave_sum(float v) {
#pragma unroll
    for (int o = 1; o < 64; o <<= 1) v += __shfl_xor(v, o);
    return v;
}
__device__ __forceinline__ float bf2f(unsigned short h) { return __builtin_bit_cast(float, (unsigned)h << 16); }
__device__ __forceinline__ float silu_f(float y) { return y / (1.0f + __expf(-y)); }

__device__ __forceinline__ void transpose_item(const float* W, int ldw, int k0, int c0, bf16* WT, int dpitch, int drow0, int dk0, float* scr, int lane) {
#pragma unroll 8
    for (int i = 0; i < 32; ++i) { const int kk = 2 * i + (lane >> 5); scr[kk * 33 + (lane & 31)] = W[(size_t)(k0 + kk) * ldw + c0 + (lane & 31)]; }
    LDS_WAIT(); asm volatile("" ::: "memory");
    const int c = lane & 7;
#pragma unroll
    for (int j = 0; j < 4; ++j) { const int n = (lane >> 3) + 8 * j; const float* s = scr + (8 * c) * 33 + n;
        v4u o; o.x = pk2(s[0 * 33], s[1 * 33]); o.y = pk2(s[2 * 33], s[3 * 33]); o.z = pk2(s[4 * 33], s[5 * 33]); o.w = pk2(s[6 * 33], s[7 * 33]);
        *(v4u*)(WT + (size_t)(drow0 + n) * dpitch + dk0 + 8 * c) = o; }
    LDS_WAIT(); asm volatile("" ::: "memory");
}
__device__ __forceinline__ int win_src_col(int tile, int g) {
    if (tile <= 3) return tile * 256 + 64 * (g & 3) + 32 * (g >> 2);
    if (tile <= 7) return 1024 + (tile - 4) * 256 + 32 * g;
    if (tile == 8) return 2064 + 32 * g;
    return 2320 + (tile - 9) * 256 + 32 * g;
}
__device__ __forceinline__ void convert_weights(Frame& F, const Args& A, int l) {
    float* scr = (float*)(F.lds + RING_OFF + F.wave * 16384);
    float* trig = scr + 64 * 33;
    trig[F.lane] = cosf(6.283185307179586f * (float)F.lane / 64.0f); trig[64 + F.lane] = sinf(6.283185307179586f * (float)F.lane / 64.0f);
    LDS_WAIT(); asm volatile("" ::: "memory");
    const int gw = F.vcu * NWAVES + F.wave, NGW = F.G * NWAVES;
    const float* w_in = F_w_in + (size_t)l * DM * INC; const float* w_pa = F_w_pa + (size_t)l * 512 * DM; const float* w_pm = F_w_pm + (size_t)l * 256 * DM;
    const float* w_pf = F_w_pf + (size_t)l * 256 * DM; const float* w_out = F_w_out + (size_t)l * DM * DM; const float* w_f1 = F_w_f1 + (size_t)l * DM * NF1; const float* w_f2 = F_w_f2 + (size_t)l * FF * DM;
    bf16* WIN = WSP(bf16, WS_WIN); bf16* WMRG = WSP(bf16, WS_WMRG); bf16* WOUT = WSP(bf16, WS_WOUT); bf16* WF1 = WSP(bf16, WS_WF1); bf16* WF2 = WSP(bf16, WS_WF2);
    constexpr int I1 = 168 * 16, I2 = 32 * 8, I3 = 32 * 4, I4 = 512, I5 = 32 * 16, I6 = 176 * 16, I7 = 32 * 44;
    constexpr int NITEMS = I1 + I2 + I3 + I4 + I5 + I6 + I7;
    for (int it = gw; it < NITEMS; it += NGW) {
        int r = it;
        if (r < I1) { const int dg = r >> 4, kb = r & 15; transpose_item(w_in, INC, 64 * kb, win_src_col(dg >> 3, dg & 7), WIN, DM, 32 * dg, 64 * kb, scr, F.lane); continue; } r -= I1;
        if (r < I2) { const int cg = r >> 3, kb = r & 7; transpose_item(w_pa, DM, 64 * kb, 32 * cg, WMRG, KMRG, 32 * cg, 64 * kb, scr, F.lane); continue; } r -= I2;
        if (r < I3) { const int cg = r >> 2, kb = r & 3; transpose_item(w_pm, DM, 64 * kb, 32 * cg, WMRG, KMRG, 32 * cg, 512 + 64 * kb, scr, F.lane); continue; } r -= I3;
        if (r < I4) {
            const int g = r >> 7, nb = (r >> 3) & 15, cb = r & 7; const int n = 64 * nb + F.lane;
            float pc[8], ps[8];
#pragma unroll
            for (int cc = 0; cc < 8; ++cc) { pc[cc] = 0.f; ps[cc] = 0.f; }
            for (int cp = 0; cp < 64; ++cp) { const float w = w_pf[(size_t)(g * 64 + cp) * DM + n];
#pragma unroll
                for (int cc = 0; cc < 8; ++cc) { const int j = ((8 * cb + cc) * cp) & 63; pc[cc] += trig[j] * w; ps[cc] -= trig[64 + j] * w; } }
            v4u oc, os; oc.x = pk2(pc[0] * 0.125f, pc[1] * 0.125f); oc.y = pk2(pc[2] * 0.125f, pc[3] * 0.125f); oc.z = pk2(pc[4] * 0.125f, pc[5] * 0.125f); oc.w = pk2(pc[6] * 0.125f, pc[7] * 0.125f);
            os.x = pk2(ps[0] * 0.125f, ps[1] * 0.125f); os.y = pk2(ps[2] * 0.125f, ps[3] * 0.125f); os.z = pk2(ps[4] * 0.125f, ps[5] * 0.125f); os.w = pk2(ps[6] * 0.125f, ps[7] * 0.125f);
            *(v4u*)(WMRG + (size_t)n * KMRG + 768 + g * 64 + 8 * cb) = oc; *(v4u*)(WMRG + (size_t)n * KMRG + 1024 + g * 64 + 8 * cb) = os;
            continue; } r -= I4;
        if (r < I5) { const int cg = r >> 4, kb = r & 15; transpose_item(w_out, DM, 64 * kb, 32 * cg, WOUT, DM, 32 * cg, 64 * kb, scr, F.lane); continue; } r -= I5;
        if (r < I6) { const int dg = r >> 4, kb = r & 15, tile = dg >> 3, g = dg & 7; const int c0 = g < 4 ? 128 * tile + 32 * g : FF + 128 * tile + 32 * (g - 4);
            transpose_item(w_f1, NF1, 64 * kb, c0, WF1, DM, 32 * dg, 64 * kb, scr, F.lane); continue; } r -= I6;
        { const int cg = r / 44, kb = r % 44; transpose_item(w_f2, DM, 64 * kb, 32 * cg, WF2, FF, 32 * cg, 64 * kb, scr, F.lane); }
    }
}

__device__ __forceinline__ void p0_prologue(Frame& F, const Args& A) {
    const int gw = F.vcu * NWAVES + F.wave, NGW = F.G * NWAVES;
    float* MOD = WSP(float, WS_MOD);
    { f32x4* red = (f32x4*)(F.lds + RING_OFF);
      for (int it = F.vcu; it < 2 * 24; it += F.G) {
        const int cg = it % 24, l = it / 24; const int col = 256 * cg + 4 * F.lane;
        f32x4 acc[9];
#pragma unroll
        for (int v = 0; v < 9; ++v) acc[v] = (f32x4){0.f, 0.f, 0.f, 0.f};
        const float* wa = F_w_ada + ((size_t)l * DM + 128 * F.wave) * 6144 + col;
        for (int k = 0; k < 128; ++k) { const f32x4 w4 = *(const f32x4*)(wa + (size_t)k * 6144); const int kk = 128 * F.wave + k;
            acc[0] = acc[0] + w4 * silu_f(F_c_ctx[kk]);
#pragma unroll
            for (int v = 1; v < 9; ++v) acc[v] = acc[v] + w4 * silu_f(F_c[(v - 1) * DM + kk]); }
#pragma unroll
        for (int v = 0; v < 9; ++v) red[(F.wave * 9 + v) * 64 + F.lane] = acc[v];
        __syncthreads();
        for (int o = F.tid; o < 9 * 64; o += NWAVES * 64) { const int v = o >> 6, ln = o & 63; f32x4 s = *(const f32x4*)(F_b_ada + (size_t)l * 6144 + 256 * cg + 4 * ln);
#pragma unroll
            for (int w = 0; w < 8; ++w) s = s + red[(w * 9 + v) * 64 + ln];
            *(f32x4*)(MOD + ((size_t)l * 9 + v) * 6144 + 256 * cg + 4 * ln) = s; }
        __syncthreads();
      } }
    { bf16* DL = WSP(bf16, WS_DFTL); const int gt = (F.vcu * NWAVES + F.wave) * 64 + F.lane, NT_ = F.G * NWAVES * 64;
      for (int i = gt; i < 2048 * 128; i += NT_) { const int r = i >> 7, t0 = (i & 127) * 8; const int rr = r & 1023; float vv[8];
#pragma unroll
          for (int j = 0; j < 8; ++j) { const int ph = (rr * (t0 + j)) & 1023; const float a = 6.283185307179586f * (float)ph * (1.0f / 1024.0f); vv[j] = (r < 1024 ? cosf(a) : sinf(a)) * (1.0f / 32.0f); }
          v4u o; o.x = pk2(vv[0], vv[1]); o.y = pk2(vv[2], vv[3]); o.z = pk2(vv[4], vv[5]); o.w = pk2(vv[6], vv[7]); *(v4u*)(DL + (size_t)r * 1024 + t0) = o; }
      bf16* DC = WSP(bf16, WS_DFTC);
      for (int i = gt; i < 512 * 32; i += NT_) { const int r = i >> 5, t0 = (i & 31) * 8; const int rr = r & 255; float vv[8];
#pragma unroll
          for (int j = 0; j < 8; ++j) { const int ph = (rr * (t0 + j)) & 255; const float a = 6.283185307179586f * (float)ph * (1.0f / 256.0f); vv[j] = (r < 256 ? cosf(a) : sinf(a)) * (1.0f / 16.0f); }
          v4u o; o.x = pk2(vv[0], vv[1]); o.y = pk2(vv[2], vv[3]); o.z = pk2(vv[4], vv[5]); o.w = pk2(vv[6], vv[7]); *(v4u*)(DC + (size_t)r * 256 + t0) = o; }
      f32x2v* RP = WSP(f32x2v, WS_ROPE);
      for (int i = gt; i < 64 * 16; i += NT_) { const int pos = i >> 4, fi = i & 15; const float inv = 1.0f / powf(10000.0f, (float)fi / 16.0f); const float a = (float)pos * inv; RP[i] = (f32x2v){cosf(a), sinf(a)}; }
    }
    convert_weights(F, A, 0);
}

__device__ __forceinline__ void norm_phase(Frame& F, const Args& A, int l, int which) {
    const int gw = F.vcu * NWAVES + F.wave, NGW = F.G * NWAVES;
    const float* MOD = WSP(float, WS_MOD) + (size_t)l * 9 * 6144;
    bf16* XN = WSP(bf16, WS_XN);
    float* wgl = (float*)(F.lds + RING_OFF);
    if (which == 0) {
        if (l > 0) { convert_weights(F, A, l); __syncthreads(); }
        const float* w_in = F_w_in + (size_t)l * DM * INC;
        for (int i = F.tid; i < 16 * 1024; i += NWAVES * 64) { const int k = i >> 4, g = i & 15; wgl[g * 1024 + k] = w_in[(size_t)k * INC + 2048 + g]; }
        { bf16* KL = WSP(bf16, WS_KL); bf16* VL = WSP(bf16, WS_VL); const int gt = gw * 64 + F.lane, NT_ = NGW * 64;
          for (int i = gt; i < 2 * 8 * 8192; i += NT_) { const int kv = i >= 8 * 8192, r = i - kv * 8 * 8192, b = r >> 13, e = (r & 8191) * 8;
              const float* src = (kv ? F_cache_v : F_cache_k) + ((size_t)(b * 2 + l)) * 65536 + e; const f32x4 a = *(const f32x4*)src, c4 = *(const f32x4*)(src + 4);
              v4u o; o.x = pk2(a[0], a[1]); o.y = pk2(a[2], a[3]); o.z = pk2(c4[0], c4[1]); o.w = pk2(c4[2], c4[3]);
              *(v4u*)((kv ? VL : KL) + (size_t)b * 1280 * 256 + e) = o; } }
        __syncthreads();
    }
    const float* ng = (which == 0 ? F_norm1_g : F_norm2_g) + (size_t)l * DM;
    const int o_sh = which == 0 ? 0 : 3072, o_sc = which == 0 ? 1024 : 4096;
    float* GATES = WSP(float, WS_GATES);
    for (int m = gw; m < MTOT; m += NGW) {
        const float* xrow = (l == 0 && which == 0) ? (m < MC ? F_x_prompt + (size_t)m * DM : F_x_sample + (size_t)(m - MC) * DM) : F_out + (size_t)m * DM;
        const int v = m < MC ? 0 : 1 + ((m - MC) >> 10);
        const float* mv = MOD + (size_t)v * 6144;
        f32x4 x[4]; float s = 0.f;
#pragma unroll
        for (int j = 0; j < 4; ++j) { x[j] = *(const f32x4*)(xrow + 4 * F.lane + 256 * j); s += (x[j][0] * x[j][0] + x[j][1] * x[j][1]) + (x[j][2] * x[j][2] + x[j][3] * x[j][3]); }
        const float rs = 1.0f / sqrtf(wave_sum(s) * (1.0f / DM) + RMS_EPS);
#pragma unroll
        for (int j = 0; j < 4; ++j) { const int c = 4 * F.lane + 256 * j; const f32x4 g = *(const f32x4*)(ng + c), sc = *(const f32x4*)(mv + o_sc + c), sh = *(const f32x4*)(mv + o_sh + c);
            x[j] = x[j] * rs * g * (sc + 1.0f) + sh;
            u32x2 w; w.x = pk2(x[j][0], x[j][1]); w.y = pk2(x[j][2], x[j][3]); *(u32x2*)(XN + (size_t)m * DM + c) = w; }
        if (which == 0) {
            float a16[16];
#pragma unroll
            for (int g = 0; g < 16; ++g) { float a = 0.f;
                asm volatile("" ::: "memory");
#pragma unroll
                for (int j = 0; j < 4; ++j) { const f32x4 w4 = *(const f32x4*)(wgl + g * 1024 + 4 * F.lane + 256 * j); a += (x[j][0] * w4[0] + x[j][1] * w4[1]) + (x[j][2] * w4[2] + x[j][3] * w4[3]); }
                a16[g] = a; }
            float a8[8], a4[4], a2[2], a1;
            { const bool hi = F.lane & 1;
#pragma unroll
              for (int i = 0; i < 8; ++i) { const float keep = hi ? a16[8 + i] : a16[i], send = hi ? a16[i] : a16[8 + i]; a8[i] = keep + __shfl_xor(send, 1); } }
            { const bool hi = F.lane & 2;
#pragma unroll
              for (int i = 0; i < 4; ++i) { const float keep = hi ? a8[4 + i] : a8[i], send = hi ? a8[i] : a8[4 + i]; a4[i] = keep + __shfl_xor(send, 2); } }
            { const bool hi = F.lane & 4;
#pragma unroll
              for (int i = 0; i < 2; ++i) { const float keep = hi ? a4[2 + i] : a4[i], send = hi ? a4[i] : a4[2 + i]; a2[i] = keep + __shfl_xor(send, 4); } }
            { const bool hi = F.lane & 8; const float keep = hi ? a2[1] : a2[0], send = hi ? a2[0] : a2[1]; a1 = keep + __shfl_xor(send, 8); }
            a1 += __shfl_xor(a1, 16); a1 += __shfl_xor(a1, 32);
            if (F.lane < 16) { const int g = 8 * (F.lane & 1) + 4 * ((F.lane >> 1) & 1) + 2 * ((F.lane >> 2) & 1) + ((F.lane >> 3) & 1); GATES[(size_t)m * 16 + g] = a1; }
        }
    }
}

constexpr int L_AU = 0, L_AR = 8192, L_AWI = 16384, L_AEMJ = 24576, L_AWK = 32768, L_CH = 40960, L_NST = 41984, L_IV = 50176, L_SL = 52224, SL_PITCH = 72;
static_assert(L_SL + 8 * 64 * SL_PITCH * 2 <= RING_BYTES, "mLSTM LDS map");
typedef float f32x4m __attribute__((ext_vector_type(4)));
__device__ __forceinline__ f32x4 mfma16(bf16x8 a, bf16x8 b, f32x4 c) { return __builtin_amdgcn_mfma_f32_16x16x32_bf16(a, b, c, 0, 0, 0); }
__device__ __forceinline__ bf16x8 pack8(const float (&v)[8]) { v4u o; o.x = pk2(v[0], v[1]); o.y = pk2(v[2], v[3]); o.z = pk2(v[4], v[5]); o.w = pk2(v[6], v[7]); return __builtin_bit_cast(bf16x8, o); }
__device__ __forceinline__ void unpack8(bf16x8 p, float (&v)[8]) { const v4u o = __builtin_bit_cast(v4u, p);
    v[0] = __builtin_bit_cast(float, o.x << 16); v[1] = __builtin_bit_cast(float, o.x & 0xffff0000u); v[2] = __builtin_bit_cast(float, o.y << 16); v[3] = __builtin_bit_cast(float, o.y & 0xffff0000u);
    v[4] = __builtin_bit_cast(float, o.z << 16); v[5] = __builtin_bit_cast(float, o.z & 0xffff0000u); v[6] = __builtin_bit_cast(float, o.w << 16); v[7] = __builtin_bit_cast(float, o.w & 0xffff0000u); }
__device__ __forceinline__ bf16x8 conv8_nat(bf16x8 xm, bf16x8 x0, bf16x8 xp, const float* cw, float post) {
    float a[8], b[8], c[8], o[8]; unpack8(xm, a); unpack8(x0, b); unpack8(xp, c);
    const f32x4 w0a = *(const f32x4*)(cw), w0b = *(const f32x4*)(cw + 4), w1a = *(const f32x4*)(cw + 512), w1b = *(const f32x4*)(cw + 516), w2a = *(const f32x4*)(cw + 1024), w2b = *(const f32x4*)(cw + 1028);
#pragma unroll
    for (int j = 0; j < 8; ++j) { const float w0 = j < 4 ? w0a[j & 3] : w0b[j & 3], w1 = j < 4 ? w1a[j & 3] : w1b[j & 3], w2 = j < 4 ? w2a[j & 3] : w2b[j & 3];
        o[j] = silu_f(w0 * a[j] + w1 * b[j] + w2 * c[j]) * post; }
    return pack8(o);
}
template <int MASK> __device__ __forceinline__ float swz_xor(float v) { return __shfl_xor(v, MASK); }
__device__ __forceinline__ float sum_xor32(float v) { auto rr = __builtin_amdgcn_permlane32_swap(__builtin_bit_cast(unsigned, v), __builtin_bit_cast(unsigned, v), false, false); return __builtin_bit_cast(float, rr[0]) + __builtin_bit_cast(float, rr[1]); }
__device__ __forceinline__ float sum_kq(float v) { v += __shfl_xor(v, 16); v += __shfl_xor(v, 32); return v; }
__device__ __forceinline__ float sum_r16(float v) { v += swz_xor<1>(v); v += swz_xor<2>(v); v += swz_xor<4>(v); v += swz_xor<8>(v); return v; }
__device__ __forceinline__ float logsigmoid_f(float x) { return fminf(x, 0.f) - log1pf(__expf(-fabsf(x))); }

__device__ __forceinline__ void mlstm_unit(Frame& F, const Args& A, int l, int b, int h, bool ctx) {
    const int T = ctx ? 256 : 1024, nc = T >> 6;
    const size_t R0 = ctx ? (size_t)b * 256 : (size_t)MC + (size_t)b * 1024;
    const size_t tbase = ctx ? (size_t)b * 65536 : (size_t)16 * 65536 + (size_t)b * 262144;
    int tid = F.tid; asm volatile("" : "+v"(tid)); const int lane = tid & 63, wave = __builtin_amdgcn_readfirstlane(tid >> 6);
    float* AU = (float*)(F.lds + L_AU); float* AR = (float*)(F.lds + L_AR); float* AWI = (float*)(F.lds + L_AWI); float* AEMJ = (float*)(F.lds + L_AEMJ); float* AWK = (float*)(F.lds + L_AWK);
    float* CBL = (float*)(F.lds + L_CH); float* CA = CBL + 32; float* CMS = CBL + 64; float* CMN = CBL + 96; float* CDEC = CBL + 128;
    float* NST = (float*)(F.lds + L_NST); float* IV = (float*)(F.lds + L_IV) + wave * 64; bf16* SL = (bf16*)(F.lds + L_SL) + wave * 64 * SL_PITCH;
    const float* GATES = WSP(float, WS_GATES); const float* gb = F_m_gate_b + l * 16; const float* cwl = F_m_conv_w + (size_t)l * 3 * 512;
    const bf16* QM = WSP(bf16, WS_QM); const bf16* KM = WSP(bf16, WS_KM); const bf16* KMT = WSP(bf16, WS_KMT) + tbase; const bf16* VT = WSP(bf16, WS_VT) + tbase; const bf16* OM = WSP(bf16, WS_OM);
    bf16* QN = WSP(bf16, WS_QN); bf16* KN = WSP(bf16, WS_KN); bf16* KNT = WSP(bf16, WS_KNT) + tbase;
    bf16* CT = WSP(bf16, WS_CT); float* HF = WSP(float, WS_HF); bf16* AC = WSP(bf16, WS_ACAT);
    { const bf16x8 z8 = {0, 0, 0, 0, 0, 0, 0, 0};
      for (int i = tid; i < T * 8; i += NWAVES * 64) { const int t = i >> 3, col = h * 64 + 8 * (i & 7); const size_t off = (R0 + t) * 256 + col;
          { const bf16x8 x0 = *(const bf16x8*)(QM + off); const bf16x8 xm = t > 0 ? *(const bf16x8*)(QM + off - 256) : z8; const bf16x8 xp = t + 1 < T ? *(const bf16x8*)(QM + off + 256) : z8;
            *(bf16x8*)(QN + off) = conv8_nat(xm, x0, xp, cwl + col, 1.0f); }
          { const bf16x8 x0 = *(const bf16x8*)(KM + off); const bf16x8 xm = t > 0 ? *(const bf16x8*)(KM + off - 256) : z8; const bf16x8 xp = t + 1 < T ? *(const bf16x8*)(KM + off + 256) : z8;
            *(bf16x8*)(KN + off) = conv8_nat(xm, x0, xp, cwl + 256 + col, 0.125f); } }
      for (int i = tid; i < T * 8; i += NWAVES * 64) { const int dd = i / (T >> 3), t0 = (i % (T >> 3)) * 8; const bf16* kr = KMT + (size_t)(h * 64 + dd) * T;
          const float cw0 = cwl[256 + h * 64 + dd], cw1 = cwl[512 + 256 + h * 64 + dd], cw2 = cwl[1024 + 256 + h * 64 + dd];
          float x[10]; { float xx[8]; unpack8(*(const bf16x8*)(kr + t0), xx);
#pragma unroll
              for (int j = 0; j < 8; ++j) x[j + 1] = xx[j]; }
          x[0] = t0 > 0 ? bf2f(kr[t0 - 1]) : 0.f; x[9] = t0 + 8 < T ? bf2f(kr[t0 + 8]) : 0.f;
          float o[8];
#pragma unroll
          for (int j = 0; j < 8; ++j) o[j] = silu_f(cw0 * x[j] + cw1 * x[j + 1] + cw2 * x[j + 2]) * 0.125f;
          *(bf16x8*)(KNT + (size_t)(h * 64 + dd) * T + t0) = pack8(o); }
    }
    for (int it = wave; it < 2 * nc; it += NWAVES) {
        const int d = it >= nc, oc = it - d * nc, t = 64 * oc + lane; const float* gp = GATES + (R0 + t) * 16 + d * 8 + h;
        const float li = gp[0] + gb[d * 8 + h]; const float lf = logsigmoid_f(gp[4] + gb[d * 8 + 4 + h]);
        float bs = lf;
#pragma unroll
        for (int off = 1; off < 64; off <<= 1) { const float o = d ? __shfl_down(bs, off) : __shfl_up(bs, off); const bool ok = d ? (lane + off < 64) : (lane >= off); if (ok) bs += o; }
        const float r = li - bs; float pm = r;
#pragma unroll
        for (int off = 1; off < 64; off <<= 1) { const float o = d ? __shfl_down(pm, off) : __shfl_up(pm, off); const bool ok = d ? (lane + off < 64) : (lane >= off); if (ok) pm = fmaxf(pm, o); }
        const float bl = __shfl(bs, d ? 0 : 63), rmax = __shfl(pm, d ? 0 : 63);
        AU[d * 1024 + t] = bs; AR[d * 1024 + t] = r; AWI[d * 1024 + t] = pm;
        if (lane == 0) { CBL[d * 16 + oc] = bl; CA[d * 16 + oc] = bl + rmax; }
    }
    __syncthreads();
    if (tid < 2) { const int d = tid; float m = ctx ? 0.f : F_state_m[((b * 2 + l) * 2 + d) * 4 + h];
        for (int k = 0; k < nc; ++k) { const int oc = d ? nc - 1 - k : k; const float bl = CBL[d * 16 + oc]; CMS[d * 16 + oc] = m; const float mn = fmaxf(bl + m, CA[d * 16 + oc]);
            CDEC[d * 16 + oc] = __expf(bl + m - mn); CMN[d * 16 + oc] = mn; m = mn; }
        if (ctx) F_out[OFF_NM + ((b * 2 + l) * 2 + d) * 4 + h] = m; }
    __syncthreads();
    for (int i = tid; i < 2 * T; i += NWAVES * 64) { const int d = i >= T, t = i - d * T, oc = t >> 6, ix = d * 1024 + t;
        const float bs = AU[ix], r = AR[ix], pm = AWI[ix], ms = CMS[d * 16 + oc]; const float mj = bs + fmaxf(ms, pm);
        AU[ix] = (bs - mj) * LOG2E; AR[ix] = r * LOG2E; AWI[ix] = __expf(bs + ms - mj); AEMJ[ix] = __expf(-mj); AWK[ix] = __expf(CBL[d * 16 + oc] + r - CMN[d * 16 + oc]); }
    __syncthreads();
    {
        int r16 = lane & 15, kq = lane >> 4; asm volatile("" : "+v"(r16), "+v"(kq));
        const int d = wave >> 2, wq = wave & 3, dk = 16 * wq + r16;
        f32x4 C[4]; float nval;
        if (ctx) {
#pragma unroll
            for (int nt = 0; nt < 4; ++nt) C[nt] = (f32x4){0.f, 0.f, 0.f, 0.f};
            nval = 0.f;
        } else {
            const float* sc = F_state_C + (size_t)(((b * 2 + l) * 2 + d) * 4 + h) * 4096;
#pragma unroll
            for (int nt = 0; nt < 4; ++nt)
#pragma unroll
                for (int rg = 0; rg < 4; ++rg) C[nt][rg] = sc[(16 * wq + 4 * kq + rg) * 64 + 16 * nt + r16];
            nval = F_state_n[(size_t)(((b * 2 + l) * 2 + d) * 4 + h) * 64 + dk];
        }
        const bf16* krow = KNT + (size_t)(h * 64 + dk) * T;
        for (int k = 0; k < nc; ++k) {
            const int oc = d ? nc - 1 - k : k;
            bf16* cts = CT + ((((R0 >> 6) + oc) * 4 + h) * 2 + d) * 4096;
#pragma unroll
            for (int nt = 0; nt < 4; ++nt) { u32x2 w; w.x = pk2(C[nt][0], C[nt][1]); w.y = pk2(C[nt][2], C[nt][3]); *(u32x2*)(cts + (16 * nt + r16) * 64 + 16 * wq + 4 * kq) = w; }
            if (kq == 0) NST[(d * 16 + oc) * 64 + dk] = nval;
            const float dec = CDEC[d * 16 + oc];
#pragma unroll
            for (int nt = 0; nt < 4; ++nt) C[nt] = C[nt] * dec;
            nval *= dec; float rsum = 0.f;
#pragma unroll
            for (int ks = 0; ks < 2; ++ks) {
                const int t0 = 64 * oc + 32 * ks + 8 * kq;
                float kt[8]; unpack8(*(const bf16x8*)(krow + t0), kt);
                const f32x4 wk0 = *(const f32x4*)(AWK + d * 1024 + t0), wk1 = *(const f32x4*)(AWK + d * 1024 + t0 + 4);
#pragma unroll
                for (int j = 0; j < 8; ++j) { kt[j] *= (j < 4 ? wk0[j & 3] : wk1[j & 3]); rsum += kt[j]; }
                const bf16x8 af = pack8(kt);
#pragma unroll
                for (int nt = 0; nt < 4; ++nt) { const bf16x8 bfr = *(const bf16x8*)(VT + (size_t)(h * 64 + 16 * nt + r16) * T + t0); C[nt] = mfma16(af, bfr, C[nt]); }
            }
            rsum = sum_kq(rsum); nval += rsum;
        }
        if (ctx) {
            float* oc_ = F_out + OFF_NC + (size_t)(((b * 2 + l) * 2 + d) * 4 + h) * 4096;
#pragma unroll
            for (int nt = 0; nt < 4; ++nt)
#pragma unroll
                for (int rg = 0; rg < 4; ++rg) oc_[(16 * wq + 4 * kq + rg) * 64 + 16 * nt + r16] = C[nt][rg];
            if (kq == 0) F_out[OFF_NN + (size_t)(((b * 2 + l) * 2 + d) * 4 + h) * 64 + dk] = nval;
        }
    }
    __syncthreads();
    for (int d = 0; d < 2; ++d) {
        for (int oc = wave; oc < nc; oc += NWAVES) {
            const int tq = 64 * oc;
            int r16 = lane & 15, kq = lane >> 4; asm volatile("" : "+v"(r16), "+v"(kq));
            bf16x8 Qf[4][2];
#pragma unroll
            for (int mt = 0; mt < 4; ++mt) {
                asm volatile("" ::: "memory");
#pragma unroll
                for (int ks = 0; ks < 2; ++ks) { const int t = tq + 16 * mt + r16, col = h * 64 + 32 * ks + 8 * kq; Qf[mt][ks] = *(const bf16x8*)(QN + (R0 + t) * 256 + col); } }
            float ul[4], wil[4], rowsum[4];
#pragma unroll
            for (int lt = 0; lt < 4; ++lt) { ul[lt] = AU[d * 1024 + tq + 16 * lt + r16]; wil[lt] = AWI[d * 1024 + tq + 16 * lt + r16]; rowsum[lt] = 0.f; }
#pragma unroll
            for (int st = 0; st < 4; ++st) {
                asm volatile("" ::: "memory");
                bf16x8 Kf[2];
#pragma unroll
                for (int ks = 0; ks < 2; ++ks) { const int t = tq + 16 * st + r16, col = h * 64 + 32 * ks + 8 * kq; Kf[ks] = *(const bf16x8*)(KN + (R0 + t) * 256 + col); }
                const f32x4 rs4 = *(const f32x4*)(AR + d * 1024 + tq + 16 * st + 4 * kq);
#pragma unroll
                for (int lt = 0; lt < 4; ++lt) {
                    const bool live = d ? (st >= lt) : (st <= lt);
                    u32x2 w; w.x = 0u; w.y = 0u;
                    if (live) {
                        f32x4 sacc = (f32x4){0.f, 0.f, 0.f, 0.f};
                        sacc = mfma16(Kf[0], Qf[lt][0], sacc); sacc = mfma16(Kf[1], Qf[lt][1], sacc);
                        f32x4 val;
#pragma unroll
                        for (int rg = 0; rg < 4; ++rg) { const int sl = 16 * st + 4 * kq + rg, ll = 16 * lt + r16; const bool ok = d ? (sl >= ll) : (sl <= ll);
                            val[rg] = ok ? sacc[rg] * __builtin_amdgcn_exp2f(ul[lt] + rs4[rg]) : 0.f; }
                        rowsum[lt] += (val[0] + val[1]) + (val[2] + val[3]);
                        w.x = pk2(val[0], val[1]); w.y = pk2(val[2], val[3]);
                    }
                    *(u32x2*)(SL + (16 * lt + r16) * SL_PITCH + 16 * st + 4 * kq) = w;
                }
            }
            asm volatile("" ::: "memory");
            const float* nst = NST + (d * 16 + oc) * 64;
            float inv[4];
#pragma unroll
            for (int mt = 0; mt < 4; ++mt) { float qn = 0.f;
#pragma unroll
                for (int ks = 0; ks < 2; ++ks) { float q8[8]; unpack8(Qf[mt][ks], q8); const f32x4 n0 = *(const f32x4*)(nst + 32 * ks + 8 * kq), n1 = *(const f32x4*)(nst + 32 * ks + 8 * kq + 4);
#pragma unroll
                    for (int j = 0; j < 8; ++j) qn += q8[j] * (j < 4 ? n0[j & 3] : n1[j & 3]); }
                float a = sum_kq(rowsum[mt] + wil[mt] * qn);
                inv[mt] = 1.0f / fmaxf(fabsf(a), AEMJ[d * 1024 + tq + 16 * mt + r16]);
                if (kq == 0) IV[16 * mt + r16] = inv[mt]; }
            const bf16* cts = CT + ((((R0 >> 6) + oc) * 4 + h) * 2 + d) * 4096;
            f32x4 H[4][4];
#pragma unroll
            for (int mt = 0; mt < 4; ++mt)
#pragma unroll
                for (int nt = 0; nt < 4; ++nt) H[mt][nt] = (f32x4){0.f, 0.f, 0.f, 0.f};
#pragma unroll
            for (int ks = 0; ks < 2; ++ks) {
                asm volatile("" ::: "memory");
                bf16x8 vb[4], cb[4];
#pragma unroll
                for (int nt = 0; nt < 4; ++nt) { vb[nt] = *(const bf16x8*)(VT + (size_t)(h * 64 + 16 * nt + r16) * T + tq + 32 * ks + 8 * kq); cb[nt] = *(const bf16x8*)(cts + (16 * nt + r16) * 64 + 32 * ks + 8 * kq); }
#pragma unroll
                for (int mt = 0; mt < 4; ++mt) {
                    const bf16x8 sa = *(const bf16x8*)(SL + (16 * mt + r16) * SL_PITCH + 32 * ks + 8 * kq);
                    float q8[8]; unpack8(Qf[mt][ks], q8);
#pragma unroll
                    for (int j = 0; j < 8; ++j) q8[j] *= wil[mt];
                    const bf16x8 qa = pack8(q8);
#pragma unroll
                    for (int nt = 0; nt < 4; ++nt) { H[mt][nt] = mfma16(sa, vb[nt], H[mt][nt]); H[mt][nt] = mfma16(qa, cb[nt], H[mt][nt]); }
                }
            }
#pragma unroll
            for (int mt = 0; mt < 4; ++mt) {
                asm volatile("" ::: "memory");
                const f32x4 iv4 = *(const f32x4*)(IV + 16 * mt + 4 * kq);
#pragma unroll
                for (int rg = 0; rg < 4; ++rg) {
                    const size_t row = R0 + tq + 16 * mt + 4 * kq + rg;
                    if (d == 0) {
#pragma unroll
                        for (int nt = 0; nt < 4; ++nt) HF[row * 256 + h * 64 + 16 * nt + r16] = H[mt][nt][rg] * iv4[rg];
                    } else {
                        float hs[4], ss = 0.f;
#pragma unroll
                        for (int nt = 0; nt < 4; ++nt) { hs[nt] = H[mt][nt][rg] * iv4[rg] + HF[row * 256 + h * 64 + 16 * nt + r16]; ss += hs[nt] * hs[nt]; }
                        ss = sum_r16(ss);
                        const float rs = 1.0f / sqrtf(ss * (1.0f / 64.0f) + RMS_EPS);
#pragma unroll
                        for (int nt = 0; nt < 4; ++nt) { const int dv = h * 64 + 16 * nt + r16;
                            AC[row * KMRG + 512 + dv] = (T_MASK & 0x800) ? (bf16)f2bf(hs[nt] * rs * F_m_norm_g[l * 256 + dv] * bf2f(OM[row * 256 + dv])) : (bf16)0; }
                    }
                }
            }
        }
        __syncthreads();
    }
}

constexpr int QU_TOTAL = 576;
__device__ __forceinline__ void mixer_phase(Frame& F, const Args& A, int l) {
    gu32* qhead = F.ctl + CW_QUEUE + 64 * l;
    for (;;) {
        __syncthreads();
        if (F.tid == 0) F.MISC[16] = __hip_atomic_fetch_add(qhead, 1u, RLX_AGENT);
        __syncthreads();
        const int u = (int)F.MISC[16];
        if (u >= QU_TOTAL) break;
        { int tl = threadIdx.x; asm volatile("" : "+v"(tl)); F.tid = tl; F.lane = tl & 63; F.wave = __builtin_amdgcn_readfirstlane(tl >> 6);
          size_t z_ = 0; asm volatile("" : "+s"(z_)); F.ws = A.ws + z_; F.out = A.out + z_; }
        const bf16* Qb = WSP(bf16, WS_Q); bf16* AC = WSP(bf16, WS_ACAT);
        if (u < 32 || (u >= 352 && u < 416)) { const int j = u < 32 ? u : u - 352; if (T_MASK & 0x100) mlstm_unit(F, A, l, j >> 2, j & 3, u >= 32); }
        else if (u < 96 || (u >= 416 && u < 448)) {
            const bool lat = u < 96; const int j = lat ? u - 32 : u - 416;
            pg8::OneUnit S; S.u.pm = lat ? (j >> 3) : (j >> 4); S.u.pn = lat ? (j & 7) : (j & 15);
            pg8::Gemm g; g.A = lat ? WSP(const pg8::bf16_t, WS_DFTL) : WSP(const pg8::bf16_t, WS_DFTC);
            g.Bt = WSP(const pg8::bf16_t, WS_UT) + (lat ? (size_t)16 * 65536 : 0); g.M = lat ? 2048 : 512; g.N = lat ? 2048 : 4096; g.K = lat ? 1024 : 256;
            pg8::EpiFourier E; E.AC = (pg8::bf16_t*)AC; E.lat = lat ? 1 : 0;
            if (T_MASK & 0x200) pg8::gemm_phase<pg8::EpiFourier, pg8::OneUnit, false, true>(F.ldsl + RING_OFF, g, S, E, F.tid);
        }
        else { const bool lat = u < 352; const int j = lat ? u - 96 : u - 448; const int b = lat ? (j >> 5) : (j >> 3), qh = lat ? ((j >> 2) & 7) : (j & 7), qb = lat ? (j & 3) : 0;
            const size_t row0 = lat ? (size_t)MC + (size_t)b * 1024 + (size_t)qb * 256 : (size_t)b * 256;
            const bf16* Kp = (lat ? WSP(bf16, WS_KL) + (size_t)b * 1280 * 256 : WSP(bf16, WS_KC) + (size_t)b * 65536) + (qh >> 1) * 64;
            const bf16* Vp = (lat ? WSP(bf16, WS_VL) + (size_t)b * 1280 * 256 : WSP(bf16, WS_VC) + (size_t)b * 65536) + (qh >> 1) * 64;
            if (T_MASK & 0x400) attn_body::attn_unit<8>((const attn_body::bf16*)(Qb + row0 * 512 + qh * 64), 512, (const attn_body::bf16*)Kp, (const attn_body::bf16*)Vp, 256, lat ? 20 : 4,
                (attn_body::bf16*)(AC + row0 * KMRG + qh * 64), KMRG, (char*)F.lds + RING_OFF, F.tid); }
    }
}

__global__ void __launch_bounds__(NWAVES * 64, 2) mk_fwd(const Args A) {
    extern __shared__ __attribute__((aligned(16))) unsigned char lds[];
    Frame F;
    F.lds = lds; F.ldsl = (LAS unsigned char*)lds;
    F.MISC = (volatile LAS unsigned*)(F.ldsl + MISC_OFF);
    F.tid = threadIdx.x; F.lane = F.tid & 63; F.wave = __builtin_amdgcn_readfirstlane(F.tid >> 6);
    F.G = gridDim.x; { const int bx = blockIdx.x; F.vcu = (F.G % 8 == 0) ? (bx % 8) * (F.G / 8) + bx / 8 : bx; }
    F.ctl = (gu32*)(A.ws + WS_CTL);
    for (int u = F.tid; u < (LDS_BYTES - LDSCTL_OFF) / 4; u += NWAVES * 64) ((LAS unsigned*)(F.ldsl + LDSCTL_OFF))[u] = 0u;
    __syncthreads();
    XcdBarrier bar; bar.bar = (unsigned*)(F.ctl + CW_BAR) + A.li * XCD_BAR_WORDS; bar.x = 0; bar.st = nullptr;
    if (A.ph_hi - A.ph_lo > 1) bar = xcd_barrier_post((unsigned*)(F.ctl + CW_BAR) + A.li * XCD_BAR_WORDS, F.MISC + 8);
    for (int ph = A.ph_lo; ph < A.ph_hi; ++ph) {
        { int tl = threadIdx.x; asm volatile("" : "+v"(tl)); F.tid = tl; F.lane = tl & 63; F.wave = __builtin_amdgcn_readfirstlane(tl >> 6);
          size_t z_ = 0; asm volatile("" : "+s"(z_)); F.ws = A.ws + z_; F.out = A.out + z_; }
        if (ph == 0) { if (T_MASK & 1) p0_prologue(F, A); }
        else {
            const int l = (ph - 1) >> 3, k = (ph - 1) & 7;
            if (k == 0) { if (T_MASK & 2) norm_phase(F, A, l, 0); }
            else if (k == 1) { if (T_MASK & 4) {
                pg8::Gemm g{WSP(const pg8::bf16_t, WS_XN), WSP(const pg8::bf16_t, WS_WIN), MTOT, NIN, DM}; pg8::StaticOrder S; S.init(MTOT, NIN, F.G, (int)blockIdx.x);
                pg8::EpiIn E; E.layer = l; E.Q = WSP(pg8::bf16_t, WS_Q); E.KC = WSP(pg8::bf16_t, WS_KC); E.VC = WSP(pg8::bf16_t, WS_VC); E.KL = WSP(pg8::bf16_t, WS_KL); E.VL = WSP(pg8::bf16_t, WS_VL);
                E.QM = WSP(pg8::bf16_t, WS_QM); E.KM = WSP(pg8::bf16_t, WS_KM); E.KMT = WSP(pg8::bf16_t, WS_KMT); E.VT = WSP(pg8::bf16_t, WS_VT); E.OM = WSP(pg8::bf16_t, WS_OM); E.UT = WSP(pg8::bf16_t, WS_UT);
                E.BG = WSP(pg8::bf16_t, WS_BG); E.onk = F_out + OFF_NK; E.onv = F_out + OFF_NV; E.qg = F_q_norm_g + l * 64; E.kg = F_k_norm_g + l * 64; E.rope = WSP(const pg8::f32x2v, WS_ROPE);
                pg8::gemm_phase<pg8::EpiIn, pg8::StaticOrder, true, true>(F.ldsl + RING_OFF, g, S, E, F.tid);
            } }
            else if (k == 2) { if (T_MASK & 8) mixer_phase(F, A, l); }
            else if (k == 3) { if (T_MASK & 16) {
                pg8::Gemm g{WSP(const pg8::bf16_t, WS_ACAT), WSP(const pg8::bf16_t, WS_WMRG), MTOT, DM, KMRG}; pg8::StaticOrder S; S.init(MTOT, DM, F.G, (int)blockIdx.x);
                pg8::EpiMerge E; E.BG = WSP(const pg8::bf16_t, WS_BG); E.O = WSP(pg8::bf16_t, WS_MRGD);
                pg8::gemm_phase<pg8::EpiMerge, pg8::StaticOrder, true, true>(F.ldsl + RING_OFF, g, S, E, F.tid);
            } }
            else if (k == 4 || k == 7) { if (T_MASK & 32) {
                pg8::Gemm g; g.M = MTOT; g.N = DM;
                if (k == 4) { g.A = WSP(const pg8::bf16_t, WS_MRGD); g.Bt = WSP(const pg8::bf16_t, WS_WOUT); g.K = DM; } else { g.A = WSP(const pg8::bf16_t, WS_HID); g.Bt = WSP(const pg8::bf16_t, WS_WF2); g.K = FF; }
                pg8::StaticOrder S; S.init(MTOT, DM, F.G, (int)blockIdx.x);
                pg8::EpiRes E; const bool first = (l == 0 && k == 4);
                E.xin_p = first ? F_x_prompt : F_out; E.xin_s = first ? F_x_sample : F_out + (size_t)MC * DM; E.xout = F_out; E.gate = WSP(const float, WS_MOD) + (size_t)l * 9 * 6144 + (k == 4 ? 2048 : 5120);
                pg8::gemm_phase<pg8::EpiRes, pg8::StaticOrder, true, true>(F.ldsl + RING_OFF, g, S, E, F.tid);
            } }
            else if (k == 5) { if (T_MASK & 64) norm_phase(F, A, l, 1); }
            else if (T_MASK & 128) {
                pg8::Gemm g{WSP(const pg8::bf16_t, WS_XN), WSP(const pg8::bf16_t, WS_WF1), MTOT, NF1, DM}; pg8::StaticOrder S; S.init(MTOT, NF1, F.G, (int)blockIdx.x);
                pg8::EpiSwiGLU E; E.H = WSP(pg8::bf16_t, WS_HID);
                pg8::gemm_phase<pg8::EpiSwiGLU, pg8::StaticOrder, true, true>(F.ldsl + RING_OFF, g, S, E, F.tid);
            }
        }
        if (ph + 1 < A.ph_hi) xcd_barrier(bar);
    }
}


#ifdef MK_DEBUG
#ifndef DBG_SKIP
#define DBG_SKIP 0
#endif
#define DBG_OFF (CTL_ZERO_BYTES - 4096)
__device__ __forceinline__ void dbg_acc(float* dbg, int k, float mine, float ref) { const float d = mine - ref; atomicAdd(dbg + k, d * d); atomicAdd(dbg + 32 + k, ref * ref); }
__device__ __forceinline__ float dbg_bf(const bf16* p, size_t i) { return bf2f(p[i]); }
__device__ float dbg_block_sum(float v, float* red) {
    v = wave_sum(v); __syncthreads(); if ((threadIdx.x & 63) == 0) red[threadIdx.x >> 6] = v; __syncthreads();
    float s = 0.f; for (int w = 0; w < 8; ++w) s += red[w]; __syncthreads(); return s; }
__global__ void __launch_bounds__(512) dbg_check(Args A) {
    __shared__ float red[16]; __shared__ float zrow[5392]; __shared__ float hrow[1024]; __shared__ float sm[4096];
    struct { unsigned char* ws; float* out; } F; F.ws = A.ws; F.out = A.out;
    float* dbg = (float*)(A.ws + DBG_OFF); const int tid = threadIdx.x, blk = blockIdx.x; const int l = 0;
    const float* MOD = WSP(float, WS_MOD);
    if (blk < 8) {
        const int rows[8] = {0, 255, 256, 4095, 4096, 4096 + 63, 4096 + 64 + 1023, 12287}; const int m = rows[blk];
        const float* xr = m < MC ? F_x_prompt + (size_t)m * DM : F_x_sample + (size_t)(m - MC) * DM; const int v = m < MC ? 0 : 1 + ((m - MC) >> 10);
        float s = 0.f; for (int c = tid; c < DM; c += 512) s += xr[c] * xr[c];
        const float rs = 1.0f / sqrtf(dbg_block_sum(s, red) / DM + RMS_EPS);
        if (blk == 0 && tid < 64) {
            const int vv = tid % 9, col = (97 * tid + 13) % 6144; float a = F_b_ada[col];
            for (int k = 0; k < DM; ++k) { const float cv = vv == 0 ? F_c_ctx[k] : F_c[(vv - 1) * DM + k]; a += silu_f(cv) * F_w_ada[(size_t)k * 6144 + col]; }
            dbg_acc(dbg, 1, MOD[(size_t)vv * 6144 + col], a); }
        for (int c = tid; c < DM; c += 512) { const float h = xr[c] * rs * F_norm1_g[c] * (1.0f + MOD[(size_t)v * 6144 + 1024 + c]) + MOD[(size_t)v * 6144 + c]; hrow[c] = h;
            dbg_acc(dbg, 2, dbg_bf(WSP(bf16, WS_XN), (size_t)m * DM + c), h); }
        __syncthreads();
        for (int c = tid; c < INC; c += 512) { float a = 0.f; for (int k = 0; k < DM; ++k) a += hrow[k] * F_w_in[(size_t)k * INC + c]; zrow[c] = a; }
        __syncthreads();
        const bool ctx = m < MC; const int b = ctx ? m >> 8 : (m - MC) >> 10, t = ctx ? m & 255 : (m - MC) & 1023, T = ctx ? 256 : 1024;
        const size_t tbase = ctx ? (size_t)b * 65536 : (size_t)16 * 65536 + (size_t)b * 262144;
        if (tid < 16) dbg_acc(dbg, 3, WSP(float, WS_GATES)[(size_t)m * 16 + tid], zrow[2048 + tid]);
        for (int i = tid; i < 12 * 64; i += 512) { const int hd = i >> 6, d = i & 63; const bool isk = hd >= 8; const int c0 = isk ? 512 + (hd - 8) * 64 : hd * 64;
            float ss = 0.f; for (int e = 0; e < 64; ++e) ss += zrow[c0 + e] * zrow[c0 + e];
            const float r = 1.0f / sqrtf(ss / 64.f + RMS_EPS); const float* g = isk ? F_k_norm_g : F_q_norm_g;
            float y = zrow[c0 + d] * r * g[d];
            if (isk && ctx) dbg_acc(dbg, 5, F.out[OFF_NK + ((size_t)((b * 2 + l) * 256 + t)) * 256 + (hd - 8) * 64 + d], y);
            if (!ctx) { const int half = d >> 5, i16 = d & 15, up = (d >> 4) & 1; const int pos = half == 0 ? (t >> 6) : (t & 63); const float inv = 1.0f / powf(10000.f, (float)i16 / 16.f), ang = (float)pos * inv;
                const int dp = (d & ~31) + (up ? i16 : i16 + 16); const float yp = zrow[c0 + dp] * r * g[dp];
                y = up ? (y * cosf(ang) + yp * sinf(ang)) : (y * cosf(ang) - yp * sinf(ang)); }
            if (!isk) dbg_acc(dbg, ctx ? 4 : 17, dbg_bf(WSP(bf16, WS_Q), (size_t)m * 512 + c0 + d), y * ATT_C2);
            else dbg_acc(dbg, ctx ? 5 : 18, ctx ? dbg_bf(WSP(bf16, WS_KC), ((size_t)(b * 256 + t)) * 256 + (hd - 8) * 64 + d) : dbg_bf(WSP(bf16, WS_KL), ((size_t)(b * 1280 + 256 + t)) * 256 + (hd - 8) * 64 + d), y); }
        for (int c = tid; c < 256; c += 512) { const float vv = zrow[768 + c];
            if (ctx) { dbg_acc(dbg, 6, F.out[OFF_NV + ((size_t)((b * 2 + l) * 256 + t)) * 256 + c], vv); dbg_acc(dbg, 6, dbg_bf(WSP(bf16, WS_VC), ((size_t)(b * 256 + t)) * 256 + c), vv); }
            else dbg_acc(dbg, 6, dbg_bf(WSP(bf16, WS_VL), ((size_t)(b * 1280 + 256 + t)) * 256 + c), vv);
            dbg_acc(dbg, 7, dbg_bf(WSP(bf16, WS_QM), (size_t)m * 256 + c), zrow[1024 + c]); dbg_acc(dbg, 7, dbg_bf(WSP(bf16, WS_KM), (size_t)m * 256 + c), zrow[1280 + c]);
            dbg_acc(dbg, 7, dbg_bf(WSP(bf16, WS_KMT), tbase + (size_t)c * T + t), zrow[1280 + c]);
            dbg_acc(dbg, 8, dbg_bf(WSP(bf16, WS_VT), tbase + (size_t)c * T + t), zrow[1536 + c]); dbg_acc(dbg, 8, dbg_bf(WSP(bf16, WS_UT), tbase + (size_t)c * T + t), zrow[2064 + c]);
            dbg_acc(dbg, 8, dbg_bf(WSP(bf16, WS_OM), (size_t)m * 256 + c), 1.0f / (1.0f + __expf(-zrow[1792 + c]))); }
        for (int c = tid; c < 3072; c += 512) dbg_acc(dbg, 9, 1.0f / (1.0f + dbg_bf(WSP(bf16, WS_BG), (size_t)m * 3072 + c)), 1.0f / (1.0f + __expf(-zrow[2320 + c])));
    } else if (blk < 16) {
        const int wave = tid >> 6, lane = tid & 63, si = (blk - 8) * 8 + wave;
        const bool lat = si & 1; const int b = (si * 5) % (lat ? 8 : 16), qh = (si * 3) % 8, t = (si * 37 + 11) % (lat ? 1024 : 256);
        const size_t row = lat ? (size_t)MC + b * 1024 + t : (size_t)b * 256 + t; const int NK = lat ? 1280 : 256;
        const bf16* Kp = (lat ? WSP(bf16, WS_KL) + (size_t)b * 1280 * 256 : WSP(bf16, WS_KC) + (size_t)b * 65536) + (qh >> 1) * 64;
        const bf16* Vp = (lat ? WSP(bf16, WS_VL) + (size_t)b * 1280 * 256 : WSP(bf16, WS_VC) + (size_t)b * 65536) + (qh >> 1) * 64;
        const bf16* Qp = WSP(bf16, WS_Q) + row * 512 + qh * 64; float* sc = sm + wave * 0;
        float mx = -1e30f; for (int k = lane; k < NK; k += 64) { float a = 0.f; for (int d = 0; d < 64; ++d) a += bf2f(Qp[d]) * bf2f(Kp[(size_t)k * 256 + d]); mx = fmaxf(mx, a); }
        for (int o = 1; o < 64; o <<= 1) mx = fmaxf(mx, __shfl_xor(mx, o));
        float den = 0.f, acc = 0.f;
        for (int k = 0; k < NK; ++k) { float a = 0.f; for (int d = 0; d < 64; ++d) a += bf2f(Qp[d]) * bf2f(Kp[(size_t)k * 256 + d]); const float p = exp2f(a - mx); den += p; acc += p * bf2f(Vp[(size_t)k * 256 + lane]); }
        dbg_acc(dbg, 10, dbg_bf(WSP(bf16, WS_ACAT), row * KMRG + qh * 64 + lane), acc / den); (void)sc;
    } else if (blk < 24) {
        const int si = (blk - 16) * 512 + tid; const bool lat = si & 1; const int T = lat ? 1024 : 256, b = (si >> 1) % (lat ? 8 : 16), tp = ((si * 53) % 29 == 0) ? 0 : (si * 131 + 7) % T, c = (si * 17 + 3) % 256;
        const size_t tbase = lat ? (size_t)16 * 65536 + (size_t)b * 262144 : (size_t)b * 65536; const bf16* u = WSP(bf16, WS_UT) + tbase + (size_t)c * T;
        float p = 0.f, q = 0.f; for (int t = 0; t < T; ++t) { const float a = 6.283185307179586f * (float)((t * tp) % T) / (float)T; p += cosf(a) * bf2f(u[t]); q += sinf(a) * bf2f(u[t]); }
        const float sq = 1.0f / sqrtf((float)T); const size_t row = lat ? (size_t)MC + b * 1024 + tp : (size_t)b * 256 + tp;
        dbg_acc(dbg, 11, dbg_bf(WSP(bf16, WS_ACAT), row * KMRG + 768 + c), p * sq); dbg_acc(dbg, 11, dbg_bf(WSP(bf16, WS_ACAT), row * KMRG + 1024 + c), q * sq);
    } else if (blk < 28) {
        const int ci = blk - 24; const bool ctx = ci < 2; const int b = ci == 0 ? 3 : ci == 1 ? 12 : ci == 2 ? 2 : 5, h = ci == 0 ? 1 : ci == 1 ? 2 : ci == 2 ? 0 : 3;
        const int T = ctx ? 256 : 1024; const size_t R0 = ctx ? (size_t)b * 256 : (size_t)MC + (size_t)b * 1024;
        const float* cwl = F_m_conv_w; const bf16* QM = WSP(bf16, WS_QM); const bf16* KM = WSP(bf16, WS_KM); const bf16* VTp = WSP(bf16, WS_VT) + (ctx ? (size_t)b * 65536 : (size_t)16 * 65536 + (size_t)b * 262144);
        float* qs = sm; float* ks = sm + 64; float* vs = sm + 128; float* part = sm + 256; float* hsum = sm + 1024;
        const int dv = tid & 63, g8 = tid >> 6; float* HB = (float*)(A.ws + 248 * MiB) + (size_t)ci * 1024 * 64;
        for (int d = 0; d < 2; ++d) {
            float C[8]; float nn = 0.f, mm = 0.f;
            for (int j = 0; j < 8; ++j) C[j] = ctx ? 0.f : F_state_C[(size_t)(((b * 2 + l) * 2 + d) * 4 + h) * 4096 + (8 * g8 + j) * 64 + dv];
            if (!ctx) { mm = F_state_m[((b * 2 + l) * 2 + d) * 4 + h]; }
            nn = ctx ? 0.f : F_state_n[(size_t)(((b * 2 + l) * 2 + d) * 4 + h) * 64 + dv];
            for (int k = 0; k < T; ++k) { const int t = d ? T - 1 - k : k; const size_t row = R0 + t;
                __syncthreads();
                if (tid < 128) { const int ch = tid & 63; const bool isk = tid >= 64; const bf16* X = isk ? KM : QM; const int cc = (isk ? 256 : 0) + h * 64 + ch;
                    const float x0 = bf2f(X[row * 256 + h * 64 + ch]), xm = t > 0 ? bf2f(X[(row - 1) * 256 + h * 64 + ch]) : 0.f, xp = t + 1 < T ? bf2f(X[(row + 1) * 256 + h * 64 + ch]) : 0.f;
                    const float y = silu_f(cwl[cc] * xm + cwl[512 + cc] * x0 + cwl[1024 + cc] * xp); if (isk) ks[ch] = y * 0.125f; else qs[ch] = y; }
                else if (tid < 192) vs[tid - 128] = bf2f(VTp[(size_t)(h * 64 + (tid - 128)) * T + t]);
                __syncthreads();
                const float* gp = WSP(float, WS_GATES) + row * 16 + d * 8 + h; const float li = gp[0] + F_m_gate_b[d * 8 + h], lf = logsigmoid_f(gp[4] + F_m_gate_b[d * 8 + 4 + h]);
                const float mn = fmaxf(lf + mm, li), fg = __expf(lf + mm - mn), ig = __expf(li - mn); mm = mn;
                float pa = 0.f;
                for (int j = 0; j < 8; ++j) { C[j] = fg * C[j] + ig * ks[8 * g8 + j] * vs[dv]; pa += qs[8 * g8 + j] * C[j]; }
                nn = fg * nn + ig * ks[dv];
                part[g8 * 64 + dv] = pa; if (g8 == 0) part[512 + dv] = qs[dv] * nn;
                __syncthreads();
                if (tid < 64) { float num = 0.f; for (int w = 0; w < 8; ++w) num += part[w * 64 + tid]; float qn = 0.f; for (int e = 0; e < 64; ++e) qn += part[512 + e];
                    const float hv = num / fmaxf(fabsf(qn), __expf(-mm));
                    if (d == 0) { HB[(size_t)t * 64 + tid] = hv; const float kv = WSP(float, WS_HF)[row * 256 + h * 64 + tid]; float sa = wave_sum(kv * kv), sr = wave_sum(hv * hv);
                        dbg_acc(dbg, ctx ? (t < 64 ? 20 : 22) : (t < 64 ? 21 : 23), kv / sqrtf(sa + 1e-30f), hv / sqrtf(sr + 1e-30f));
                        if (tid == 0) { atomicAdd(dbg + (ctx ? 24 : 25), (sqrtf(sa / sr) - 1.0f) * (sqrtf(sa / sr) - 1.0f)); atomicAdd(dbg + 32 + (ctx ? 24 : 25), 1.0f); } }
                    else { const float hs = hv + HB[(size_t)t * 64 + tid]; hsum[tid] = hs; } }
                __syncthreads();
                if (d == 1 && tid < 64) { float ss = 0.f; for (int e = 0; e < 64; ++e) ss += hsum[e] * hsum[e]; const float rr = 1.0f / sqrtf(ss / 64.f + RMS_EPS);
                    const float ref = hsum[tid] * rr * F_m_norm_g[h * 64 + tid] * bf2f(WSP(bf16, WS_OM)[row * 256 + h * 64 + tid]);
                    dbg_acc(dbg, ctx ? 12 : 19, dbg_bf(WSP(bf16, WS_ACAT), row * KMRG + 512 + h * 64 + tid), ref); }
            }
            if (ctx) { for (int j = 0; j < 8; ++j) dbg_acc(dbg, 13, F.out[OFF_NC + (size_t)(((b * 2 + l) * 2 + d) * 4 + h) * 4096 + (8 * g8 + j) * 64 + dv], C[j]);
                if (g8 == 0) { dbg_acc(dbg, 13, F.out[OFF_NN + (size_t)(((b * 2 + l) * 2 + d) * 4 + h) * 64 + dv], nn); if (dv == 0) dbg_acc(dbg, 13, F.out[OFF_NM + ((b * 2 + l) * 2 + d) * 4 + h], mm); } }
        }
    }
}
__global__ void __launch_bounds__(512) dbg_check2(Args A, int stage) {
    __shared__ float red[16]; __shared__ float rowbuf[2816]; __shared__ float rowb2[1024];
    struct { unsigned char* ws; float* out; } F; F.ws = A.ws; F.out = A.out;
    float* dbg = (float*)(A.ws + DBG_OFF); const int tid = threadIdx.x, blk = blockIdx.x;
    const int rows[8] = {0, 255, 256, 4095, 4096, 4096 + 1024, 4096 + 2047, 12287}; const int m = rows[blk]; const int v = m < MC ? 0 : 1 + ((m - MC) >> 10);
    const float* MOD = WSP(float, WS_MOD);
    if (stage == 0) {
        const bf16* ac = WSP(bf16, WS_ACAT) + (size_t)m * KMRG; const bf16* bg = WSP(bf16, WS_BG) + (size_t)m * 3072; const bf16* wm = WSP(bf16, WS_WMRG);
        for (int c = tid; c < DM; c += 512) { float s0 = 0.f, s1 = 0.f, s2 = 0.f; const bf16* w = wm + (size_t)c * KMRG;
            for (int k = 0; k < 512; ++k) s0 += bf2f(ac[k]) * bf2f(w[k]); for (int k = 512; k < 768; ++k) s1 += bf2f(ac[k]) * bf2f(w[k]); for (int k = 768; k < 1280; ++k) s2 += bf2f(ac[k]) * bf2f(w[k]);
            const float ref = s0 / (1.f + bf2f(bg[c])) + s1 / (1.f + bf2f(bg[1024 + c])) + s2 / (1.f + bf2f(bg[2048 + c]));
            dbg_acc(dbg, 14, dbg_bf(WSP(bf16, WS_MRGD), (size_t)m * DM + c), ref); }
    } else if (stage == 1) {
        const float* xr = m < MC ? F_x_prompt + (size_t)m * DM : F_x_sample + (size_t)(m - MC) * DM; const bf16* mg = WSP(bf16, WS_MRGD) + (size_t)m * DM; const bf16* wo = WSP(bf16, WS_WOUT);
        for (int c = tid; c < DM; c += 512) { float s = 0.f; for (int k = 0; k < DM; ++k) s += bf2f(mg[k]) * bf2f(wo[(size_t)c * DM + k]);
            dbg_acc(dbg, 15, F.out[(size_t)m * DM + c], xr[c] + MOD[(size_t)v * 6144 + 2048 + c] * s); }
    } else if (stage == 2) {
        const float* xr = F.out + (size_t)m * DM; float s = 0.f; for (int c = tid; c < DM; c += 512) s += xr[c] * xr[c];
        const float rs = 1.0f / sqrtf(dbg_block_sum(s, red) / DM + RMS_EPS);
        for (int c = tid; c < DM; c += 512) { const float h = xr[c] * rs * F_norm2_g[c] * (1.0f + MOD[(size_t)v * 6144 + 4096 + c]) + MOD[(size_t)v * 6144 + 3072 + c]; rowb2[c] = h; dbg_acc(dbg, 16, dbg_bf(WSP(bf16, WS_XN), (size_t)m * DM + c), h); }
        __syncthreads();
        for (int j = tid; j < FF; j += 512) { float g = 0.f, u = 0.f; for (int k = 0; k < DM; ++k) { g += rowb2[k] * F_w_f1[(size_t)k * NF1 + j]; u += rowb2[k] * F_w_f1[(size_t)k * NF1 + FF + j]; }
            const float ref = silu_f(g) * u; rowbuf[j] = ref; dbg_acc(dbg, 16, dbg_bf(WSP(bf16, WS_HID), (size_t)m * FF + j), ref); }
    }
}
__global__ void dbg_encode(Args A, int nout) {
    float* dbg = (float*)(A.ws + DBG_OFF); __shared__ float sc;
    if (threadIdx.x == 0) { int first = 0; for (int k = 1 + DBG_SKIP; k < 32; ++k) { const float sr = dbg[32 + k], sd = dbg[k]; if (sr > 0.f && sd > 0.0025f * sr) { first = k; break; } if (sr == 0.f && sd > 0.f) { first = k; break; } }
        float target = first == 0 ? 0.f : 0.10f + 0.05f * (float)first;
#ifdef DBG_REPORT
        { const float rel = sqrtf(dbg[DBG_REPORT] / fmaxf(dbg[32 + DBG_REPORT], 1e-30f)); target = 0.15f + fminf(0.8f, 8.0f * rel); }
#endif
        sc = 1.0f - sqrtf(target); }
    __syncthreads();
    const float s = sc; if (s == 1.0f) return;
    for (size_t i = (size_t)blockIdx.x * blockDim.x + threadIdx.x; i < (size_t)nout; i += (size_t)gridDim.x * blockDim.x) A.out[i] *= s;
}
#endif

extern "C" void kernel_launch(void* const* d_in, const int* in_sizes, int n_in, void* d_out, int out_size, void* d_ws, size_t ws_size, hipStream_t stream) {
    static int grid = 0;
    if (grid == 0) {
        if (n_in != 25 || out_size != 17842432 || ws_size < WS_END) { fprintf(stderr, "kernel_launch: unexpected shapes: n_in %d out %d ws %zu; nothing launched\n", n_in, out_size, ws_size); grid = -1; return; }
        int dev = 0, cus = 0, per_cu = 0;
        if (hipGetDevice(&dev) != hipSuccess || hipDeviceGetAttribute(&cus, hipDeviceAttributeMultiprocessorCount, dev) != hipSuccess) { grid = -1; return; }
        if (hipFuncSetAttribute((const void*)mk_fwd, hipFuncAttributeMaxDynamicSharedMemorySize, LDS_BYTES) != hipSuccess) { fprintf(stderr, "kernel_launch: hipFuncSetAttribute failed\n"); grid = -1; return; }
        if (hipOccupancyMaxActiveBlocksPerMultiprocessor(&per_cu, (const void*)mk_fwd, NWAVES * 64, LDS_BYTES) != hipSuccess || per_cu < 1) { fprintf(stderr, "kernel_launch: occupancy query says %d blocks per CU\n", per_cu); per_cu = 1; }
        (void)hipGetLastError();
        grid = cus;
    }
    if (grid < 0) return;
    if (hipMemsetAsync((char*)d_ws + WS_CTL, 0, CTL_ZERO_BYTES, stream) != hipSuccess) { fprintf(stderr, "kernel_launch: memset failed\n"); return; }
    Args a{};
    for (int i = 0; i < 25; ++i) a.in[i] = (const float*)d_in[i];
    a.out = (float*)d_out; a.ws = (unsigned char*)d_ws;
#ifdef MK_DEBUG
    for (int ph = 0; ph < N_PHASES; ++ph) { a.ph_lo = ph; a.ph_hi = ph + 1; a.li = 0; hipLaunchKernelGGL(mk_fwd, dim3(grid), dim3(NWAVES * 64), LDS_BYTES, stream, a);
        if (ph == 3) hipLaunchKernelGGL(dbg_check, dim3(28), dim3(512), 0, stream, a);
        if (ph == 4) hipLaunchKernelGGL(dbg_check2, dim3(8), dim3(512), 0, stream, a, 0);
        if (ph == 5) hipLaunchKernelGGL(dbg_check2, dim3(8), dim3(512), 0, stream, a, 1);
        if (ph == 7) hipLaunchKernelGGL(dbg_check2, dim3(8), dim3(512), 0, stream, a, 2); }
    hipLaunchKernelGGL(dbg_encode, dim3(256), dim3(256), 0, stream, a, out_size);
#else
    if (N_LAUNCHES == 1) {
        a.ph_lo = 0; a.ph_hi = N_PHASES; a.li = 0;
        hipLaunchKernelGGL(mk_fwd, dim3(grid), dim3(NWAVES * 64), LDS_BYTES, stream, a);
    } else {
        for (int ph = 0; ph < N_PHASES; ++ph) { a.ph_lo = ph; a.ph_hi = ph + 1; a.li = 0; hipLaunchKernelGGL(mk_fwd, dim3(grid), dim3(NWAVES * 64), LDS_BYTES, stream, a); }
    }
#endif
    const hipError_t le = hipPeekAtLastError();
    if (le != hipSuccess) fprintf(stderr, "kernel_launch: launch failed: %s\n", hipGetErrorName(le));
}
```

```cpp
#include <hip/hip_runtime.h>
#include <hip/hip_bf16.h>
#include <cstdio>
#include <cstdint>
#include <cmath>

#ifndef MK_N_LAUNCHES
#define MK_N_LAUNCHES 1
#endif
#ifndef T_MASK
#define T_MASK 0xFFFF
#endif

constexpr int DM = 1024, MC = 4096, ML = 8192, MTOT = 12288;
constexpr int INC = 5392, NIN = 5376, KMRG = 1280, FF = 2816, NF1 = 5632, NBG = 3072;
constexpr float RMS_EPS = 1e-6f;
constexpr float LOG2E = 1.4426950408889634f;
constexpr float ATT_C2 = 0.125f * 1.4426950408889634f;
constexpr size_t OFF_YP = 0, OFF_YS = 4194304, OFF_NK = 12582912, OFF_NV = 14680064, OFF_NC = 16777216, OFF_NN = 17825792, OFF_NM = 17842176;
constexpr size_t MiB = 1u << 20;
constexpr size_t WS_CTL = 0, CTL_ZERO_BYTES = 2 * MiB;
constexpr size_t WS_MOD = 1 * MiB;
constexpr size_t WS_WIN = 2 * MiB;
constexpr size_t WS_WMRG = WS_WIN + 11010048;
constexpr size_t WS_WOUT = WS_WMRG + 2621440;
constexpr size_t WS_WF1 = WS_WOUT + 2097152;
constexpr size_t WS_WF2 = WS_WF1 + 11534336;
constexpr size_t WS_ROPE = WS_WF2 + 5767168;
constexpr size_t WS_DFTC = WS_ROPE + 65536;
constexpr size_t WS_DFTL = WS_DFTC + 262144;
constexpr size_t WS_GATES = WS_DFTL + 4194304;
constexpr size_t WS_XN = 40 * MiB;
constexpr size_t WS_CT = WS_XN;
constexpr size_t WS_HF = WS_XN + 12 * MiB;
constexpr size_t WS_BG = 64 * MiB;
constexpr size_t WS_HID = WS_BG;
constexpr size_t WS_Q = 136 * MiB;
constexpr size_t WS_KC = WS_Q + 12 * MiB, WS_VC = WS_KC + 2 * MiB, WS_KL = WS_VC + 2 * MiB, WS_VL = WS_KL + 5 * MiB;
constexpr size_t WS_MRGD = WS_Q;
constexpr size_t WS_QM = 162 * MiB, WS_KM = WS_QM + 6 * MiB, WS_KMT = WS_KM + 6 * MiB, WS_VT = WS_KMT + 6 * MiB, WS_OM = WS_VT + 6 * MiB, WS_UT = WS_OM + 6 * MiB;
constexpr size_t WS_ACAT = 198 * MiB;
constexpr size_t WS_QN = 228 * MiB, WS_KN = 234 * MiB, WS_KNT = 240 * MiB;
constexpr size_t WS_UT2 = 240 * MiB;
constexpr size_t WS_PA = 252 * MiB;
constexpr size_t WS_END = 255 * MiB;
static_assert(WS_GATES + 786432 <= WS_XN && WS_VL + 5 * MiB <= WS_QM && WS_UT + 6 * MiB <= WS_ACAT, "ws map");
constexpr int CW_TMO = 0, CW_CODE = 1;
constexpr int CW_BAR = 4096;
constexpr int CW_QUEUE = 65536;
constexpr int CW_EFLAG = 110592;
constexpr int CW_HFLAG = 118784;
constexpr int CW_GFLAG = 126976;
constexpr int CW_MFLAG = 131072;
constexpr int RING_OFF = 0, RING_BYTES = 131072;
constexpr int LDS_BYTES = 163840;
constexpr int SPARE_STAGE = RING_BYTES, SPARE_ROPE = RING_BYTES + 8192;
constexpr int LDSCTL_OFF = LDS_BYTES - 1024, MISC_OFF = LDSCTL_OFF + 320;


namespace pg8 {
#define PG8_LAS __attribute__((address_space(3)))
typedef unsigned short bf16_t;
typedef short bf16x8 __attribute__((ext_vector_type(8)));
typedef float f32x4 __attribute__((ext_vector_type(4)));
typedef unsigned u32x4 __attribute__((ext_vector_type(4)));
constexpr int BM = 256, BK = 64, HALF = 128, HTB = HALF * BK * 2  , STAGE_BYTES = 8 * HTB, NXCD = 8, WGM = 8;

__host__ __device__ __forceinline__ int lds_byte(int r, int c) { const int st = (r >> 4) * 2 + (c >> 5), rr = r & 15, cc = c & 31, ob = rr * 64 + cc * 2; return st * 1024 + (ob ^ (((ob >> 9) & 1) << 5)); }
__host__ __device__ __forceinline__ void stage_rc(int b, int& R, int& C) { const int st = b / 1024, sb = b % 1024, swz = sb ^ (((sb >> 9) & 1) << 5); R = (st >> 1) * 16 + swz / 64; C = (st & 1) * 32 + (swz % 64) / 2; }
__host__ __device__ __forceinline__ int perm32(int rho) { const int n = rho >> 4, i = rho & 15; return 8 * (i >> 2) + 4 * n + (i & 3); }

struct Unit { int pm, pn; };
struct Gemm { const bf16_t* A; const bf16_t* Bt; int M, N, K; };

struct StaticOrder {
    int nM, nN, nwg, G, c;
    __host__ __device__ __forceinline__ void init(int M, int N, int G_, int c_) { nM = M / BM; nN = N / BM; nwg = nM * nN; G = G_; c = c_; }
    __host__ __device__ __forceinline__ bool next(int i, Unit& u) const {
        const long L = (long)i * G + c; if (L >= nwg) return false;
        int wgid = (int)L; { const int q = nwg / NXCD, r = nwg % NXCD, xcd = wgid % NXCD, off = wgid / NXCD; wgid = (xcd < r ? xcd * (q + 1) : r * (q + 1) + (xcd - r) * q) + off; }
        const int nig = WGM * nN, gid = wgid / nig, fm = gid * WGM, gsz = (nM - fm) < WGM ? (nM - fm) : WGM;
        u.pm = fm + ((wgid % nig) % gsz); u.pn = (wgid % nig) / gsz; return true;
    }
    __device__ __forceinline__ void a_ready(const Unit&) const {}
    __device__ __forceinline__ void done(const Unit&) const {}
};

struct GOrder {
    StaticOrder so; int split;
    __device__ void init(int M, int N, int G_, int c_) { split = (G_ == 256 && M == 12288 && N == 5632) ? 1 : 0; so.init(M, split ? N - 512 : N, G_, c_); }
    __device__ bool next(int i, Unit& u) const {
        if (!split) return so.next(i, u);
        if (i > 3) return false;
        if (i < 3 || so.c < 192) return so.next(i, u);
        const int j = so.c - 192, x = j & 7, a = j >> 3; u.pm = 16 + 4 * x + (a >> 1); u.pn = 20 + (a & 1); return true;
    }
    __device__ __forceinline__ void a_ready(const Unit&) const {}
    __device__ __forceinline__ void done(const Unit&) const {}
};
struct FlagUnit { Unit u; unsigned* flag;
    __device__ __forceinline__ bool next(int i, Unit& o) const { if (i != 0) return false; o = u; return true; }
    __device__ __forceinline__ void a_ready(const Unit&) const {}
    __device__ __forceinline__ void done(const Unit&) const {
        asm volatile("s_waitcnt vmcnt(0)" ::: "memory"); __syncthreads();
        if (threadIdx.x == 0) { __builtin_amdgcn_fence(__ATOMIC_RELEASE, "agent"); asm volatile("s_waitcnt vmcnt(0)" ::: "memory"); (void)__hip_atomic_fetch_add(flag, 1u, __ATOMIC_RELAXED, __HIP_MEMORY_SCOPE_AGENT); } }
};

__device__ __forceinline__ unsigned cvt_pk_bf16(float lo, float hi) { unsigned r; asm volatile("v_cvt_pk_bf16_f32 %0, %1, %2" : "=v"(r) : "v"(lo), "v"(hi)); return r; }
typedef float f32x2 __attribute__((ext_vector_type(2)));

typedef float f32x2v __attribute__((ext_vector_type(2)));
typedef unsigned u32x2 __attribute__((ext_vector_type(2)));
__device__ __forceinline__ unsigned f2bf_(float f) { unsigned u = __builtin_bit_cast(unsigned, f); return (u + 0x7fffu + ((u >> 16) & 1u)) >> 16; }
typedef __bf16 bf16x2h_t __attribute__((ext_vector_type(2)));
__device__ __forceinline__ unsigned pk2_(float lo, float hi) { f32x2v v = {lo, hi}; return __builtin_bit_cast(unsigned, __builtin_convertvector(v, bf16x2h_t)); }
__device__ __forceinline__ u32x2 pk4_(f32x4 v) { u32x2 w; w.x = pk2_(v[0], v[1]); w.y = pk2_(v[2], v[3]); return w; }
__device__ __forceinline__ float bf2f_(unsigned short h) { return __builtin_bit_cast(float, (unsigned)h << 16); }
__device__ __forceinline__ f32x4 bf4_to_f32(u32x2 w) { f32x4 r; r[0] = __builtin_bit_cast(float, w.x << 16); r[1] = __builtin_bit_cast(float, w.x & 0xffff0000u); r[2] = __builtin_bit_cast(float, w.y << 16); r[3] = __builtin_bit_cast(float, w.y & 0xffff0000u); return r; }

struct OneUnit { Unit u;
    __device__ __forceinline__ bool next(int i, Unit& o) const { if (i != 0) return false; o = u; return true; }
    __device__ __forceinline__ void a_ready(const Unit&) const {}
    __device__ __forceinline__ void done(const Unit&) const {} };

struct EpiIn {
    static constexpr bool PERM = false, AFTER_DRAIN = false, HAS_MID = false;
    int layer;
    bf16_t *Q, *KC, *VC, *KL, *VL, *QM, *KM, *KMT, *VT, *OM, *UT; unsigned char* BG;
    float *onk, *onv;
    const float *qg, *kg;
    const PG8_LAS f32x2v* rope;
    PG8_LAS bf16_t* stage;
    __device__ __forceinline__ void operator()(const f32x4 (&acc)[2][2][4][2], const Unit& u, int wr, int wc, int fr0, int fq0) const {
        int fr = fr0, fq = fq0; asm volatile("" : "+v"(fr), "+v"(fq));
        const int pn = u.pn, pm = u.pm;
        const bool ctx = pm < 16;
        const int b = ctx ? pm : ((pm - 16) >> 2);
        const int tb = ctx ? 0 : ((pm - 16) & 3) * 256;
        const int T = ctx ? 256 : 1024;
        const int rl0 = wr * 64 + fr;
        if (pn <= 3) {
            const float* gv = (pn == 2) ? kg : qg;
            f32x4 g4[2][2];
#pragma unroll
            for (int bj = 0; bj < 2; ++bj)
#pragma unroll
                for (int n = 0; n < 2; ++n) g4[bj][n] = *(const f32x4*)(gv + 32 * bj + 16 * n + 4 * fq);
#pragma unroll
            for (int ai = 0; ai < 2; ++ai)
#pragma unroll
                for (int m = 0; m < 4; ++m) {
                    asm volatile("" ::: "memory"); const int rl = rl0 + ai * 128 + m * 16; const int t = tb + rl; const size_t row = (size_t)pm * 256 + rl;
                    f32x4 v[2][2];
#pragma unroll
                    for (int bj = 0; bj < 2; ++bj)
#pragma unroll
                        for (int n = 0; n < 2; ++n) v[bj][n] = acc[ai][bj][m][n];
                    if (pn != 3) {
                        float ss = 0.f;
#pragma unroll
                        for (int bj = 0; bj < 2; ++bj)
#pragma unroll
                            for (int n = 0; n < 2; ++n) { const f32x4 x = v[bj][n]; ss += (x[0] * x[0] + x[1] * x[1]) + (x[2] * x[2] + x[3] * x[3]); }
                        ss += __shfl_xor(ss, 16); ss += __shfl_xor(ss, 32);
                        const float rs = 1.0f / sqrtf(ss * (1.0f / 64.0f) + RMS_EPS);
#pragma unroll
                        for (int bj = 0; bj < 2; ++bj)
#pragma unroll
                            for (int n = 0; n < 2; ++n) v[bj][n] = v[bj][n] * rs * g4[bj][n];
                        if (!ctx) {
#pragma unroll
                            for (int bj = 0; bj < 2; ++bj) {
                                const int pos = bj == 0 ? (t >> 6) : (t & 63);
                                const PG8_LAS f32x2v* rp = rope + pos * 16 + 4 * fq;
#pragma unroll
                                for (int j = 0; j < 4; ++j) { const f32x2v cs = rp[j]; const float x1 = v[bj][0][j], x2 = v[bj][1][j];
                                    v[bj][0][j] = x1 * cs.x - x2 * cs.y; v[bj][1][j] = x2 * cs.x + x1 * cs.y; }
                            }
                        }
                    }
                    if (pn <= 1) {
                        bf16_t* dst = Q + row * 512 + (4 * pn + wc) * 64 + 8 * fq;
#pragma unroll
                        for (int bj = 0; bj < 2; ++bj) { const u32x2 p0 = pk4_(v[bj][0] * ATT_C2), p1 = pk4_(v[bj][1] * ATT_C2); const u32x4 w = {p0.x, p0.y, p1.x, p1.y}; *(u32x4*)(dst + 32 * bj) = w; }
                    } else {
                        const int hb = wc * 64 + 8 * fq; const int hf = wc * 64 + (pn == 2 ? 4 * fq : 8 * fq), nf = pn == 2 ? 16 : 4;
                        if (ctx) {
                            float* of = (pn == 2 ? onk : onv) + ((size_t)((b * 2 + layer) * 256 + t)) * 256 + hf;
                            bf16_t* dst = (pn == 2 ? KC : VC) + ((size_t)(b * 256 + t)) * 256 + hb;
#pragma unroll
                            for (int bj = 0; bj < 2; ++bj) {
#pragma unroll
                                for (int n = 0; n < 2; ++n) *(f32x4*)(of + 32 * bj + nf * n) = v[bj][n];
                                const u32x2 p0 = pk4_(v[bj][0]), p1 = pk4_(v[bj][1]); const u32x4 w = {p0.x, p0.y, p1.x, p1.y}; *(u32x4*)(dst + 32 * bj) = w; }
                        } else {
                            bf16_t* dst = (pn == 2 ? KL : VL) + ((size_t)(b * 1280 + 256 + t)) * 256 + hb;
#pragma unroll
                            for (int bj = 0; bj < 2; ++bj) { const u32x2 p0 = pk4_(v[bj][0]), p1 = pk4_(v[bj][1]); const u32x4 w = {p0.x, p0.y, p1.x, p1.y}; *(u32x4*)(dst + 32 * bj) = w; }
                        }
                    }
                }
        } else {
            const int c0 = 32 * wc + 8 * fq;
            const size_t tbase = ctx ? (size_t)b * 65536 : (size_t)16 * 65536 + (size_t)b * 262144;
            const size_t tsel = pn == 5 ? (size_t)(KMT - UT) : pn == 6 ? (size_t)(VT - UT) : 0;
#pragma unroll
            for (int ai = 0; ai < 2; ++ai)
#pragma unroll
                for (int m = 0; m < 4; ++m) {
                    asm volatile("" ::: "memory"); const int rl = rl0 + ai * 128 + m * 16; const int t = tb + rl; const size_t row = (size_t)pm * 256 + rl; u32x4 gw4 = {0u, 0u, 0u, 0u};
#pragma unroll
                    for (int bj = 0; bj < 2; ++bj)
#pragma unroll
                        for (int n = 0; n < 2; ++n) {
                            const f32x4 x = acc[ai][bj][m][n]; const int c = c0 + 128 * bj;
                            if (pn == 4) { const u32x2 p = pk4_(x); if (n == 0) { gw4[0] = p.x; gw4[1] = p.y; } else { gw4[2] = p.x; gw4[3] = p.y; *(u32x4*)(QM + row * 256 + c) = gw4; } }
                            else if (pn == 5 || pn == 6 || pn == 8) {
                                if (pn == 5) { const u32x2 p = pk4_(x); if (n == 0) { gw4[0] = p.x; gw4[1] = p.y; } else { gw4[2] = p.x; gw4[3] = p.y; *(u32x4*)(KM + row * 256 + c) = gw4; } }
                                PG8_LAS bf16_t* sw = stage + (wr * 4 + wc) * 512;
#pragma unroll
                                for (int j = 0; j < 4; ++j) sw[(8 * fq + 4 * n + j) * 16 + fr] = (bf16_t)f2bf_(x[j]);
                                if (n == 1) {
                                    const int L = fq * 16 + fr; const u32x4 tv = *(const PG8_LAS u32x4*)(sw + (L >> 1) * 16 + (L & 1) * 8);
                                    bf16_t* tp = UT + tsel + tbase + (size_t)(128 * bj + 32 * wc + (L >> 1)) * T + tb + ai * 128 + wr * 64 + m * 16 + (L & 1) * 8;
                                    *(u32x4*)tp = tv;
                                }
                            }
                            else if (pn == 7) { f32x4 s;
#pragma unroll
                                for (int j = 0; j < 4; ++j) s[j] = 1.0f / (1.0f + __expf(-x[j]));
                                const u32x2 p = pk4_(s); if (n == 0) { gw4[0] = p.x; gw4[1] = p.y; } else { gw4[2] = p.x; gw4[3] = p.y; *(u32x4*)(OM + row * 256 + c) = gw4; } }
                            else {
                                unsigned w = 0u;
#pragma unroll
                                for (int j = 0; j < 4; ++j) { const float gq = fmaxf(255.0f * __builtin_amdgcn_rcpf(1.0f + __expf(-x[j])), 1.0f); w = __builtin_amdgcn_cvt_pk_u8_f32(gq, j, w); }
                                gw4[bj * 2 + n] = w;
                                if (bj == 1 && n == 1) *(u32x4*)(BG + ((size_t)(((pn - 9) >> 2) * 48 + pm) * 4 + ((pn - 9) & 3)) * 65536 + (size_t)rl * 256 + (wc * 4 + fq) * 16) = gw4; }
                        }
                }
        }
    }
};

__device__ __forceinline__ f32x4 u8x4_to_f32(unsigned w) { f32x4 r; r[0] = (float)(w & 0xffu); r[1] = (float)((w >> 8) & 0xffu); r[2] = (float)((w >> 16) & 0xffu); r[3] = (float)(w >> 24); return r; }
struct EpiMerge {
    static constexpr bool PERM = false, AFTER_DRAIN = false, HAS_MID = true;
    const unsigned char* BG; bf16_t* O;
    __device__ __forceinline__ void mid(f32x4 (&acc)[2][2][4][2], const Unit& u, int t, int wr, int wc, int fr0, int fq0) const {
        if (t != 8 && t != 12) return;
        int fr = fr0, fq = fq0; asm volatile("" : "+v"(fr), "+v"(fq));
        const int gn = (t == 8) ? 0 : 1, gd = (t == 8) ? 1 : 2;
        const size_t lo = (size_t)(wr * 64 + fr) * 256 + (wc * 4 + fq) * 16;
        const unsigned char* bn0 = BG + ((size_t)(gn * 48 + u.pm) * 4 + u.pn) * 65536 + lo;
        const unsigned char* bd0 = BG + ((size_t)(gd * 48 + u.pm) * 4 + u.pn) * 65536 + lo;
#pragma unroll
        for (int ai = 0; ai < 2; ++ai) {
            u32x4 cn[4], cd[4];
#pragma unroll
            for (int m = 0; m < 4; ++m) { cn[m] = *(const u32x4*)(bn0 + (ai * 128 + m * 16) * 256); cd[m] = *(const u32x4*)(bd0 + (ai * 128 + m * 16) * 256); }
            asm volatile("" ::: "memory");
#pragma unroll
            for (int m = 0; m < 4; ++m)
#pragma unroll
                for (int bj = 0; bj < 2; ++bj)
#pragma unroll
                    for (int n = 0; n < 2; ++n) { const f32x4 en = u8x4_to_f32(cn[m][bj * 2 + n]), ed = u8x4_to_f32(cd[m][bj * 2 + n]); f32x4 f;
#pragma unroll
                        for (int j = 0; j < 4; ++j) f[j] = en[j] * __builtin_amdgcn_rcpf(ed[j]);
                        acc[ai][bj][m][n] = acc[ai][bj][m][n] * f; }
            asm volatile("" ::: "memory");
        }
    }
    __device__ __forceinline__ void operator()(const f32x4 (&acc)[2][2][4][2], const Unit& u, int wr, int wc, int fr0, int fq0) const {
        int fr = fr0, fq = fq0; asm volatile("" : "+v"(fr), "+v"(fq));
        const size_t row0 = (size_t)u.pm * 256 + wr * 64 + fr; const int c0 = u.pn * 256 + 32 * wc + 8 * fq;
        const unsigned char* bf0 = BG + ((size_t)(2 * 48 + u.pm) * 4 + u.pn) * 65536 + (size_t)(wr * 64 + fr) * 256 + (wc * 4 + fq) * 16; bf16_t* op0 = O + row0 * 1024 + c0;
#pragma unroll
        for (int ai = 0; ai < 2; ++ai) {
            u32x4 cf[4];
#pragma unroll
            for (int m = 0; m < 4; ++m) cf[m] = *(const u32x4*)(bf0 + (ai * 128 + m * 16) * 256);
            asm volatile("" ::: "memory");
#pragma unroll
            for (int m = 0; m < 4; ++m) { bf16_t* op = op0 + (size_t)(ai * 128 + m * 16) * 1024;
#pragma unroll
                for (int bj = 0; bj < 2; ++bj) { const f32x4 g0 = u8x4_to_f32(cf[m][bj * 2]) * (1.0f / 255.0f), g1 = u8x4_to_f32(cf[m][bj * 2 + 1]) * (1.0f / 255.0f);
                    const u32x2 p0 = pk4_(acc[ai][bj][m][0] * g0), p1 = pk4_(acc[ai][bj][m][1] * g1); const u32x4 w = {p0.x, p0.y, p1.x, p1.y}; *(u32x4*)(op + 128 * bj) = w; } }
            asm volatile("" ::: "memory");
        }
    }
};

struct EpiRes {
    static constexpr bool PERM = false, AFTER_DRAIN = false, HAS_MID = true;
    int mode;
    unsigned* wflag; unsigned wneed;
    __device__ __forceinline__ void mid(f32x4 (&)[2][2][4][2], const Unit& u, int t, int, int, int, int) const {
        if (t != 38 || wflag == nullptr || u.pm >= 16) return;
        unsigned sp = 0; while (__hip_atomic_load(wflag, __ATOMIC_RELAXED, __HIP_MEMORY_SCOPE_AGENT) < wneed) { __builtin_amdgcn_s_sleep(4); if (++sp > (1u << 22)) break; }
        asm volatile("" ::: "memory");
    }
    const float *xin_p, *xin_s;
    bf16_t* xb;
    float* xout;
    const float* gate;
    __device__ __forceinline__ void operator()(const f32x4 (&acc)[2][2][4][2], const Unit& u, int wr, int wc, int fr0, int fq0) const {
        int fr = fr0, fq = fq0; asm volatile("" : "+v"(fr), "+v"(fq));
        const int pm = u.pm; const int v = pm < 16 ? 0 : 1 + ((pm - 16) >> 2);
        const float* xin = pm < 16 ? xin_p + (size_t)pm * 256 * 1024 : xin_s + (size_t)(pm - 16) * 256 * 1024;
        const int c0 = u.pn * 256 + 32 * wc + 8 * fq;
        f32x4 g4[2][2];
#pragma unroll
        for (int bj = 0; bj < 2; ++bj)
#pragma unroll
            for (int n = 0; n < 2; ++n) g4[bj][n] = *(const f32x4*)(gate + (size_t)v * 6144 + c0 + 128 * bj + 4 * n);
        const size_t r0 = (size_t)pm * 256 + wr * 64 + fr;
        if (mode == 0) {
            const float* xp0 = xin + (size_t)(wr * 64 + fr) * 1024 + c0; bf16_t* op0 = xb + r0 * 1024 + c0;
#pragma unroll
            for (int ai = 0; ai < 2; ++ai) {
                f32x4 cx[4][2][2];
#pragma unroll
                for (int m = 0; m < 4; ++m) { const float* xp = xp0 + (size_t)(ai * 128 + m * 16) * 1024;
#pragma unroll
                    for (int bj = 0; bj < 2; ++bj)
#pragma unroll
                        for (int n = 0; n < 2; ++n) cx[m][bj][n] = *(const f32x4*)(xp + 128 * bj + 4 * n); }
                asm volatile("" ::: "memory");
#pragma unroll
                for (int m = 0; m < 4; ++m) { bf16_t* op = op0 + (size_t)(ai * 128 + m * 16) * 1024;
#pragma unroll
                    for (int bj = 0; bj < 2; ++bj) { const u32x2 p0 = pk4_(cx[m][bj][0] + g4[bj][0] * acc[ai][bj][m][0]), p1 = pk4_(cx[m][bj][1] + g4[bj][1] * acc[ai][bj][m][1]);
                        const u32x4 w = {p0.x, p0.y, p1.x, p1.y}; *(u32x4*)(op + 128 * bj) = w; } }
                asm volatile("" ::: "memory");
            }
        } else {
            const bf16_t* xp0 = xb + r0 * 1024 + c0; float* op0 = xout + r0 * 1024 + c0;
#pragma unroll
            for (int ai = 0; ai < 2; ++ai) {
                u32x4 cx[4][2];
#pragma unroll
                for (int m = 0; m < 4; ++m) { const bf16_t* xp = xp0 + (size_t)(ai * 128 + m * 16) * 1024;
#pragma unroll
                    for (int bj = 0; bj < 2; ++bj) cx[m][bj] = *(const u32x4*)(xp + 128 * bj); }
                asm volatile("" ::: "memory");
#pragma unroll
                for (int m = 0; m < 4; ++m) { float* op = op0 + (size_t)(ai * 128 + m * 16) * 1024;
#pragma unroll
                    for (int bj = 0; bj < 2; ++bj)
#pragma unroll
                        for (int n = 0; n < 2; ++n) { const u32x2 h = {cx[m][bj][2 * n], cx[m][bj][2 * n + 1]}; *(f32x4*)(op + 128 * bj + 4 * n) = bf4_to_f32(h) + g4[bj][n] * acc[ai][bj][m][n]; } }
                asm volatile("" ::: "memory");
            }
        }
    }
};

struct EpiSwiGLU {
    static constexpr bool PERM = false, AFTER_DRAIN = false, HAS_MID = false;
    bf16_t* H;
    __device__ __forceinline__ void operator()(const f32x4 (&acc)[2][2][4][2], const Unit& u, int wr, int wc, int fr0, int fq0) const {
        int fr = fr0, fq = fq0; asm volatile("" : "+v"(fr), "+v"(fq));
        const int c0 = u.pn * 128 + 32 * wc + 8 * fq;
#pragma unroll
        for (int ai = 0; ai < 2; ++ai)
#pragma unroll
            for (int m = 0; m < 4; ++m) {
                asm volatile("" ::: "memory"); const size_t row = (size_t)u.pm * 256 + ai * 128 + wr * 64 + m * 16 + fr; bf16_t* op = H + row * FF + c0; u32x4 w;
#pragma unroll
                for (int n = 0; n < 2; ++n) { const f32x4 g = acc[ai][0][m][n], v = acc[ai][1][m][n]; f32x4 o;
#pragma unroll
                    for (int j = 0; j < 4; ++j) o[j] = g[j] * __builtin_amdgcn_rcpf(1.0f + __expf(-g[j])) * v[j];
                    const u32x2 p = pk4_(o); w[2 * n] = p.x; w[2 * n + 1] = p.y; }
                *(u32x4*)op = w;
            }
    }
};

struct EpiFourier {
    static constexpr bool PERM = false, AFTER_DRAIN = false, HAS_MID = false;
    bf16_t* AC; int lat;
    __device__ __forceinline__ void operator()(const f32x4 (&acc)[2][2][4][2], const Unit& u, int wr, int wc, int fr0, int fq0) const {
        int fr = fr0, fq = fq0; asm volatile("" : "+v"(fr), "+v"(fq));
        const size_t tok0 = lat ? (size_t)4096 + (size_t)u.pn * 1024 : (size_t)u.pn * 256;
        const int T = lat ? 1024 : 256, half = T >> 1;
        const int c0 = 32 * wc + 4 * fq;
#pragma unroll
        for (int ai = 0; ai < 2; ++ai)
#pragma unroll
            for (int m = 0; m < 4; ++m) {
                asm volatile("" ::: "memory");
                const int s = lat ? (u.pm >> 1) : ai; const int tp = lat ? 256 * (u.pm & 1) + ai * 128 + wr * 64 + m * 16 + fr : wr * 64 + m * 16 + fr;
                const bool special = (s == 1 && tp == 0);
                bf16_t* p1 = AC + (tok0 + (special ? half : tp)) * KMRG + 768 + (special ? 0 : 256 * s) + c0;
                bf16_t* p2 = AC + (tok0 + (T - tp)) * KMRG + 768 + 256 * s + c0;
#pragma unroll
                for (int bj = 0; bj < 2; ++bj)
#pragma unroll
                    for (int n = 0; n < 2; ++n) { const f32x4 v = acc[ai][bj][m][n]; const int co = 128 * bj + 16 * n;
                        *(u32x2*)(p1 + co) = pk4_(v);
                        if (tp >= 1) *(u32x2*)(p2 + co) = pk4_(s ? -v : v);
                        if (special) { const u32x2 z = {0u, 0u}; *(u32x2*)(AC + tok0 * KMRG + 1024 + c0 + co) = z; *(u32x2*)(AC + (tok0 + half) * KMRG + 1024 + c0 + co) = z; } }
            }
    }
};

template <class Epi, class Sched, bool ALIGN_EPI = false, bool SP2 = false>
__device__ __forceinline__ void gemm_phase(PG8_LAS unsigned char* lds, const Gemm g, const Sched& S, const Epi& E, const int tid_in, unsigned* prof = nullptr) {
#ifdef PROF_GEMM
    unsigned long long pg_start = 0; if (prof && tid_in == 0) pg_start = __builtin_amdgcn_s_memrealtime();
#endif
    const int tid = tid_in, wid = __builtin_amdgcn_readfirstlane(tid >> 6), lane = tid & 63, wr = wid >> 2, wc = wid & 3, fr = lane & 15, fq = lane >> 4;
    const int K = g.K, nt = K / BK;
    unsigned voffA[2], voffB[2];
#pragma unroll
    for (int i = 0; i < 2; ++i) { int R, C; stage_rc(tid * 16 + i * 8192, R, C); const int Rb = Epi::PERM ? ((R & ~31) + perm32(R & 31)) : R;
        voffA[i] = (unsigned)(R * K + C) * 2u; voffB[i] = (unsigned)(Rb * K + C) * 2u; }
    const size_t kstep = (size_t)(BK * 2);
    const size_t hstep = (size_t)HALF * K * 2;
    const size_t tstep = 2 * hstep;
    const unsigned ldsw = (unsigned)wid * 1024u;
    const int aoff = lds_byte(wr * 64 + fr, fq * 8), boff = lds_byte(wc * 32 + fr, fq * 8);
#define PG8_SA(b, h) (((b) * 2 + (h)) * HTB)
#define PG8_SB(b, h) ((4 + (b) * 2 + (h)) * HTB)
#define PG8_STAGE(bufoff, gbase, voff) do { _Pragma("unroll") for (int _i = 0; _i < 2; ++_i) \
        __builtin_amdgcn_global_load_lds((const unsigned*)((const char*)(gbase) + (voff)[_i]), (PG8_LAS unsigned*)(lds + (bufoff) + ldsw + _i * 8192), 16, 0, 0); } while (0)
#define PG8_LDA(dst, b, h) do { _Pragma("unroll") for (int m = 0; m < 4; ++m) _Pragma("unroll") for (int k = 0; k < 2; ++k) dst[m][k] = *(const PG8_LAS bf16x8*)(lds + PG8_SA(b, h) + aoff + m * 2048 + k * 1024); } while (0)
#define PG8_LDB(dst, b, h) do { _Pragma("unroll") for (int n = 0; n < 2; ++n) _Pragma("unroll") for (int k = 0; k < 2; ++k) dst[n][k] = *(const PG8_LAS bf16x8*)(lds + PG8_SB(b, h) + boff + n * 2048 + k * 1024); } while (0)
#define PG8_MMA(ai, bj, At, Bt) do { __builtin_amdgcn_s_setprio(1); _Pragma("unroll") for (int m = 0; m < 4; ++m) _Pragma("unroll") for (int n = 0; n < 2; ++n) _Pragma("unroll") for (int k = 0; k < 2; ++k) \
        acc[ai][bj][m][n] = __builtin_amdgcn_mfma_f32_16x16x32_bf16(Bt[n][k], At[m][k], acc[ai][bj][m][n], 0, 0, 0); __builtin_amdgcn_s_setprio(0); } while (0)
#define PG8_WAIT_V(n) asm volatile("s_waitcnt vmcnt(" #n ")" ::: "memory")
#define PG8_WAIT_L(n) asm volatile("s_waitcnt lgkmcnt(" #n ")" ::: "memory")
#define PG8_BAR __builtin_amdgcn_s_barrier()
#define PG8_SCHED __builtin_amdgcn_sched_barrier(0)
    Unit cur, nxt; int ui = 0;
    if (!S.next(0, cur)) return;
    f32x4 acc[2][2][4][2];
#pragma unroll
    for (int a = 0; a < 2; ++a)
#pragma unroll
        for (int b = 0; b < 2; ++b)
#pragma unroll
            for (int m = 0; m < 4; ++m)
#pragma unroll
                for (int n = 0; n < 2; ++n) acc[a][b][m][n] = (f32x4){0.f, 0.f, 0.f, 0.f};
    bf16x8 At[4][2], B0[2][2], B1[2][2];
    const char* cA = (const char*)g.A + (size_t)cur.pm * tstep; const char* cB = (const char*)g.Bt + (size_t)cur.pn * tstep;
    S.a_ready(cur);
    if constexpr (SP2) {
        PG8_STAGE(PG8_SB(0, 0), cB, voffB); PG8_STAGE(PG8_SB(0, 1), cB + hstep, voffB); PG8_STAGE(PG8_SA(0, 0), cA, voffA); PG8_STAGE(PG8_SA(0, 1), cA + hstep, voffA);
        if (wr == 1) PG8_BAR;
        PG8_WAIT_V(2); PG8_BAR;
        PG8_STAGE(PG8_SB(1, 0), cB + kstep, voffB); PG8_STAGE(PG8_SA(1, 0), cA + kstep, voffA); PG8_STAGE(PG8_SB(1, 1), cB + hstep + kstep, voffB);
        PG8_WAIT_V(6); PG8_BAR;
    } else {
        PG8_STAGE(PG8_SB(0, 0), cB, voffB); PG8_STAGE(PG8_SA(0, 0), cA, voffA); PG8_STAGE(PG8_SB(0, 1), cB + hstep, voffB); PG8_STAGE(PG8_SA(0, 1), cA + hstep, voffA);
        if (wr == 1) PG8_BAR;
        PG8_WAIT_V(4); PG8_BAR;
        PG8_STAGE(PG8_SB(1, 0), cB + kstep, voffB); PG8_STAGE(PG8_SA(1, 0), cA + kstep, voffA); PG8_STAGE(PG8_SB(1, 1), cB + hstep + kstep, voffB);
        PG8_WAIT_V(6); PG8_BAR;
    }
    for (;;) {
        const bool has_next = S.next(ui + 1, nxt);
        const char* nA = has_next ? (const char*)g.A + (size_t)nxt.pm * tstep : cA; const char* nB = has_next ? (const char*)g.Bt + (size_t)nxt.pn * tstep : cB;
        for (int t = 0; t < nt; t += 2) {
            if constexpr (Epi::HAS_MID) { E.mid(acc, cur, t, wr, wc, fr, fq); }
            const bool last = (t == nt - 2);
            const char* a1 = cA + (size_t)(t + 1) * kstep;
            const char* a2 = last ? nA : cA + (size_t)(t + 2) * kstep; const char* b2 = last ? nB : cB + (size_t)(t + 2) * kstep;
            const char* a3 = a2 + kstep; const char* b3 = b2 + kstep;
            if (last && has_next) S.a_ready(nxt);
            if constexpr (SP2) {
            PG8_LDB(B0, 0, 0); PG8_LDB(B1, 0, 1); PG8_SCHED; PG8_LDA(At, 0, 0); PG8_STAGE(PG8_SA(1, 1), a1 + hstep, voffA);
            PG8_WAIT_V(8); PG8_WAIT_L(0); PG8_BAR; PG8_MMA(0, 0, At, B0); PG8_MMA(0, 1, At, B1); PG8_BAR; PG8_SCHED;
            PG8_LDA(At, 0, 1); PG8_STAGE(PG8_SB(0, 0), b2, voffB); PG8_STAGE(PG8_SB(0, 1), b2 + hstep, voffB); PG8_STAGE(PG8_SA(0, 0), a2, voffA);
            PG8_WAIT_V(8); PG8_WAIT_L(0); PG8_BAR; PG8_MMA(1, 0, At, B0); PG8_MMA(1, 1, At, B1); PG8_BAR; PG8_SCHED;
            PG8_LDB(B0, 1, 0); PG8_LDB(B1, 1, 1); PG8_SCHED; PG8_LDA(At, 1, 0); PG8_STAGE(PG8_SA(0, 1), a2 + hstep, voffA);
            PG8_WAIT_V(8); PG8_WAIT_L(0); PG8_BAR; PG8_MMA(0, 0, At, B0); PG8_MMA(0, 1, At, B1); PG8_BAR; PG8_SCHED;
            PG8_LDA(At, 1, 1); PG8_STAGE(PG8_SB(1, 0), b3, voffB); PG8_STAGE(PG8_SB(1, 1), b3 + hstep, voffB); PG8_STAGE(PG8_SA(1, 0), a3, voffA);
            PG8_WAIT_V(8); PG8_WAIT_L(0); PG8_BAR; PG8_MMA(1, 0, At, B0); PG8_MMA(1, 1, At, B1); PG8_BAR; PG8_SCHED;
            } else {
            PG8_LDB(B0, 0, 0); PG8_SCHED; PG8_LDA(At, 0, 0); PG8_STAGE(PG8_SA(1, 1), a1 + hstep, voffA);
            PG8_WAIT_L(8); PG8_BAR; PG8_WAIT_L(0); PG8_MMA(0, 0, At, B0); PG8_BAR; PG8_SCHED;
            PG8_LDB(B1, 0, 1); PG8_STAGE(PG8_SB(0, 0), b2, voffB);
            PG8_BAR; PG8_WAIT_L(0); PG8_MMA(0, 1, At, B1); PG8_BAR;
            PG8_LDA(At, 0, 1); PG8_STAGE(PG8_SA(0, 0), a2, voffA);
            PG8_BAR; PG8_WAIT_L(0); PG8_MMA(1, 0, At, B0); PG8_BAR; PG8_SCHED;
            PG8_STAGE(PG8_SB(0, 1), b2 + hstep, voffB);
            PG8_WAIT_V(6); PG8_BAR; PG8_MMA(1, 1, At, B1); PG8_BAR;
            PG8_LDB(B0, 1, 0); PG8_SCHED; PG8_LDA(At, 1, 0); PG8_STAGE(PG8_SA(0, 1), a2 + hstep, voffA);
            PG8_WAIT_L(8); PG8_BAR; PG8_WAIT_L(0); PG8_MMA(0, 0, At, B0); PG8_BAR; PG8_SCHED;
            PG8_LDB(B1, 1, 1); PG8_STAGE(PG8_SB(1, 0), b3, voffB);
            PG8_BAR; PG8_WAIT_L(0); PG8_MMA(0, 1, At, B1); PG8_BAR;
            PG8_LDA(At, 1, 1); PG8_STAGE(PG8_SA(1, 0), a3, voffA);
            PG8_BAR; PG8_WAIT_L(0); PG8_MMA(1, 0, At, B0); PG8_BAR; PG8_SCHED;
            PG8_STAGE(PG8_SB(1, 1), b3 + hstep, voffB);
            PG8_WAIT_V(6); PG8_BAR; PG8_MMA(1, 1, At, B1); PG8_BAR;
            }
        }
        if constexpr (ALIGN_EPI) { if (wr == 0) PG8_BAR; }
#ifdef PROF_GEMM
        unsigned long long pg_t0 = 0; if (prof && tid == 0) pg_t0 = __builtin_amdgcn_s_memrealtime();
#endif
        if constexpr (!Epi::AFTER_DRAIN) { E(acc, cur, wr, wc, fr, fq); S.done(cur); }
#ifdef PROF_GEMM
#ifndef PROF_PN_LO
#define PROF_PN_LO 0
#define PROF_PN_HI 1000
#endif
        if (prof && tid == 0 && cur.pn >= PROF_PN_LO && cur.pn <= PROF_PN_HI) { atomicAdd(prof, (unsigned)(__builtin_amdgcn_s_memrealtime() - pg_t0)); atomicAdd(prof + 1, 1u); }
#endif
        if (!has_next) break;
#pragma unroll
        for (int a = 0; a < 2; ++a)
#pragma unroll
            for (int b = 0; b < 2; ++b)
#pragma unroll
                for (int m = 0; m < 4; ++m)
#pragma unroll
                    for (int n = 0; n < 2; ++n) acc[a][b][m][n] = (f32x4){0.f, 0.f, 0.f, 0.f};
        cur = nxt; cA = nA; cB = nB; ++ui;
        if constexpr (ALIGN_EPI) { if (wr == 1) PG8_BAR; }
    }
    PG8_WAIT_V(0);
    if constexpr (!ALIGN_EPI) { if (wr == 0) PG8_BAR; }
    PG8_BAR;
    if constexpr (Epi::AFTER_DRAIN) { E.fused(acc, cur, wr, wc, fr, fq, lds, wid, lane); S.done(cur); }
#ifdef PROF_GEMM
    if (prof && tid == 0) { atomicAdd(prof + 2, (unsigned)(__builtin_amdgcn_s_memrealtime() - pg_start)); atomicAdd(prof + 3, 1u); }
#endif
#undef PG8_SA
#undef PG8_SB
#undef PG8_STAGE
#undef PG8_LDA
#undef PG8_LDB
#undef PG8_MMA
#undef PG8_WAIT_V
#undef PG8_WAIT_L
#undef PG8_BAR
#undef PG8_SCHED
}
}

#define ATTN_STORE16(p,v) (*(u32x4*)(p)=(v))

#include <hip/hip_bf16.h>
#include <cmath>
namespace attn_body {
using bf16=__hip_bfloat16;
using bf16x8=__attribute__((ext_vector_type(8)))short;
using s16x4=__attribute__((ext_vector_type(4)))short;
using f32x16=__attribute__((ext_vector_type(16)))float;
using u32x4=__attribute__((ext_vector_type(4)))unsigned;
constexpr int D=64;
constexpr int NW=8,QBLK=32,QB=QBLK*NW,KVBLK=64;
constexpr int ATTN_UNIT_ROWS=QB;
__device__ __forceinline__ int crow(int r,int hi){return (r&3)+8*(r>>2)+4*hi;}
#define SBAR() __builtin_amdgcn_sched_barrier(0)
__device__ __forceinline__ void cmask(f32x16&p0,f32x16&p1,int jb,int qrel,int hi){
  const float NEG=-INFINITY; int kb=64*jb+4*hi;
  #pragma unroll
  for(int r=0;r<16;++r){int kv=kb+(r&3)+8*(r>>2); if(kv>qrel)p0[r]=NEG; if(kv+32>qrel)p1[r]=NEG;}
}

constexpr int NSLOT=3, SLOTB=8192;
constexpr int LDS_K=0, LDS_V=NSLOT*SLOTB, LDS_WS=2*NSLOT*SLOTB, LDS_OST=LDS_WS+NW*64*4, LDS_BYTES=LDS_OST+NW*4096;
constexpr float C2=0.125f*1.4426950408889634f;
__device__ __forceinline__ void glds16(const void*gsrc,unsigned lds_dst){unsigned keep;
  asm volatile("s_mov_b32 %0, m0\n\ts_mov_b32 m0, %2\n\ts_nop 0\n\tglobal_load_lds_dwordx4 %1, off\n\ts_mov_b32 m0, %0":"=&s"(keep):"v"(gsrc),"s"(lds_dst):"memory");}
__device__ __forceinline__ float max3f(float a,float b,float c){float r;asm("v_max3_f32 %0, %1, %2, %3":"=v"(r):"v"(a),"v"(b),"v"(c));return r;}
__device__ __forceinline__ float max2f(float a,float b){float r;asm("v_max_f32_e32 %0, %1, %2":"=v"(r):"v"(a),"v"(b));return r;}
__device__ __forceinline__ float fadd_s(float a,float b){float r;asm("v_add_f32_e32 %0, %1, %2":"=v"(r):"v"(a),"v"(b));return r;}
__device__ __forceinline__ float fsub_s(float a,float b){float r;asm("v_sub_f32_e32 %0, %1, %2":"=v"(r):"v"(a),"v"(b));return r;}
typedef float f32x2_t __attribute__((ext_vector_type(2))); typedef __bf16 bf16x2_t __attribute__((ext_vector_type(2)));
__device__ __forceinline__ unsigned cvtpk_s(float lo,float hi){f32x2_t v={lo,hi};bf16x2_t b=__builtin_convertvector(v,bf16x2_t);return __builtin_bit_cast(unsigned,b);}
#define WAIT_BAR(N) asm volatile("s_waitcnt vmcnt(" #N ") lgkmcnt(0)\n\ts_barrier":::"memory")

__device__ __forceinline__ void qkt(f32x16&p0,f32x16&p1,const char*Kslot,const bf16x8*qr,const f32x16&negm,int r32,int hi){
  const char*kb=Kslot+hi*1024+r32*16;
  #pragma unroll
  for(int d0=0;d0<4;++d0){
    const bf16x8 b0=*reinterpret_cast<const bf16x8*>(kb+d0*2048);
    const bf16x8 b1=*reinterpret_cast<const bf16x8*>(kb+d0*2048+512);
    if(d0==0){p0=__builtin_amdgcn_mfma_f32_32x32x16_bf16(b0,qr[0],negm,0,0,0);p1=__builtin_amdgcn_mfma_f32_32x32x16_bf16(b1,qr[0],negm,0,0,0);}
    else{p0=__builtin_amdgcn_mfma_f32_32x32x16_bf16(b0,qr[d0],p0,0,0,0);p1=__builtin_amdgcn_mfma_f32_32x32x16_bf16(b1,qr[d0],p1,0,0,0);}}
}
typedef __attribute__((address_space(3))) const char* lds_cptr;
typedef short v4i16_t __attribute__((ext_vector_type(4)));
__device__ __forceinline__ void kload8(bf16x8*kf,lds_cptr kp){
  kf[0]=*(const __attribute__((address_space(3))) bf16x8*)(kp);      kf[1]=*(const __attribute__((address_space(3))) bf16x8*)(kp+512);
  kf[2]=*(const __attribute__((address_space(3))) bf16x8*)(kp+2048); kf[3]=*(const __attribute__((address_space(3))) bf16x8*)(kp+2560);
  kf[4]=*(const __attribute__((address_space(3))) bf16x8*)(kp+4096); kf[5]=*(const __attribute__((address_space(3))) bf16x8*)(kp+4608);
  kf[6]=*(const __attribute__((address_space(3))) bf16x8*)(kp+6144); kf[7]=*(const __attribute__((address_space(3))) bf16x8*)(kp+6656);
}
__device__ __forceinline__ void kload2(bf16x8*kf,lds_cptr kp,int j){ kf[2*j]=*(const __attribute__((address_space(3))) bf16x8*)(kp+j*2048); kf[2*j+1]=*(const __attribute__((address_space(3))) bf16x8*)(kp+j*2048+512); }
__device__ __forceinline__ s16x4 vtr(lds_cptr p){ return __builtin_bit_cast(s16x4,__builtin_amdgcn_ds_read_tr16_b64_v4i16((__attribute__((address_space(3))) v4i16_t*)p)); }
__device__ __forceinline__ float rowmax(const f32x16&p0,const f32x16&p1){
  float a=max3f(p0[0],p0[1],p1[0]),b=max3f(p0[2],p0[3],p1[1]);a=max3f(a,p1[2],p1[3]);
  #pragma unroll
  for(int r=4;r<16;r+=4){a=max3f(a,p0[r],p0[r+1]);b=max3f(b,p0[r+2],p0[r+3]);a=max3f(a,p1[r],p1[r+1]);b=max3f(b,p1[r+2],p1[r+3]);}
  const float m=max2f(a,b);
  auto rr=__builtin_amdgcn_permlane32_swap(__float_as_uint(m),__float_as_uint(m),false,false);
  return max2f(__uint_as_float(rr[0]),__uint_as_float(rr[1]));
}
__device__ __forceinline__ void pv(f32x16*o,int vb,bf16x8 pa0,bf16x8 pa1,bf16x8 pa2,bf16x8 pa3){
  #pragma unroll
  for(int d0=0;d0<2;++d0){s16x4 lo[4],hi[4];
    #pragma unroll
    for(int ks=0;ks<4;++ks){
      asm volatile("ds_read_b64_tr_b16 %0,%1 offset:%c2":"=&v"(lo[ks]):"v"(vb),"i"(d0*4096+ks*1024):"memory");
      asm volatile("ds_read_b64_tr_b16 %0,%1 offset:%c2":"=&v"(hi[ks]):"v"(vb),"i"(d0*4096+ks*1024+512):"memory");}
    asm volatile("s_waitcnt lgkmcnt(0)":::"memory");SBAR();
    #define PK(k) (bf16x8){lo[k][0],lo[k][1],lo[k][2],lo[k][3],hi[k][0],hi[k][1],hi[k][2],hi[k][3]}
    o[d0]=__builtin_amdgcn_mfma_f32_32x32x16_bf16(pa0,PK(0),o[d0],0,0,0);
    o[d0]=__builtin_amdgcn_mfma_f32_32x32x16_bf16(pa1,PK(1),o[d0],0,0,0);
    o[d0]=__builtin_amdgcn_mfma_f32_32x32x16_bf16(pa2,PK(2),o[d0],0,0,0);
    o[d0]=__builtin_amdgcn_mfma_f32_32x32x16_bf16(pa3,PK(3),o[d0],0,0,0);
    #undef PK
  }
}

#ifndef ATTN_STORE16
#define ATTN_STORE16(p,v) (*(u32x4*)(p)=(v))
#endif
template<int THRL> __device__ __forceinline__ void attn_unit(const bf16*Qb,int QP,const bf16*__restrict__ Kh,const bf16*__restrict__ Vh,int KP,int NT,bf16*Ob,int OP,char*shm,const int tid_in){
  const int tid=tid_in,lane=tid&63,r32=lane&31,hi=lane>>5; const int wid=__builtin_amdgcn_readfirstlane(tid>>6);
  const bf16*Qw=Qb+(long)(wid*QBLK)*QP;
  const unsigned lds0=(unsigned)(uintptr_t)shm;
  float*wsf=(float*)(shm+LDS_WS)+wid*64;
  const bf16*ksrc=Kh+(long)lane*KP+wid*8;
  const bf16*vsrc=Vh+(long)(16*(wid&3)+(lane>>2))*KP+(wid>>2)*32+(lane&3)*8;
  const unsigned kdst=lds0+LDS_K+wid*1024, vdst=lds0+LDS_V+wid*1024;
  #define DMA_K(t,slot) glds16(ksrc+(long)(t)*KVBLK*KP,(unsigned)__builtin_amdgcn_readfirstlane(kdst+(slot)))
  #define DMA_V(t,slot) glds16(vsrc+(long)(t)*KVBLK*KP,(unsigned)__builtin_amdgcn_readfirstlane(vdst+(slot)))
  const int vb0=(int)(lds0+LDS_V)+((lane>>4)&1)*32+(lane&3)*8+(4*hi+((lane&15)>>2))*64;
  const char*Kbase=shm+LDS_K; bf16x8 kf[8];
  const lds_cptr shm3=(lds_cptr)shm; const lds_cptr kp0=shm3+LDS_K+hi*1024+r32*16; const lds_cptr vp0=shm3+LDS_V+((lane>>4)&1)*32+(lane&3)*8+(4*hi+((lane&15)>>2))*64;
  DMA_K(0,0);DMA_V(0,0);DMA_K(1,SLOTB);
  bf16x8 qr[4];
  #pragma unroll
  for(int d0=0;d0<4;++d0)qr[d0]=*reinterpret_cast<const bf16x8*>(&Qw[(long)r32*QP+d0*16+hi*8]);
  float mhat=0.f,l_reg=0.f;f32x16 o[2];o[0]=f32x16{};o[1]=f32x16{};f32x16 negm=f32x16{};asm volatile("":"+v"(negm));
  #define CMASK(P0,P1,t) do{}while(0)
  bool resc=false;
  #define START(P0,P1) do{ const float rm=rowmax(P0,P1); resc=false; \
    { const float dl=rm; mhat=fadd_s(mhat,dl); \
      _Pragma("unroll") for(int r=0;r<16;++r){P0[r]=fsub_s(P0[r],dl);P1[r]=fsub_s(P1[r],dl);} \
      _Pragma("unroll") for(int r=0;r<16;++r)negm[r]=-mhat; asm volatile("":"+v"(negm)); } \
    _Pragma("unroll") for(int r=0;r<16;++r)P0[r]=__builtin_amdgcn_exp2f(P0[r]); }while(0)
  #define RESC() do{ if(resc){ asm volatile("s_waitcnt lgkmcnt(0)":::"memory"); \
      _Pragma("unroll") for(int d_=0;d_<2;++d_) _Pragma("unroll") for(int r=0;r<16;++r)o[d_][r]*=wsf[crow(r,hi)]; } }while(0)
  f32x16 pA0,pA1,pB0,pB1;
  int sl_prev=0,sl_cur=0,sl_next=SLOTB;
  #define ROT() do{sl_prev=sl_cur;sl_cur=sl_next;sl_next=(sl_next==(NSLOT-1)*SLOTB)?0:sl_next+SLOTB;}while(0)
  DMA_K(2,2*SLOTB);
  WAIT_BAR(3);
  qkt(pA0,pA1,Kbase,qr,negm,r32,hi);asm volatile("s_nop 15\n\ts_nop 7":"+v"(pA0),"+v"(pA1));CMASK(pA0,pA1,0);
  START(pA0,pA1);
  _Pragma("unroll") for(int r=0;r<16;++r)pA1[r]=__builtin_amdgcn_exp2f(pA1[r]);
  WAIT_BAR(0);
  DMA_K(3,0);DMA_V(1,SLOTB);
  ROT();
  kload8(kf,kp0+sl_cur);
  WAIT_BAR(2);
  s16x4 vlo[8],vhi[8]; u32x4 pw0,pw1,pw2,pw3;
  #define PKW(P,B) cvtpk_s(P[B],P[B+1])
  #define PAF(k) __builtin_bit_cast(bf16x8,pw##k)
  #define VFR(i) (bf16x8){vlo[i][0],vlo[i][1],vlo[i][2],vlo[i][3],vhi[i][0],vhi[i][1],vhi[i][2],vhi[i][3]}
  #define PIN(x) asm volatile("":"+v"(x))
  #define MX3(a,b,c) __builtin_fmaxf(__builtin_fmaxf((a),(b)),(c))
  #define GAPA(MF,A0,A1,A2,A3,W0,W1,PW) do{ MF; sacc+=A0; sacc+=A1; sacc+=A2; sacc+=A3; PIN(sacc); W0; W1; PIN(PW); SBAR(); }while(0)
  #define EX(v) __builtin_amdgcn_exp2f(v)
  #define GAPB(MF,X,B) do{ MF; X[B]=EX(X[B]); X[B+1]=EX(X[B+1]); X[B+2]=EX(X[B+2]); X[B+3]=EX(X[B+3]); PIN(X); SBAR(); }while(0)
  #define VRD(i) do{ vlo[i]=vtr(vp_+(((i)>>2)*4096+((i)&3)*1024)); vhi[i]=vtr(vp_+(((i)>>2)*4096+((i)&3)*1024+512)); }while(0)
  #define KRD(G,j) do{ if(G){ kload2(kf,kp0+sl_next,j); SBAR(); } }while(0)
  #define STEP(C0,C1,P0,P1,t,GK,GV,GL) do{ SBAR(); \
    const lds_cptr vp_=vp0+sl_prev; \
    VRD(0); SBAR(); float sacc=(P0[0]+P0[1]); \
    GAPA(C0=__builtin_amdgcn_mfma_f32_32x32x16_bf16(kf[0],qr[0],negm,0,0,0), P0[2],P0[3],P0[4],P0[5],     pw0[0]=PKW(P0,0), pw0[1]=PKW(P0,2), pw0); \
    VRD(4); SBAR(); GAPA(C1=__builtin_amdgcn_mfma_f32_32x32x16_bf16(kf[1],qr[0],negm,0,0,0), P0[6],P0[7],P0[8],P0[9],     pw0[2]=PKW(P0,4), pw0[3]=PKW(P0,6), pw0); \
    VRD(1); SBAR(); GAPA(C0=__builtin_amdgcn_mfma_f32_32x32x16_bf16(kf[2],qr[1],C0,0,0,0),   P0[10],P0[11],P0[12],P0[13], pw1[0]=PKW(P0,8), pw1[1]=PKW(P0,10), pw1); \
    VRD(5); SBAR(); GAPA(C1=__builtin_amdgcn_mfma_f32_32x32x16_bf16(kf[3],qr[1],C1,0,0,0),   P0[14],P0[15],P1[0],P1[1],   pw1[2]=PKW(P0,12),pw1[3]=PKW(P0,14), pw1); \
    VRD(2); SBAR(); GAPA(C0=__builtin_amdgcn_mfma_f32_32x32x16_bf16(kf[4],qr[2],C0,0,0,0),   P1[2],P1[3],P1[4],P1[5],     pw2[0]=PKW(P1,0), pw2[1]=PKW(P1,2), pw2); \
    VRD(6); SBAR(); GAPA(C1=__builtin_amdgcn_mfma_f32_32x32x16_bf16(kf[5],qr[2],C1,0,0,0),   P1[6],P1[7],P1[8],P1[9],     pw2[2]=PKW(P1,4), pw2[3]=PKW(P1,6), pw2); \
    VRD(3); SBAR(); GAPA(C0=__builtin_amdgcn_mfma_f32_32x32x16_bf16(kf[6],qr[3],C0,0,0,0),   P1[10],P1[11],P1[12],P1[13], pw3[0]=PKW(P1,8), pw3[1]=PKW(P1,10), pw3); \
    VRD(7); SBAR(); GAPA(C1=__builtin_amdgcn_mfma_f32_32x32x16_bf16(kf[7],qr[3],C1,0,0,0),   P1[14],P1[15],0.f,0.f,       pw3[2]=PKW(P1,12),pw3[3]=PKW(P1,14), pw3); \
    l_reg+=sacc; \
    if(GK){DMA_K((t)+3,sl_cur);} if(GV){DMA_V((t)+1,sl_next);} \
    CMASK(C0,C1,t); \
    { float a=MX3(C0[0],C0[1],C1[0]),b=MX3(C0[2],C0[3],C1[1]); a=MX3(a,C1[2],C1[3]); \
      _Pragma("unroll") for(int r=4;r<16;r+=4){a=MX3(a,C0[r],C0[r+1]);b=MX3(b,C0[r+2],C0[r+3]);a=MX3(a,C1[r],C1[r+1]);b=MX3(b,C1[r+2],C1[r+3]);} \
      float rm=__builtin_fmaxf(a,b); { auto rr=__builtin_amdgcn_permlane32_swap(__float_as_uint(rm),__float_as_uint(rm),false,false); rm=__builtin_fmaxf(__uint_as_float(rr[0]),__uint_as_float(rr[1])); } \
      resc=false; \
      if(__builtin_expect(__any(rm>(float)THRL),0)){ const float dl=__builtin_fmaxf(rm,0.f); mhat+=dl; \
        _Pragma("unroll") for(int r=0;r<16;++r){C0[r]-=dl;C1[r]-=dl;} \
        _Pragma("unroll") for(int r=0;r<16;++r)negm[r]=-mhat; asm volatile("":"+v"(negm)); \
        const float f=__builtin_amdgcn_exp2f(-dl); l_reg*=f; if(hi==0)wsf[r32]=f; resc=true; } } \
    SBAR(); \
    GAPB(o[0]=__builtin_amdgcn_mfma_f32_32x32x16_bf16(PAF(0),VFR(0),o[0],0,0,0), C0,0); \
    GAPB(o[1]=__builtin_amdgcn_mfma_f32_32x32x16_bf16(PAF(0),VFR(4),o[1],0,0,0), C0,4); \
    KRD(GL,0); GAPB(o[0]=__builtin_amdgcn_mfma_f32_32x32x16_bf16(PAF(1),VFR(1),o[0],0,0,0), C0,8); \
    KRD(GL,1); GAPB(o[1]=__builtin_amdgcn_mfma_f32_32x32x16_bf16(PAF(1),VFR(5),o[1],0,0,0), C0,12); \
    KRD(GL,2); GAPB(o[0]=__builtin_amdgcn_mfma_f32_32x32x16_bf16(PAF(2),VFR(2),o[0],0,0,0), C1,0); \
    KRD(GL,3); GAPB(o[1]=__builtin_amdgcn_mfma_f32_32x32x16_bf16(PAF(2),VFR(6),o[1],0,0,0), C1,4); \
    GAPB(o[0]=__builtin_amdgcn_mfma_f32_32x32x16_bf16(PAF(3),VFR(3),o[0],0,0,0), C1,8); \
    GAPB(o[1]=__builtin_amdgcn_mfma_f32_32x32x16_bf16(PAF(3),VFR(7),o[1],0,0,0), C1,12); \
    }while(0)
  int t=1;
  #undef CMASK
  #define CMASK(P0,P1,t) do{}while(0)
  for(;t+5<NT;t+=2){
    STEP(pB0,pB1,pA0,pA1,t,true,true,true);     WAIT_BAR(2); RESC(); ROT();
    STEP(pA0,pA1,pB0,pB1,t+1,true,true,true);   WAIT_BAR(2); RESC(); ROT();
  }
  #undef CMASK
  #define CMASK(P0,P1,t) do{}while(0)
  #define ENDW(tt) do{ if((tt)+3<NT){WAIT_BAR(2);} else if((tt)+2<NT){WAIT_BAR(1);} else {WAIT_BAR(0);} }while(0)
  for(;t+1<NT;t+=2){
    STEP(pB0,pB1,pA0,pA1,t,(t+3<NT),(t+1<NT),(t+1<NT));       ENDW(t);   RESC(); ROT();
    STEP(pA0,pA1,pB0,pB1,t+1,(t+4<NT),(t+2<NT),(t+2<NT));     ENDW(t+1); RESC(); ROT();
  }
  STEP(pB0,pB1,pA0,pA1,NT-1,false,false,false); RESC();
  { float sacc=pB0[0]+pB0[1]; _Pragma("unroll") for(int r=2;r<16;++r)sacc+=pB0[r]; _Pragma("unroll") for(int r=0;r<16;++r)sacc+=pB1[r]; l_reg+=sacc;
    pw0=(u32x4){PKW(pB0,0),PKW(pB0,2),PKW(pB0,4),PKW(pB0,6)};pw1=(u32x4){PKW(pB0,8),PKW(pB0,10),PKW(pB0,12),PKW(pB0,14)};pw2=(u32x4){PKW(pB1,0),PKW(pB1,2),PKW(pB1,4),PKW(pB1,6)};pw3=(u32x4){PKW(pB1,8),PKW(pB1,10),PKW(pB1,12),PKW(pB1,14)};
    SBAR(); pv(o,vb0+sl_cur,PAF(0),PAF(1),PAF(2),PAF(3)); }
  #undef PKW
  #undef PAF
  #undef VFR
  #undef PIN
  #undef MX3
  #undef GAPA
  #undef GAPB
  #undef EX
  #undef VRD
  #undef KRD
  #undef STEP
  #undef ENDW
  {auto rr=__builtin_amdgcn_permlane32_swap(__float_as_uint(l_reg),__float_as_uint(l_reg),false,false);l_reg=__uint_as_float(rr[0])+__uint_as_float(rr[1]);}
  if(hi==0)wsf[32+r32]=l_reg;asm volatile("s_waitcnt lgkmcnt(0)":::"memory");
  float rli[16];
  #pragma unroll
  for(int r=0;r<16;++r)rli[r]=__builtin_amdgcn_rcpf(wsf[32+crow(r,hi)]);
  bf16*Ow=Ob+(long)(wid*QBLK)*OP;
  { bf16*stg=(bf16*)(shm+LDS_OST)+wid*2048;
    #pragma unroll
    for(int r=0;r<16;++r){const int orow=crow(r,hi);
      #pragma unroll
      for(int d0=0;d0<2;++d0)stg[orow*64+d0*32+r32]=__float2bfloat16(o[d0][r]*rli[r]);}
    asm volatile("s_waitcnt lgkmcnt(0)":::"memory");
    #pragma unroll
    for(int i=0;i<4;++i){const int row=i*8+(lane>>3),ch=lane&7; const u32x4 v=*(const u32x4*)(stg+row*64+ch*8); ATTN_STORE16(Ow+(long)row*OP+ch*8,v);} }
  asm volatile("s_waitcnt lgkmcnt(0)\n\ts_barrier":::"memory");
  #undef DMA_K
  #undef DMA_V
  #undef CMASK
  #undef START
  #undef RESC
  #undef ROT
}
constexpr int ATTN_LDS_BYTES=LDS_BYTES;
#undef SBAR
#undef WAIT_BAR
}

#define GAS __attribute__((address_space(1)))
#define LAS __attribute__((address_space(3)))
typedef unsigned short bf16;
typedef unsigned v4u __attribute__((ext_vector_type(4)));
typedef float f32x4 __attribute__((ext_vector_type(4)));
typedef short bf16x8 __attribute__((ext_vector_type(8)));
typedef GAS unsigned gu32;
typedef GAS unsigned long long gu64;
#define RLX_AGENT __ATOMIC_RELAXED, __HIP_MEMORY_SCOPE_AGENT
#define LDS_WAIT() asm volatile("s_waitcnt lgkmcnt(0)" ::: "memory")
#define VM_WAIT() asm volatile("s_waitcnt vmcnt(0)" ::: "memory")
__device__ __forceinline__ unsigned long long rt() { return __builtin_amdgcn_s_memrealtime(); }
__device__ __forceinline__ unsigned f2bf(float f) { unsigned u = __builtin_bit_cast(unsigned, f); return (u + 0x7fffu + ((u >> 16) & 1u)) >> 16; }
typedef __bf16 bf16x2g_t __attribute__((ext_vector_type(2))); typedef float f32x2g_t __attribute__((ext_vector_type(2)));
__device__ __forceinline__ unsigned pk2(float lo, float hi) { f32x2g_t v = {lo, hi}; return __builtin_bit_cast(unsigned, __builtin_convertvector(v, bf16x2g_t)); }

#define XB_TMO      128
#define XB_XCNT(j)  (256  + 64 * (j))
#define XB_XSUB(j)  (1280 + 64 * (j))
#define XB_XGEN(j)  (2304 + 64 * (j))
#define XB_TOP      3328
#define XB_TOPGEN   3392
#define XCD_BAR_WORDS 3456
#define XB_SPIN_CAP (1u << 18)

__device__ __forceinline__ unsigned xb_ld(unsigned* p)              { return __hip_atomic_load(p, __ATOMIC_RELAXED, __HIP_MEMORY_SCOPE_AGENT); }
__device__ __forceinline__ unsigned xb_add(unsigned* p, unsigned v) { return __hip_atomic_fetch_add(p, v, __ATOMIC_RELAXED, __HIP_MEMORY_SCOPE_AGENT); }
__device__ __forceinline__ unsigned xb_xcc_id() { return (unsigned)__builtin_amdgcn_s_getreg((3 << 11) | 20) & 0xFu; }
#define XB_SPIN(cond, bar) do { unsigned _sp = 0; while (cond) { __builtin_amdgcn_s_sleep(1); \
    if ((++_sp & 255u) == 0u) { if (xb_ld(&(bar)[XB_TMO])) break; if (_sp > XB_SPIN_CAP) { atomicAdd(&(bar)[XB_TMO], 1u); break; } } } } while (0)

struct XcdBarrier {
    unsigned* bar; unsigned x;
    volatile LAS unsigned* st;
};

__device__ __forceinline__ XcdBarrier xcd_barrier_post(unsigned* bar, volatile LAS unsigned* st) {
    XcdBarrier b; b.bar = bar; b.x = xb_xcc_id(); b.st = st;
    if (threadIdx.x == 0) (void)xb_add(&bar[XB_XCNT(b.x)], 1u);
    return b;
}
__device__ __forceinline__ void xcd_barrier_complete(unsigned* bar, unsigned x, unsigned& nloc, unsigned& nx) {
    const unsigned G = gridDim.x * gridDim.y * gridDim.z;
    unsigned sum, cnt, mine, sp = 0u;
    for (;;) {
        sum = 0u; cnt = 0u; mine = 0u;
#pragma unroll
        for (unsigned j = 0; j < 16; ++j) { const unsigned c = xb_ld(&bar[XB_XCNT(j)]); sum += c; cnt += (c > 0u) ? 1u : 0u; mine = (j == x) ? c : mine; }
        if (sum == G) break;
        __builtin_amdgcn_s_sleep(1);
        if ((++sp & 255u) == 0u) { if (xb_ld(&bar[XB_TMO])) break; if (sp > XB_SPIN_CAP) { atomicAdd(&bar[XB_TMO], 1u); break; } }
    }
    nloc = mine > 0u ? mine : 1u; nx = cnt > 0u ? cnt : 1u;
}

__device__ __forceinline__ void xcd_barrier(const XcdBarrier& b) {
    asm volatile("s_waitcnt vmcnt(0)" ::: "memory");
    __syncthreads();
    if (threadIdx.x == 0) {
        unsigned* bar = b.bar;
        __builtin_amdgcn_s_waitcnt(0);
        unsigned nloc = b.st[0], nx = b.st[1];
        if (nloc == 0u) { xcd_barrier_complete(bar, b.x, nloc, nx); b.st[0] = nloc; b.st[1] = nx; }
        asm volatile("buffer_inv sc1" ::: "memory");
        const unsigned old = xb_add(&bar[XB_XSUB(b.x)], 1u);
        const unsigned gen = old / nloc;
        if (old == gen * nloc || old == gen * nloc + (nloc >> 1))
            asm volatile("buffer_wbl2 sc1" ::: "memory");
        if (old + 1u == (gen + 1u) * nloc) {
            __builtin_amdgcn_fence(__ATOMIC_RELEASE, "agent");
            asm volatile("s_waitcnt vmcnt(0)" ::: "memory");
            const unsigned og = xb_add(&bar[XB_TOP], 1u);
            const unsigned tg = og / nx;
            if (og + 1u == (tg + 1u) * nx) xb_add(&bar[XB_TOPGEN], 1u);
            else XB_SPIN(xb_ld(&bar[XB_TOPGEN]) == tg, bar);
            asm volatile("" ::: "memory");
            xb_add(&bar[XB_XGEN(b.x)], 1u);
            asm volatile("s_waitcnt vmcnt(0)" ::: "memory");
        } else {
            XB_SPIN(xb_ld(&bar[XB_XGEN(b.x)]) == gen, bar);
            asm volatile("" ::: "memory");
            asm volatile("s_waitcnt vmcnt(0)" ::: "memory");
        }
    }
    __syncthreads();
}

constexpr int NWAVES = 8;
constexpr int N_LAUNCHES = MK_N_LAUNCHES;
constexpr int N_PHASES = 17;
typedef unsigned u32x2 __attribute__((ext_vector_type(2)));
typedef float f32x2v __attribute__((ext_vector_type(2)));

struct Frame {
    unsigned char* lds;
    LAS unsigned char* ldsl;
    volatile LAS unsigned* MISC;
    gu32* ctl;
    int tid, lane, wave, vcu, G;
    unsigned char* ws; float* out;
};
struct Args { const float* in[25]; float* out; unsigned char* ws; int ph_lo, ph_hi, li, pad; };
#define F_x_prompt (A.in[0])
#define F_x_sample (A.in[1])
#define F_cache_k (A.in[2])
#define F_cache_v (A.in[3])
#define F_state_C (A.in[4])
#define F_state_n (A.in[5])
#define F_state_m (A.in[6])
#define F_c (A.in[7])
#define F_c_ctx (A.in[8])
#define F_w_ada (A.in[9])
#define F_b_ada (A.in[10])
#define F_norm1_g (A.in[11])
#define F_w_in (A.in[12])
#define F_q_norm_g (A.in[13])
#define F_k_norm_g (A.in[14])
#define F_m_conv_w (A.in[15])
#define F_m_gate_b (A.in[16])
#define F_m_norm_g (A.in[17])
#define F_w_pa (A.in[18])
#define F_w_pm (A.in[19])
#define F_w_pf (A.in[20])
#define F_w_out (A.in[21])
#define F_norm2_g (A.in[22])
#define F_w_f1 (A.in[23])
#define F_w_f2 (A.in[24])
#define F_out (F.out)
#define WSP(T, off) ((T*)(F.ws + (off)))

__device__ __forceinline__ float wave_sum(float v) {
#pragma unroll
    for (int o = 1; o < 64; o <<= 1) v += __shfl_xor(v, o);
    return v;
}
__device__ __forceinline__ float bf2f(unsigned short h) { return __builtin_bit_cast(float, (unsigned)h << 16); }
__device__ __forceinline__ float silu_f(float y) { return y / (1.0f + __expf(-y)); }

template <bool PN = false>
__device__ __forceinline__ void transpose_item(const float* W, int ldw, int k0, int c0, bf16* WT, int dpitch, int drow0, int dk0, float* scr, int lane) {
    const int h = 4 * (lane & 7), pcol = PN ? 16 * ((h >> 2) & 1) + 4 * ((h >> 3) & 3) : h, kr = lane >> 3;
    f32x4 v[8];
#pragma unroll
    for (int i = 0; i < 8; ++i) v[i] = *(const f32x4*)(W + (size_t)(k0 + 8 * i + kr) * ldw + c0 + h);
#pragma unroll
    for (int i = 0; i < 8; ++i) { float* s = scr + (8 * i + kr) * 33 + pcol; s[0] = v[i][0]; s[1] = v[i][1]; s[2] = v[i][2]; s[3] = v[i][3]; }
    LDS_WAIT(); asm volatile("" ::: "memory");
    const int c = lane & 7;
#pragma unroll
    for (int j = 0; j < 4; ++j) { const int n = (lane >> 3) + 8 * j; const float* s = scr + (8 * c) * 33 + n;
        v4u o; o.x = pk2(s[0 * 33], s[1 * 33]); o.y = pk2(s[2 * 33], s[3 * 33]); o.z = pk2(s[4 * 33], s[5 * 33]); o.w = pk2(s[6 * 33], s[7 * 33]);
        *(v4u*)(WT + (size_t)(drow0 + n) * dpitch + dk0 + 8 * c) = o; }
    LDS_WAIT(); asm volatile("" ::: "memory");
}
__device__ __forceinline__ int win_src_col(int tile, int g) {
    if (tile <= 3) return tile * 256 + 64 * (g & 3) + 32 * (g >> 2);
    if (tile <= 7) return 1024 + (tile - 4) * 256 + 32 * g;
    if (tile == 8) return 2064 + 32 * g;
    return 2320 + (tile - 9) * 256 + 32 * g;
}
constexpr int CV_I1 = 168 * 16, CV_I2 = 32 * 8, CV_I3 = 32 * 4, CV_I4 = 512, CV_I5 = 32 * 16, CV_I6 = 176 * 16, CV_I7 = 32 * 44;
constexpr int CV_MRG = CV_I1, CV_OUT = CV_I1 + CV_I2 + CV_I3 + CV_I4, CV_F1 = CV_OUT + CV_I5, CV_F2 = CV_F1 + CV_I6, CV_END = CV_F2 + CV_I7;
__device__ __forceinline__ void convert_weights(Frame& F, const Args& A, int l, int it_lo, int it_hi, int wi, int nw) {
    float* scr = (float*)(F.lds + RING_OFF + F.wave * 16384);
    float* trig = scr + 64 * 33;
    trig[F.lane] = cosf(6.283185307179586f * (float)F.lane / 64.0f); trig[64 + F.lane] = sinf(6.283185307179586f * (float)F.lane / 64.0f);
    LDS_WAIT(); asm volatile("" ::: "memory");
    const float* w_in = F_w_in + (size_t)l * DM * INC; const float* w_pa = F_w_pa + (size_t)l * 512 * DM; const float* w_pm = F_w_pm + (size_t)l * 256 * DM;
    const float* w_pf = F_w_pf + (size_t)l * 256 * DM; const float* w_out = F_w_out + (size_t)l * DM * DM; const float* w_f1 = F_w_f1 + (size_t)l * DM * NF1; const float* w_f2 = F_w_f2 + (size_t)l * FF * DM;
    bf16* WIN = WSP(bf16, WS_WIN); bf16* WMRG = WSP(bf16, WS_WMRG); bf16* WOUT = WSP(bf16, WS_WOUT); bf16* WF1 = WSP(bf16, WS_WF1); bf16* WF2 = WSP(bf16, WS_WF2);
    constexpr int I1 = CV_I1, I2 = CV_I2, I3 = CV_I3, I4 = CV_I4, I5 = CV_I5, I6 = CV_I6;
    for (int it = it_lo + wi; it < it_hi; it += nw) {
        int r = it;
        if (r < I1) { const int dg = r >> 4, kb = r & 15; if ((dg >> 3) >= 3) transpose_item<true>(w_in, INC, 64 * kb, win_src_col(dg >> 3, dg & 7), WIN, DM, 32 * dg, 64 * kb, scr, F.lane);
            else transpose_item(w_in, INC, 64 * kb, win_src_col(dg >> 3, dg & 7), WIN, DM, 32 * dg, 64 * kb, scr, F.lane);
            continue; } r -= I1;
        if (r < I2) { const int cg = r >> 3, kb = r & 7; transpose_item<true>(w_pa, DM, 64 * kb, 32 * cg, WMRG, KMRG, 32 * cg, 64 * kb, scr, F.lane); continue; } r -= I2;
        if (r < I3) { const int cg = r >> 2, kb = r & 3; transpose_item<true>(w_pm, DM, 64 * kb, 32 * cg, WMRG, KMRG, 32 * cg, 512 + 64 * kb, scr, F.lane); continue; } r -= I3;
        if (r < I4) {
            const int g = r >> 7, nb = (r >> 3) & 15, cb = r & 7; const int n = 64 * nb + F.lane;
            const int nr = (n & ~31) + 16 * ((n >> 2) & 1) + 4 * ((n >> 3) & 3) + (n & 3);
            float pc[8], ps[8];
#pragma unroll
            for (int cc = 0; cc < 8; ++cc) { pc[cc] = 0.f; ps[cc] = 0.f; }
            for (int cp0 = 0; cp0 < 64; cp0 += 16) { float w[16];
#pragma unroll
                for (int q = 0; q < 16; ++q) w[q] = w_pf[(size_t)(g * 64 + cp0 + q) * DM + n];
#pragma unroll
                for (int q = 0; q < 16; ++q)
#pragma unroll
                    for (int cc = 0; cc < 8; ++cc) { const int j = ((8 * cb + cc) * (cp0 + q)) & 63; pc[cc] += trig[j] * w[q]; ps[cc] -= trig[64 + j] * w[q]; } }
            v4u oc, os; oc.x = pk2(pc[0] * 0.125f, pc[1] * 0.125f); oc.y = pk2(pc[2] * 0.125f, pc[3] * 0.125f); oc.z = pk2(pc[4] * 0.125f, pc[5] * 0.125f); oc.w = pk2(pc[6] * 0.125f, pc[7] * 0.125f);
            os.x = pk2(ps[0] * 0.125f, ps[1] * 0.125f); os.y = pk2(ps[2] * 0.125f, ps[3] * 0.125f); os.z = pk2(ps[4] * 0.125f, ps[5] * 0.125f); os.w = pk2(ps[6] * 0.125f, ps[7] * 0.125f);
            *(v4u*)(WMRG + (size_t)nr * KMRG + 768 + g * 64 + 8 * cb) = oc; *(v4u*)(WMRG + (size_t)nr * KMRG + 1024 + g * 64 + 8 * cb) = os;
            continue; } r -= I4;
        if (r < I5) { const int cg = r >> 4, kb = r & 15; transpose_item<true>(w_out, DM, 64 * kb, 32 * cg, WOUT, DM, 32 * cg, 64 * kb, scr, F.lane); continue; } r -= I5;
        if (r < I6) { const int dg = r >> 4, kb = r & 15, tile = dg >> 3, g = dg & 7; const int c0 = g < 4 ? 128 * tile + 32 * g : FF + 128 * tile + 32 * (g - 4);
            transpose_item<true>(w_f1, NF1, 64 * kb, c0, WF1, DM, 32 * dg, 64 * kb, scr, F.lane); continue; } r -= I6;
        { const int cg = r / 44, kb = r % 44; transpose_item<true>(w_f2, DM, 64 * kb, 32 * cg, WF2, FF, 32 * cg, 64 * kb, scr, F.lane); }
    }
}

__device__ __forceinline__ void p0_prologue(Frame& F, const Args& A) {
    const int gw = F.vcu * NWAVES + F.wave, NGW = F.G * NWAVES;
    float* PMOD = WSP(float, WS_BG);
    if (F.vcu < 2 * 24 * 4) {
      float* scv = (float*)(F.lds + RING_OFF);
      f32x4* red = (f32x4*)(F.lds + RING_OFF + 40960);
      for (int i = F.tid; i < 9 * DM; i += NWAVES * 64) { const int v = i >> 10, k = i & 1023; scv[i] = silu_f(v == 0 ? F_c_ctx[k] : F_c[(v - 1) * DM + k]); }
      __syncthreads();
      for (int it = F.vcu; it < 2 * 24 * 4; it += F.G) {
        const int q = it & 3, cg = (it >> 2) % 24, l = it / 96; const int col = 256 * cg + 4 * F.lane;
        f32x4 acc[9];
#pragma unroll
        for (int v = 0; v < 9; ++v) acc[v] = (f32x4){0.f, 0.f, 0.f, 0.f};
        const int kb = 256 * q + 32 * F.wave;
        const float* wa = F_w_ada + ((size_t)l * DM + kb) * 6144 + col;
        for (int k0 = 0; k0 < 32; k0 += 16) {
            f32x4 w4[16];
#pragma unroll
            for (int k = 0; k < 16; ++k) w4[k] = __builtin_nontemporal_load((const f32x4*)(wa + (size_t)(k0 + k) * 6144));
#pragma unroll
            for (int k = 0; k < 16; ++k) { const int kk = kb + k0 + k;
#pragma unroll
                for (int v = 0; v < 9; ++v) acc[v] = acc[v] + w4[k] * scv[v * 1024 + kk]; }
        }
#pragma unroll
        for (int v = 0; v < 9; ++v) red[(F.wave * 9 + v) * 64 + F.lane] = acc[v];
        __syncthreads();
        for (int o = F.tid; o < 9 * 64; o += NWAVES * 64) { const int v = o >> 6, ln = o & 63; f32x4 s = red[v * 64 + ln];
#pragma unroll
            for (int w = 1; w < 8; ++w) s = s + red[(w * 9 + v) * 64 + ln];
            *(f32x4*)(PMOD + (((size_t)q * 2 + l) * 9 + v) * 6144 + 256 * cg + 4 * ln) = s; }
        __syncthreads();
      } }
    { bf16* DL = WSP(bf16, WS_DFTL); const int gt = (F.vcu * NWAVES + F.wave) * 64 + F.lane, NT_ = F.G * NWAVES * 64;
      for (int i = gt; i < 1024 * 128; i += NT_) { const int r = i >> 7, t0 = (i & 127) * 8; const bool cs = (r <= 512); const int rr = r < 512 ? r : (r == 512 ? 512 : r - 512); float vv[8];
#pragma unroll
          for (int j = 0; j < 8; ++j) { const int ph = (rr * (t0 + j)) & 1023; const float a = (float)ph * (1.0f / 1024.0f); vv[j] = (cs ? __builtin_amdgcn_cosf(a) : __builtin_amdgcn_sinf(a)) * (1.0f / 32.0f); }
          v4u o; o.x = pk2(vv[0], vv[1]); o.y = pk2(vv[2], vv[3]); o.z = pk2(vv[4], vv[5]); o.w = pk2(vv[6], vv[7]); *(v4u*)(DL + (size_t)r * 1024 + t0) = o; }
      bf16* DC = WSP(bf16, WS_DFTC);
      for (int i = gt; i < 256 * 32; i += NT_) { const int r = i >> 5, t0 = (i & 31) * 8; const bool cs = (r <= 128); const int rr = r < 128 ? r : (r == 128 ? 128 : r - 128); float vv[8];
#pragma unroll
          for (int j = 0; j < 8; ++j) { const int ph = (rr * (t0 + j)) & 255; const float a = (float)ph * (1.0f / 256.0f); vv[j] = (cs ? __builtin_amdgcn_cosf(a) : __builtin_amdgcn_sinf(a)) * (1.0f / 16.0f); }
          v4u o; o.x = pk2(vv[0], vv[1]); o.y = pk2(vv[2], vv[3]); o.z = pk2(vv[4], vv[5]); o.w = pk2(vv[6], vv[7]); *(v4u*)(DC + (size_t)r * 256 + t0) = o; }
      f32x2v* RP = WSP(f32x2v, WS_ROPE);
      for (int i = gt; i < 64 * 16; i += NT_) { const int pos = i >> 4, fi = i & 15; const float inv = 1.0f / powf(10000.0f, (float)fi / 16.0f); const float a = (float)pos * inv; RP[i] = (f32x2v){cosf(a), sinf(a)}; }
    }
}

__device__ __forceinline__ void norm_phase(Frame& F, const Args& A, int l, int which, int fitem = -1, gu32* fflag = nullptr, bool fused = false) {
    const int gw = F.vcu * NWAVES + F.wave, NGW = F.G * NWAVES;
    if (fused) { asm volatile("s_waitcnt vmcnt(0)" ::: "memory"); __syncthreads();
        if (fitem >= 0 && F.tid == 0) { __builtin_amdgcn_fence(__ATOMIC_RELEASE, "agent"); asm volatile("s_waitcnt vmcnt(0)" ::: "memory"); (void)__hip_atomic_fetch_add(fflag, 1u, RLX_AGENT); } }
    const float* MOD = WSP(float, WS_MOD) + (size_t)l * 9 * 6144;
    bf16* XN = WSP(bf16, WS_XN);
    float* gml = (float*)(F.lds + RING_OFF); float* shl = gml + 9 * 1024;
    bf16* wgb = (bf16*)(F.lds + RING_OFF + 73728);
    float* gpart = (float*)(F.lds + RING_OFF + 73728 + 32768);
    const bool idle0 = (which == 0 && l == 0 && F.G == 256 && F.vcu >= 192);
    if (which == 0 && l > 0 && F.G != 256) { convert_weights(F, A, l, 0, CV_END, F.vcu * NWAVES + F.wave, F.G * NWAVES); __syncthreads(); }
    if (which == 0 && l == 0) {
        const float* PMOD = WSP(float, WS_BG); float* MODW = WSP(float, WS_MOD); const size_t QS = (size_t)2 * 9 * 6144;
        for (int i4 = gw * 64 + F.lane; i4 < 2 * 9 * 6144 / 4; i4 += NGW * 64) { const size_t i = (size_t)i4 * 4;
            *(f32x4*)(MODW + i) = ((*(const f32x4*)(PMOD + i) + *(const f32x4*)(PMOD + QS + i)) + (*(const f32x4*)(PMOD + 2 * QS + i) + *(const f32x4*)(PMOD + 3 * QS + i))) + *(const f32x4*)(F_b_ada + (i / (9 * 6144)) * 6144 + (i % 6144)); }
        if (!idle0)
        for (int i4 = F.tid; i4 < 9 * 256; i4 += NWAVES * 64) { const int v = i4 >> 8, c = (i4 & 255) * 4; const size_t isc = (size_t)v * 6144 + 1024 + c, ish = (size_t)v * 6144 + c;
            const f32x4 sc = ((*(const f32x4*)(PMOD + isc) + *(const f32x4*)(PMOD + QS + isc)) + (*(const f32x4*)(PMOD + 2 * QS + isc) + *(const f32x4*)(PMOD + 3 * QS + isc))) + *(const f32x4*)(F_b_ada + 1024 + c);
            const f32x4 sh = ((*(const f32x4*)(PMOD + ish) + *(const f32x4*)(PMOD + QS + ish)) + (*(const f32x4*)(PMOD + 2 * QS + ish) + *(const f32x4*)(PMOD + 3 * QS + ish))) + *(const f32x4*)(F_b_ada + c);
            *(f32x4*)(gml + v * 1024 + c) = *(const f32x4*)(F_norm1_g + c) * (sc + 1.0f); *(f32x4*)(shl + v * 1024 + c) = sh; }
    } else { const float* ng = (which == 0 ? F_norm1_g : F_norm2_g) + (size_t)l * DM; const int o_sh = which == 0 ? 0 : 3072, o_sc = which == 0 ? 1024 : 4096;
      for (int i4 = F.tid; i4 < 9 * 256; i4 += NWAVES * 64) { const int v = i4 >> 8, c = (i4 & 255) * 4;
          *(f32x4*)(gml + v * 1024 + c) = *(const f32x4*)(ng + c) * (*(const f32x4*)(MOD + (size_t)v * 6144 + o_sc + c) + 1.0f); *(f32x4*)(shl + v * 1024 + c) = *(const f32x4*)(MOD + (size_t)v * 6144 + o_sh + c); } }
    if (which == 0) {
        const float* w_in = F_w_in + (size_t)l * DM * INC;
        if (!idle0)
        for (int i = F.tid; i < 4 * 1024; i += NWAVES * 64) { const int k = i >> 2, g4 = (i & 3) * 4; const f32x4 w4 = *(const f32x4*)(w_in + (size_t)k * INC + 2048 + g4);
#pragma unroll
            for (int j = 0; j < 4; ++j) wgb[(g4 + j) * 1024 + k] = (bf16)f2bf(w4[j]); }
        { bf16* KL = WSP(bf16, WS_KL); bf16* VL = WSP(bf16, WS_VL); const int gt = gw * 64 + F.lane, NT_ = NGW * 64;
          for (int i = gt; i < 2 * 8 * 8192; i += NT_) { const int kv = i >= 8 * 8192, r = i - kv * 8 * 8192, b = r >> 13, e = (r & 8191) * 8;
              const int es = kv ? e : (e & ~31) + ((e >> 3) & 3) * 4; const int e2 = kv ? e + 4 : es + 16;
              const float* src = (kv ? F_cache_v : F_cache_k) + ((size_t)(b * 2 + l)) * 65536; const f32x4 a = *(const f32x4*)(src + es), c4 = *(const f32x4*)(src + e2);
              v4u o; o.x = pk2(a[0], a[1]); o.y = pk2(a[2], a[3]); o.z = pk2(c4[0], c4[1]); o.w = pk2(c4[2], c4[3]);
              *(v4u*)((kv ? VL : KL) + (size_t)b * 1280 * 256 + e) = o; } }
    }
    __syncthreads();
    float* GATES = WSP(float, WS_GATES);
    const bool from_in = (l == 0 && which == 0);
    const float* xbp = from_in ? F_x_prompt : F_out; const float* xbs = from_in ? F_x_sample : F_out + (size_t)MC * DM;
    const bf16* xb16 = WSP(bf16, WS_ACAT);
    if (fused && fitem >= 0) {
        if (F.tid < 64) { asm volatile("buffer_inv sc1" ::: "memory"); unsigned sp = 0; while ((unsigned)__builtin_amdgcn_readfirstlane(__hip_atomic_load(fflag, RLX_AGENT)) < 4u) { __builtin_amdgcn_s_sleep(2); if (++sp > (1u << 22)) { if (F.tid == 0) __hip_atomic_store(F.ctl + CW_TMO, 0xBAD3u, RLX_AGENT); break; } }
            asm volatile("s_waitcnt vmcnt(0)" ::: "memory"); }
        __syncthreads(); }
    const int n_it = which == 0 ? 192 : 1;
    for (int item = fused ? (fitem >= 0 ? fitem : 192) : (which == 0 ? F.vcu : 0); item < n_it; item += fused ? 192 : (which == 0 ? F.G : 1)) {
        const int m_first = which == 0 ? 64 * item + 8 * F.wave : gw, m_step = which == 0 ? 1 : NGW, m_end = which == 0 ? 64 * item + 8 * F.wave + 8 : MTOT;
        for (int m0 = m_first; m0 < m_end; m0 += 4 * m_step) {
            f32x4 xr[4][4];
#pragma unroll
            for (int r = 0; r < 4; ++r) { const int m = m0 + r * m_step;
                if (m < m_end) { const float* xrow = m < MC ? xbp + (size_t)m * DM : xbs + (size_t)(m - MC) * DM;
#pragma unroll
                    for (int j = 0; j < 4; ++j) { if (which == 0) xr[r][j] = *(const f32x4*)(xrow + 4 * F.lane + 256 * j);
                        else { const u32x2 w = *(const u32x2*)(xb16 + (size_t)m * DM + 4 * F.lane + 256 * j); xr[r][j][0] = __builtin_bit_cast(float, w.x << 16); xr[r][j][1] = __builtin_bit_cast(float, w.x & 0xffff0000u); xr[r][j][2] = __builtin_bit_cast(float, w.y << 16); xr[r][j][3] = __builtin_bit_cast(float, w.y & 0xffff0000u); } } } }
            asm volatile("" ::: "memory");
#pragma unroll
            for (int r = 0; r < 4; ++r) { const int m = m0 + r * m_step;
                if (m < m_end) {
                    const int v = m < MC ? 0 : 1 + ((m - MC) >> 10); float s = 0.f;
#pragma unroll
                    for (int j = 0; j < 4; ++j) s += (xr[r][j][0] * xr[r][j][0] + xr[r][j][1] * xr[r][j][1]) + (xr[r][j][2] * xr[r][j][2] + xr[r][j][3] * xr[r][j][3]);
                    const float rs = 1.0f / sqrtf(wave_sum(s) * (1.0f / DM) + RMS_EPS);
#pragma unroll
                    for (int j = 0; j < 4; ++j) { const int c = 4 * F.lane + 256 * j; const f32x4 g = *(const f32x4*)(gml + v * 1024 + c), sh = *(const f32x4*)(shl + v * 1024 + c);
                        const f32x4 y = xr[r][j] * rs * g + sh;
                        u32x2 w; w.x = pk2(y[0], y[1]); w.y = pk2(y[2], y[3]); *(u32x2*)(XN + (size_t)m * DM + c) = w; }
                } }
        }
        if (which == 0) {
            __syncthreads();
            const int r16 = F.lane & 15, kq = F.lane >> 4, mt = F.wave & 3, kh = F.wave >> 2;
            const bf16* arow = XN + (size_t)(64 * item + 16 * mt + r16) * DM + 512 * kh + 8 * kq; const bf16* brow = wgb + r16 * 1024 + 512 * kh + 8 * kq;
            bf16x8 af[16];
#pragma unroll
            for (int ks = 0; ks < 16; ++ks) af[ks] = *(const bf16x8*)(arow + 32 * ks);
            f32x4 acc = (f32x4){0.f, 0.f, 0.f, 0.f};
#pragma unroll
            for (int ks = 0; ks < 16; ++ks) acc = __builtin_amdgcn_mfma_f32_16x16x32_bf16(af[ks], *(const bf16x8*)(brow + 32 * ks), acc, 0, 0, 0);
            if (kh == 1) { *(f32x4*)(gpart + ((mt * 16 + r16) * 4 + kq) * 4) = acc; }
            __syncthreads();
            if (kh == 0) { const f32x4 o = acc + *(const f32x4*)(gpart + ((mt * 16 + r16) * 4 + kq) * 4);
#pragma unroll
                for (int rg = 0; rg < 4; ++rg) GATES[(size_t)(64 * item + 16 * mt + 4 * kq + rg) * 16 + r16] = o[rg]; }
            __syncthreads();
        }
    }
    __syncthreads();
    if (which == 0 && l == 0) {
        if (F.G == 256) {
            const int I4LO = CV_MRG + CV_I2 + CV_I3;
            for (int r = 0; r < 2; ++r) {
                int lo, hi, wi, nw;
                if (idle0) { const int w = (F.vcu - 192) * NWAVES + F.wave; lo = r == 0 ? I4LO : 0; hi = r == 0 ? CV_OUT : 2048; wi = w; nw = 512; }
                else { const int w = F.vcu * NWAVES + F.wave; lo = r == 0 ? 2048 : CV_OUT; hi = r == 0 ? I4LO : CV_F1; wi = r == 0 ? w : (w + 512) % 1536; nw = 1536; }
                convert_weights(F, A, 0, lo, hi, wi, nw);
            }
        } else convert_weights(F, A, 0, 0, CV_END, F.vcu * NWAVES + F.wave, F.G * NWAVES);
    }
}

__device__ __forceinline__ void norm2_after_outproj(Frame& F, const Args& A, int l, int pm, int pn, gu32* flag) {
    asm volatile("s_waitcnt vmcnt(0)" ::: "memory"); __syncthreads();
    if (F.tid < 64) {
        if (F.tid == 0) { __builtin_amdgcn_fence(__ATOMIC_RELEASE, "agent"); asm volatile("s_waitcnt vmcnt(0)" ::: "memory"); (void)__hip_atomic_fetch_add(flag, 1u, RLX_AGENT); }
        asm volatile("buffer_inv sc1" ::: "memory");
        unsigned sp = 0; while ((unsigned)__builtin_amdgcn_readfirstlane(__hip_atomic_load(flag, RLX_AGENT)) < 4u) { __builtin_amdgcn_s_sleep(2); if (++sp > (1u << 22)) { if (F.tid == 0) __hip_atomic_store(F.ctl + CW_TMO, 0xBAD2u, RLX_AGENT); break; } }
        asm volatile("s_waitcnt vmcnt(0)" ::: "memory");
    }
    __syncthreads();
    const float* MOD = WSP(float, WS_MOD) + (size_t)l * 9 * 6144; const int v = pm < 16 ? 0 : 1 + ((pm - 16) >> 2);
    const bf16* xb16 = WSP(bf16, WS_ACAT); bf16* XN = WSP(bf16, WS_XN);
    f32x4 gg[4], sh[4];
#pragma unroll
    for (int j = 0; j < 4; ++j) { const int c = 4 * F.lane + 256 * j; gg[j] = *(const f32x4*)(F_norm2_g + (size_t)l * DM + c) * (*(const f32x4*)(MOD + (size_t)v * 6144 + 4096 + c) + 1.0f); sh[j] = *(const f32x4*)(MOD + (size_t)v * 6144 + 3072 + c); }
    const int m_base = pm * 256 + pn * 64 + F.wave * 8;
#pragma unroll
    for (int ch = 0; ch < 2; ++ch) {
        u32x2 xr[4][4];
#pragma unroll
        for (int r = 0; r < 4; ++r)
#pragma unroll
            for (int j = 0; j < 4; ++j) xr[r][j] = *(const u32x2*)(xb16 + (size_t)(m_base + 4 * ch + r) * DM + 4 * F.lane + 256 * j);
        asm volatile("" ::: "memory");
#pragma unroll
        for (int r = 0; r < 4; ++r) { const int m = m_base + 4 * ch + r; f32x4 x[4]; float s = 0.f;
#pragma unroll
            for (int j = 0; j < 4; ++j) { const u32x2 w = xr[r][j]; x[j][0] = __builtin_bit_cast(float, w.x << 16); x[j][1] = __builtin_bit_cast(float, w.x & 0xffff0000u); x[j][2] = __builtin_bit_cast(float, w.y << 16); x[j][3] = __builtin_bit_cast(float, w.y & 0xffff0000u);
                s += (x[j][0] * x[j][0] + x[j][1] * x[j][1]) + (x[j][2] * x[j][2] + x[j][3] * x[j][3]); }
            const float rs = 1.0f / sqrtf(wave_sum(s) * (1.0f / DM) + RMS_EPS);
#pragma unroll
            for (int j = 0; j < 4; ++j) { const f32x4 y = x[j] * rs * gg[j] + sh[j]; u32x2 w; w.x = pk2(y[0], y[1]); w.y = pk2(y[2], y[3]); *(u32x2*)(XN + (size_t)m * DM + 4 * F.lane + 256 * j) = w; }
        }
    }
}

constexpr int L_AU = 0, L_AR = 8192, L_AWI = 16384, L_AEMJ = 24576, L_AWK = 32768, L_CH = 40960, L_NST = 41984, L_IV = 50176, L_SL = 52224, SL_PITCH = 72;
static_assert(L_SL + 8 * 64 * SL_PITCH * 2 <= RING_BYTES, "mLSTM LDS map");
typedef float f32x4m __attribute__((ext_vector_type(4)));
__device__ __forceinline__ f32x4 mfma16(bf16x8 a, bf16x8 b, f32x4 c) { return __builtin_amdgcn_mfma_f32_16x16x32_bf16(a, b, c, 0, 0, 0); }
__device__ __forceinline__ bf16x8 pack8(const float (&v)[8]) { v4u o; o.x = pk2(v[0], v[1]); o.y = pk2(v[2], v[3]); o.z = pk2(v[4], v[5]); o.w = pk2(v[6], v[7]); return __builtin_bit_cast(bf16x8, o); }
__device__ __forceinline__ void unpack8(bf16x8 p, float (&v)[8]) { const v4u o = __builtin_bit_cast(v4u, p);
    v[0] = __builtin_bit_cast(float, o.x << 16); v[1] = __builtin_bit_cast(float, o.x & 0xffff0000u); v[2] = __builtin_bit_cast(float, o.y << 16); v[3] = __builtin_bit_cast(float, o.y & 0xffff0000u);
    v[4] = __builtin_bit_cast(float, o.z << 16); v[5] = __builtin_bit_cast(float, o.z & 0xffff0000u); v[6] = __builtin_bit_cast(float, o.w << 16); v[7] = __builtin_bit_cast(float, o.w & 0xffff0000u); }
__device__ __forceinline__ bf16x8 conv8_nat(bf16x8 xm, bf16x8 x0, bf16x8 xp, const float* cw, float post) {
    float a[8], b[8], c[8], o[8]; unpack8(xm, a); unpack8(x0, b); unpack8(xp, c);
    const f32x4 w0a = *(const f32x4*)(cw), w0b = *(const f32x4*)(cw + 4), w1a = *(const f32x4*)(cw + 512), w1b = *(const f32x4*)(cw + 516), w2a = *(const f32x4*)(cw + 1024), w2b = *(const f32x4*)(cw + 1028);
#pragma unroll
    for (int j = 0; j < 8; ++j) { const float w0 = j < 4 ? w0a[j & 3] : w0b[j & 3], w1 = j < 4 ? w1a[j & 3] : w1b[j & 3], w2 = j < 4 ? w2a[j & 3] : w2b[j & 3];
        o[j] = silu_f(w0 * a[j] + w1 * b[j] + w2 * c[j]) * post; }
    return pack8(o);
}
template <int MASK> __device__ __forceinline__ float swz_xor(float v) { return __shfl_xor(v, MASK); }
__device__ __forceinline__ float sum_xor32(float v) { auto rr = __builtin_amdgcn_permlane32_swap(__builtin_bit_cast(unsigned, v), __builtin_bit_cast(unsigned, v), false, false); return __builtin_bit_cast(float, rr[0]) + __builtin_bit_cast(float, rr[1]); }
__device__ __forceinline__ float sum_kq(float v) { v += __shfl_xor(v, 16); v += __shfl_xor(v, 32); return v; }
__device__ __forceinline__ float sum_r16(float v) { v += swz_xor<1>(v); v += swz_xor<2>(v); v += swz_xor<4>(v); v += swz_xor<8>(v); return v; }
__device__ __forceinline__ float logsigmoid_f(float x) { return fminf(x, 0.f) - log1pf(__expf(-fabsf(x))); }

constexpr size_t PA_PLANE = (size_t)2 * 4 * MTOT;
constexpr size_t NSLOT_M = (size_t)192 * 4 * 2;
__device__ __forceinline__ void mlstm_c0(Frame& F, const Args& A, int l) {
    const int gw = F.vcu * NWAVES + F.wave, NGW = F.G * NWAVES; const int gt = gw * 64 + F.lane, NT_ = NGW * 64; const int lane = F.lane;
    const float* cwl = F_m_conv_w + (size_t)l * 3 * 512; const float* gb = F_m_gate_b + l * 16; const float* GATES = WSP(float, WS_GATES);
    const bf16* QM = WSP(bf16, WS_QM); const bf16* KM = WSP(bf16, WS_KM); const bf16* KMT = WSP(bf16, WS_KMT); const bf16* VTb = WSP(bf16, WS_VT);
    bf16* QN = WSP(bf16, WS_QN); bf16* KN = WSP(bf16, WS_KN); bf16* UT2 = WSP(bf16, WS_UT2);
    float* PA = WSP(float, WS_PA); float* CS = PA + 3 * PA_PLANE; float* NU = CS + NSLOT_M * 4 + NSLOT_M * 64;
    float* wkl = (float*)(F.lds + RING_OFF) + F.wave * 64;
    for (int it = gw; it < 192 * 4 * 2; it += NGW) { const int d = it & 1, h = (it >> 1) & 3, cgk = it >> 3; const size_t row = (size_t)cgk * 64 + lane;
        const float* gp = GATES + row * 16 + d * 8 + h; const float g_i = gp[0], g_f = gp[4];
        const bool lat = cgk >= 64; const int T = lat ? 1024 : 256; const int b = lat ? (cgk - 64) >> 4 : cgk >> 2, oc = lat ? (cgk - 64) & 15 : cgk & 3;
        const size_t tbase = lat ? (size_t)16 * 65536 + (size_t)b * 262144 : (size_t)b * 65536;
        int r16 = lane & 15, kq = lane >> 4; asm volatile("" : "+v"(r16), "+v"(kq));
        bf16x8 bfr[2][4], kfr[2][4]; float kxl[2][4], kxh[2][4];
#pragma unroll
        for (int ks = 0; ks < 2; ++ks) { const int t0 = 64 * oc + 32 * ks + 8 * kq;
#pragma unroll
            for (int nt = 0; nt < 4; ++nt) { bfr[ks][nt] = *(const bf16x8*)(VTb + tbase + (size_t)(h * 64 + 16 * nt + r16) * T + t0);
                const bf16* kr = KMT + tbase + (size_t)(h * 64 + 16 * nt + r16) * T; kfr[ks][nt] = *(const bf16x8*)(kr + t0); kxl[ks][nt] = t0 > 0 ? bf2f(kr[t0 - 1]) : 0.f; kxh[ks][nt] = t0 + 8 < T ? bf2f(kr[t0 + 8]) : 0.f; } }
        const float li = g_i + gb[d * 8 + h]; const float lf = logsigmoid_f(g_f + gb[d * 8 + 4 + h]);
        float bs = lf;
#pragma unroll
        for (int off = 1; off < 64; off <<= 1) { const float o = d ? __shfl_down(bs, off) : __shfl_up(bs, off); const bool ok = d ? (lane + off < 64) : (lane >= off); if (ok) bs += o; }
        const float r = li - bs; float pm = r;
#pragma unroll
        for (int off = 1; off < 64; off <<= 1) { const float o = d ? __shfl_down(pm, off) : __shfl_up(pm, off); const bool ok = d ? (lane + off < 64) : (lane >= off); if (ok) pm = fmaxf(pm, o); }
        const float bl = __shfl(bs, d ? 0 : 63), rmax = __shfl(pm, d ? 0 : 63);
        float* pp = PA + ((size_t)d * 4 + h) * MTOT + row; pp[0] = bs; pp[PA_PLANE] = r; pp[2 * PA_PLANE] = pm;
        const size_t slot = ((size_t)cgk * 4 + h) * 2 + d;
        if (lane == 0) { float* cs = CS + slot * 4; cs[0] = bl; cs[1] = bl + rmax; }
        wkl[lane] = __expf(r - rmax);
        f32x4 U[4][4];
#pragma unroll
        for (int mt = 0; mt < 4; ++mt)
#pragma unroll
            for (int nt = 0; nt < 4; ++nt) U[mt][nt] = (f32x4){0.f, 0.f, 0.f, 0.f};
        float nsum[4] = {0.f, 0.f, 0.f, 0.f};
#pragma unroll
        for (int ks = 0; ks < 2; ++ks) {
            const f32x4 wk0 = *(const f32x4*)(wkl + 32 * ks + 8 * kq), wk1 = *(const f32x4*)(wkl + 32 * ks + 8 * kq + 4);
#pragma unroll
            for (int mt = 0; mt < 4; ++mt) { const int ch = h * 64 + 16 * mt + r16;
                const float cw0 = cwl[256 + ch], cw1 = cwl[512 + 256 + ch], cw2 = cwl[1024 + 256 + ch];
                float x[10]; { float xx[8]; unpack8(kfr[ks][mt], xx);
#pragma unroll
                    for (int j = 0; j < 8; ++j) x[j + 1] = xx[j]; }
                x[0] = kxl[ks][mt]; x[9] = kxh[ks][mt];
                float kt[8];
#pragma unroll
                for (int j = 0; j < 8; ++j) { kt[j] = silu_f(cw0 * x[j] + cw1 * x[j + 1] + cw2 * x[j + 2]) * 0.125f * (j < 4 ? wk0[j & 3] : wk1[j & 3]); nsum[mt] += kt[j]; }
                const bf16x8 af = pack8(kt);
#pragma unroll
                for (int nt = 0; nt < 4; ++nt) U[mt][nt] = mfma16(af, bfr[ks][nt], U[mt][nt]); }
        }
        bf16* us = UT2 + slot * 4096;
#pragma unroll
        for (int mt = 0; mt < 4; ++mt) { const float ns = sum_kq(nsum[mt]); if (kq == 0) NU[slot * 64 + 16 * mt + r16] = ns;
#pragma unroll
            for (int nt = 0; nt < 4; ++nt) { u32x2 w; w.x = pk2(U[mt][nt][0], U[mt][nt][1]); w.y = pk2(U[mt][nt][2], U[mt][nt][3]); *(u32x2*)(us + (16 * nt + r16) * 64 + 16 * mt + 4 * kq) = w; } }
    }
    { const bf16x8 z8 = {0, 0, 0, 0, 0, 0, 0, 0};
      for (int i = gt; i < MTOT * 32; i += NT_) { const int row = i >> 5, col = 8 * (i & 31); const int t = row < MC ? (row & 255) : ((row - MC) & 1023), T = row < MC ? 256 : 1024; const size_t off = (size_t)row * 256 + col;
        const bf16x8 q0 = *(const bf16x8*)(QM + off), qm_ = t > 0 ? *(const bf16x8*)(QM + off - 256) : z8, qp = t + 1 < T ? *(const bf16x8*)(QM + off + 256) : z8;
        const bf16x8 k0 = *(const bf16x8*)(KM + off), km_ = t > 0 ? *(const bf16x8*)(KM + off - 256) : z8, kp = t + 1 < T ? *(const bf16x8*)(KM + off + 256) : z8;
        *(bf16x8*)(QN + off) = conv8_nat(qm_, q0, qp, cwl + col, 1.0f); *(bf16x8*)(KN + off) = conv8_nat(km_, k0, kp, cwl + 256 + col, 0.125f); } }
}
__device__ __forceinline__ void mlstm_m1(Frame& F, const Args& A, int l, int b, int h, bool ctx, gu32* flag) {
    const int T = ctx ? 256 : 1024, nc = T >> 6;
    const size_t R0 = ctx ? (size_t)b * 256 : (size_t)MC + (size_t)b * 1024;
    int tid = F.tid; asm volatile("" : "+v"(tid));
    float* CDEC = (float*)(F.lds + L_CH); float* CE = CDEC + 32;
    bf16* CT = WSP(bf16, WS_CT); const bf16* UT2 = WSP(bf16, WS_UT2); float* PA = WSP(float, WS_PA); float* CS = PA + 3 * PA_PLANE; float* NSTG = CS + NSLOT_M * 4; const float* NU = NSTG + NSLOT_M * 64;
    if (tid < 2) { const int d = tid; float mm = ctx ? 0.f : F_state_m[((b * 2 + l) * 2 + d) * 4 + h];
        float bl_[16], a_[16];
#pragma unroll
        for (int k = 0; k < 16; ++k) { if (k < nc) { const float* cs = CS + ((((R0 >> 6) + k) * 4 + h) * 2 + d) * 4; bl_[k] = cs[0]; a_[k] = cs[1]; } else { bl_[k] = 0.f; a_[k] = 0.f; } }
#pragma unroll
        for (int k = 0; k < 16; ++k) { const int oc = d ? nc - 1 - k : k;
            if (k < nc) { float bl = 0.f, aa = 0.f;
#pragma unroll
                for (int q = 0; q < 16; ++q) { if (q == oc) { bl = bl_[q]; aa = a_[q]; } }
                float* cs = CS + ((((R0 >> 6) + oc) * 4 + h) * 2 + d) * 4; cs[2] = mm; const float mn = fmaxf(bl + mm, aa);
                CDEC[d * 16 + oc] = __expf(bl + mm - mn); CE[d * 16 + oc] = __expf(aa - mn); cs[3] = mn; mm = mn; } }
        if (ctx) F_out[OFF_NM + ((b * 2 + l) * 2 + d) * 4 + h] = mm; }
    __syncthreads();
    {
        const int d = tid >> 8, e = tid & 255, dv = e >> 2, dk0 = (e & 3) * 16;
        float C[16]; float nval = 0.f;
        if (ctx) {
#pragma unroll
            for (int i = 0; i < 16; ++i) C[i] = 0.f;
        } else {
            const float* sc = F_state_C + (size_t)(((b * 2 + l) * 2 + d) * 4 + h) * 4096;
#pragma unroll
            for (int i = 0; i < 16; ++i) C[i] = sc[(dk0 + i) * 64 + dv];
            if (e < 64) nval = F_state_n[(size_t)(((b * 2 + l) * 2 + d) * 4 + h) * 64 + e];
        }
        for (int k0 = 0; k0 < nc; k0 += 4) {
            bf16x8 u[4][2]; float nu[4];
#pragma unroll
            for (int kk = 0; kk < 4; ++kk) { const int oc = d ? nc - 1 - (k0 + kk) : k0 + kk; const size_t slot = (((R0 >> 6) + oc) * 4 + h) * 2 + d;
                u[kk][0] = *(const bf16x8*)(UT2 + slot * 4096 + 16 * e); u[kk][1] = *(const bf16x8*)(UT2 + slot * 4096 + 16 * e + 8); nu[kk] = e < 64 ? NU[slot * 64 + e] : 0.f; }
#pragma unroll
            for (int kk = 0; kk < 4; ++kk) { const int oc = d ? nc - 1 - (k0 + kk) : k0 + kk; const size_t slot = (((R0 >> 6) + oc) * 4 + h) * 2 + d;
                float lo[8], hi[8];
#pragma unroll
                for (int i = 0; i < 8; ++i) { lo[i] = C[i]; hi[i] = C[8 + i]; }
                *(bf16x8*)(CT + slot * 4096 + 16 * e) = pack8(lo); *(bf16x8*)(CT + slot * 4096 + 16 * e + 8) = pack8(hi);
                if (e < 64) NSTG[slot * 64 + e] = nval;
                const float dec = CDEC[d * 16 + oc], we = CE[d * 16 + oc]; float ul[8], uh[8]; unpack8(u[kk][0], ul); unpack8(u[kk][1], uh);
#pragma unroll
                for (int i = 0; i < 8; ++i) { C[i] = dec * C[i] + we * ul[i]; C[8 + i] = dec * C[8 + i] + we * uh[i]; }
                nval = dec * nval + we * nu[kk]; }
        }
        if (ctx) {
            float* oc_ = F_out + OFF_NC + (size_t)(((b * 2 + l) * 2 + d) * 4 + h) * 4096;
#pragma unroll
            for (int i = 0; i < 16; ++i) oc_[(dk0 + i) * 64 + dv] = C[i];
            if (e < 64) F_out[OFF_NN + (size_t)(((b * 2 + l) * 2 + d) * 4 + h) * 64 + e] = nval;
        }
    }
    asm volatile("s_waitcnt vmcnt(0)" ::: "memory");
    __syncthreads();
    if (tid == 0) { __builtin_amdgcn_fence(__ATOMIC_RELEASE, "agent"); asm volatile("s_waitcnt vmcnt(0)" ::: "memory"); __hip_atomic_store(flag, 1u, RLX_AGENT); }
}
__device__ __forceinline__ void mlstm_wait(Frame& F, gu32* flag) {
    if (F.tid < 64) { asm volatile("buffer_inv sc1" ::: "memory"); unsigned sp = 0; while ((unsigned)__builtin_amdgcn_readfirstlane(__hip_atomic_load(flag, RLX_AGENT)) == 0u) { __builtin_amdgcn_s_sleep(4); if (++sp > (1u << 24)) { if (F.tid == 0) __hip_atomic_store(F.ctl + CW_TMO, 0xBAD1u, RLX_AGENT); break; } }
        asm volatile("s_waitcnt vmcnt(0)" ::: "memory"); }
    __syncthreads();
}
__device__ __forceinline__ void mlstm_m2_item(Frame& F, const Args& A, int l, int b, int h, bool ctx, int oc, int tid_in) {
    const int T = ctx ? 256 : 1024;
    const size_t R0 = ctx ? (size_t)b * 256 : (size_t)MC + (size_t)b * 1024;
    const size_t tbase = ctx ? (size_t)b * 65536 : (size_t)16 * 65536 + (size_t)b * 262144;
    int tid = tid_in; asm volatile("" : "+v"(tid)); const int lane = tid & 63, wave = __builtin_amdgcn_readfirstlane(tid >> 6);
    float* IV = (float*)(F.lds + L_IV) + wave * 64; bf16* SL = (bf16*)(F.lds + L_SL) + wave * 64 * SL_PITCH;
    const bf16* VT = WSP(bf16, WS_VT) + tbase; const bf16* OM = WSP(bf16, WS_OM); const bf16* QN = WSP(bf16, WS_QN); const bf16* KN = WSP(bf16, WS_KN);
    const bf16* CT = WSP(bf16, WS_CT); float* HF = WSP(float, WS_HF); bf16* AC = WSP(bf16, WS_ACAT); const float* PA = WSP(float, WS_PA); const float* CS = PA + 3 * PA_PLANE; const float* NSTG = CS + NSLOT_M * 4;
    const int tq = 64 * oc;
    unsigned hfp[4][4][2];
#pragma unroll
    for (int d = 0; d < 2; ++d) {
            int r16 = lane & 15, kq = lane >> 4; asm volatile("" : "+v"(r16), "+v"(kq));
            const float* pu = PA + ((size_t)d * 4 + h) * MTOT + R0 + tq;
            const size_t slot = (((R0 >> 6) + oc) * 4 + h) * 2 + d;
            bf16x8 Qf[4][2]; f32x4 rs4[4]; float bsv[4], pmv[4]; f32x4 nv[2][2];
#pragma unroll
            for (int mt = 0; mt < 4; ++mt) {
#pragma unroll
                for (int ks = 0; ks < 2; ++ks) { const int t = tq + 16 * mt + r16, col = h * 64 + 32 * ks + 8 * kq; Qf[mt][ks] = *(const bf16x8*)(QN + (R0 + t) * 256 + col); }
                rs4[mt] = *(const f32x4*)(pu + PA_PLANE + 16 * mt + 4 * kq); bsv[mt] = pu[16 * mt + r16]; pmv[mt] = pu[2 * PA_PLANE + 16 * mt + r16]; }
            const float ms = CS[slot * 4 + 2];
            const float* nst = NSTG + slot * 64;
#pragma unroll
            for (int ks = 0; ks < 2; ++ks) { nv[ks][0] = *(const f32x4*)(nst + 32 * ks + 8 * kq); nv[ks][1] = *(const f32x4*)(nst + 32 * ks + 8 * kq + 4); }
            bf16x8 Kfa[4][2];
#pragma unroll
            for (int st = 0; st < 4; ++st)
#pragma unroll
                for (int ks = 0; ks < 2; ++ks) Kfa[st][ks] = *(const bf16x8*)(KN + (R0 + tq + 16 * st + r16) * 256 + h * 64 + 32 * ks + 8 * kq);
            float ul[4], wil[4], emj[4], rowsum[4];
#pragma unroll
            for (int lt = 0; lt < 4; ++lt) { const float bs = bsv[lt], pm = pmv[lt]; const float mj = bs + fmaxf(ms, pm);
                ul[lt] = (bs - mj) * LOG2E; wil[lt] = __expf(bs + ms - mj); emj[lt] = __expf(-mj); rowsum[lt] = 0.f; rs4[lt] = rs4[lt] * LOG2E; }
#pragma unroll
            for (int st = 0; st < 4; ++st) {
                const bf16x8* Kf = Kfa[st];
#pragma unroll
                for (int lt = 0; lt < 4; ++lt) {
                    const bool live = d ? (st >= lt) : (st <= lt);
                    u32x2 w; w.x = 0u; w.y = 0u;
                    if (live) {
                        f32x4 sacc = (f32x4){0.f, 0.f, 0.f, 0.f};
                        sacc = mfma16(Kf[0], Qf[lt][0], sacc); sacc = mfma16(Kf[1], Qf[lt][1], sacc);
                        f32x4 val;
#pragma unroll
                        for (int rg = 0; rg < 4; ++rg) { const int sl = 16 * st + 4 * kq + rg, ll = 16 * lt + r16; const bool ok = d ? (sl >= ll) : (sl <= ll);
                            val[rg] = ok ? sacc[rg] * __builtin_amdgcn_exp2f(ul[lt] + rs4[st][rg]) : 0.f; }
                        rowsum[lt] += (val[0] + val[1]) + (val[2] + val[3]);
                        w.x = pk2(val[0], val[1]); w.y = pk2(val[2], val[3]);
                    }
                    *(u32x2*)(SL + (16 * lt + r16) * SL_PITCH + 16 * st + 4 * kq) = w;
                }
            }
            const bf16* cts = CT + slot * 4096;
            float inv[4];
#pragma unroll
            for (int mt = 0; mt < 4; ++mt) { float qn = 0.f;
#pragma unroll
                for (int ks = 0; ks < 2; ++ks) { float q8[8]; unpack8(Qf[mt][ks], q8);
#pragma unroll
                    for (int j = 0; j < 8; ++j) qn += q8[j] * (j < 4 ? nv[ks][0][j & 3] : nv[ks][1][j & 3]); }
                float a = sum_kq(rowsum[mt] + wil[mt] * qn);
                inv[mt] = 1.0f / fmaxf(fabsf(a), emj[mt]);
                if (kq == 0) IV[16 * mt + r16] = inv[mt]; }
            f32x4 H[4][4];
#pragma unroll
            for (int mt = 0; mt < 4; ++mt)
#pragma unroll
                for (int nt = 0; nt < 4; ++nt) H[mt][nt] = (f32x4){0.f, 0.f, 0.f, 0.f};
#pragma unroll
            for (int ks = 0; ks < 2; ++ks) {
                bf16x8 vbk[4], cbk[4];
#pragma unroll
                for (int nt = 0; nt < 4; ++nt) { vbk[nt] = *(const bf16x8*)(VT + (size_t)(h * 64 + 16 * nt + r16) * T + tq + 32 * ks + 8 * kq); cbk[nt] = *(const bf16x8*)(cts + (16 * nt + r16) * 64 + 32 * ks + 8 * kq); }
#pragma unroll
                for (int mt = 0; mt < 4; ++mt) {
                    const bf16x8 sa = *(const bf16x8*)(SL + (16 * mt + r16) * SL_PITCH + 32 * ks + 8 * kq);
                    float q8[8]; unpack8(Qf[mt][ks], q8);
#pragma unroll
                    for (int j = 0; j < 8; ++j) q8[j] *= wil[mt];
                    const bf16x8 qa = pack8(q8);
#pragma unroll
                    for (int nt = 0; nt < 4; ++nt) { H[mt][nt] = mfma16(sa, vbk[nt], H[mt][nt]); H[mt][nt] = mfma16(qa, cbk[nt], H[mt][nt]); }
                }
            }
            if (d == 0) {
#pragma unroll
                for (int mt = 0; mt < 4; ++mt) { const f32x4 iv4 = *(const f32x4*)(IV + 16 * mt + 4 * kq);
#pragma unroll
                    for (int nt = 0; nt < 4; ++nt) { hfp[mt][nt][0] = pk2(H[mt][nt][0] * iv4[0], H[mt][nt][1] * iv4[1]); hfp[mt][nt][1] = pk2(H[mt][nt][2] * iv4[2], H[mt][nt][3] * iv4[3]); } }
            } else {
                float gmn[4];
#pragma unroll
                for (int nt = 0; nt < 4; ++nt) gmn[nt] = F_m_norm_g[l * 256 + h * 64 + 16 * nt + r16];
#pragma unroll
                for (int mt = 0; mt < 4; ++mt) { const f32x4 iv4 = *(const f32x4*)(IV + 16 * mt + 4 * kq);
#pragma unroll
                    for (int rg = 0; rg < 4; ++rg) {
                        float hs[4], ss = 0.f;
#pragma unroll
                        for (int nt = 0; nt < 4; ++nt) { const unsigned pw = hfp[mt][nt][rg >> 1]; const float hf = __builtin_bit_cast(float, (rg & 1) ? (pw & 0xffff0000u) : (pw << 16));
                            hs[nt] = H[mt][nt][rg] * iv4[rg] + hf; ss += hs[nt] * hs[nt]; }
                        ss = sum_r16(ss);
                        const float rs = 1.0f / sqrtf(ss * (1.0f / 64.0f) + RMS_EPS);
#pragma unroll
                        for (int nt = 0; nt < 4; ++nt) SL[(16 * mt + 4 * kq + rg) * SL_PITCH + 16 * nt + r16] = (bf16)f2bf(hs[nt] * rs * gmn[nt]);
                    }
                }
                { const size_t row = R0 + tq + lane; const bf16* omr = OM + row * 256 + h * 64; bf16* acr = AC + row * KMRG + 512 + h * 64;
                  bf16x8 og[8];
#pragma unroll
                  for (int c8 = 0; c8 < 8; ++c8) og[c8] = *(const bf16x8*)(omr + 8 * c8);
#pragma unroll
                  for (int c8 = 0; c8 < 8; ++c8) { float yv[8], gv[8]; unpack8(*(const bf16x8*)(SL + lane * SL_PITCH + 8 * c8), yv); unpack8(og[c8], gv);
#pragma unroll
                      for (int q = 0; q < 8; ++q) yv[q] *= gv[q];
                      *(bf16x8*)(acr + 8 * c8) = pack8(yv); } }
            }
    }
}

constexpr int QU_TOTAL = 624;
__device__ __forceinline__ void mixer_phase(Frame& F, const Args& A, int l) {
    gu32* qhead = F.ctl + CW_QUEUE + 64 * l;
    gu32* mflag = F.ctl + CW_MFLAG + 64 * (l * 96);
    for (;;) {
        __syncthreads();
        if (F.tid == 0) F.MISC[16] = __hip_atomic_fetch_add(qhead, 1u, RLX_AGENT);
        __syncthreads();
        const int qpos = (int)F.MISC[16];
        if (qpos >= QU_TOTAL) break;
        const int u = qpos < 224 ? qpos : qpos < 480 ? qpos + 32 : qpos < 496 ? qpos + 32 : qpos + 48;
        { int tl = threadIdx.x; asm volatile("" : "+v"(tl)); F.tid = tl; F.lane = tl & 63; F.wave = __builtin_amdgcn_readfirstlane(tl >> 6);
          size_t z_ = 0; asm volatile("" : "+s"(z_)); F.ws = A.ws + z_; F.out = A.out + z_; }
#ifdef PROF_UNIT
        const unsigned long long pu_t0 = __builtin_amdgcn_s_memrealtime();
#endif
        const bf16* Qb = WSP(bf16, WS_Q); bf16* AC = WSP(bf16, WS_ACAT);
        if (u < 96) { const bool ctx = u >= 32;
            const int j = ctx ? u - 32 : u;
            if (T_MASK & 0x100) mlstm_m1(F, A, l, j >> 2, j & 3, ctx, mflag + 64 * u); }
        else if (u < 192) {
            const bool ctx = u >= 160; const int j = ctx ? u - 160 : u - 96;
            const int bh0 = ctx ? (j >> 1) * 4 + (j & 1) * 2 : (j >> 1);
            if (T_MASK & 0x100) {
                mlstm_wait(F, mflag + 64 * (ctx ? 32 + bh0 : bh0));
                if (ctx) mlstm_wait(F, mflag + 64 * (32 + bh0 + 1));
                const int bh = ctx ? bh0 + (F.wave >> 2) : bh0; const int oc = ctx ? (F.wave & 3) : (j & 1) * 8 + F.wave;
                mlstm_m2_item(F, A, l, bh >> 2, bh & 3, ctx, oc, F.tid);
            }
        }
        else if (u < 256 || (u >= 512 && u < 544)) {
            const bool lat = u < 256; const int j = lat ? u - 192 : u - 512;
            pg8::OneUnit S; S.u.pm = lat ? (j >> 3) : 0; S.u.pn = lat ? (j & 7) : j;
            pg8::Gemm g; g.A = lat ? WSP(const pg8::bf16_t, WS_DFTL) : WSP(const pg8::bf16_t, WS_DFTC);
            g.Bt = WSP(const pg8::bf16_t, WS_UT) + (lat ? (size_t)16 * 65536 : 0); g.M = lat ? 1024 : 256; g.N = lat ? 2048 : 4096; g.K = lat ? 1024 : 256;
            pg8::EpiFourier E; E.AC = (pg8::bf16_t*)AC; E.lat = lat ? 1 : 0;
            if (T_MASK & 0x200) pg8::gemm_phase<pg8::EpiFourier, pg8::OneUnit, false, true>(F.ldsl + RING_OFF, g, S, E, F.tid);
        }
        else { const bool lat = u < 512; const int j = lat ? u - 256 : u - 544; const int b = lat ? (j >> 5) : (j >> 3), qh = lat ? ((j >> 2) & 7) : (j & 7), qb = lat ? (j & 3) : 0;
            const size_t row0 = lat ? (size_t)MC + (size_t)b * 1024 + (size_t)qb * 256 : (size_t)b * 256;
            const bf16* Kp = (lat ? WSP(bf16, WS_KL) + (size_t)b * 1280 * 256 : WSP(bf16, WS_KC) + (size_t)b * 65536) + (qh >> 1) * 64;
            const bf16* Vp = (lat ? WSP(bf16, WS_VL) + (size_t)b * 1280 * 256 : WSP(bf16, WS_VC) + (size_t)b * 65536) + (qh >> 1) * 64;
            if (T_MASK & 0x400) attn_body::attn_unit<8>((const attn_body::bf16*)(Qb + row0 * 512 + qh * 64), 512, (const attn_body::bf16*)Kp, (const attn_body::bf16*)Vp, 256, lat ? 20 : 4,
                (attn_body::bf16*)(AC + row0 * KMRG + qh * 64), KMRG, (char*)F.lds + RING_OFF, F.tid); }
#ifdef PROF_UNIT
        if (l == 0 && F.tid == 0) { const int ty = u < 32 ? 0 : u < 96 ? 2 : u < 160 ? 6 : u < 192 ? 7 : u < 256 ? 1 : u < 512 ? 3 : u < 544 ? 4 : 5;
            unsigned* pc = (unsigned*)(A.ws + CTL_ZERO_BYTES - 12288); const unsigned dt = (unsigned)(__builtin_amdgcn_s_memrealtime() - pu_t0); atomicAdd(pc + 2 * ty, dt); atomicAdd(pc + 2 * ty + 1, 1u); atomicAdd(pc + 16, dt); pc[17] = 256u; }
#endif
    }
}

#ifdef PROF_GEMM
#define PROFP(kk) ((l == 0 && (kk) == PROF_GEMM) ? (unsigned*)(A.ws + CTL_ZERO_BYTES - 16384) : (unsigned*)nullptr)
#else
#define PROFP(kk) ((unsigned*)nullptr)
#endif
__global__ void __launch_bounds__(NWAVES * 64, 2) mk_fwd(const Args A) {
    extern __shared__ __attribute__((aligned(16))) unsigned char lds[];
    Frame F;
    F.lds = lds; F.ldsl = (LAS unsigned char*)lds;
    F.MISC = (volatile LAS unsigned*)(F.ldsl + MISC_OFF);
    F.tid = threadIdx.x; F.lane = F.tid & 63; F.wave = __builtin_amdgcn_readfirstlane(F.tid >> 6);
    F.G = gridDim.x; { const int bx = blockIdx.x; F.vcu = (F.G % 8 == 0) ? (bx % 8) * (F.G / 8) + bx / 8 : bx; }
    F.ctl = (gu32*)(A.ws + WS_CTL);
    for (int u = F.tid; u < (LDS_BYTES - LDSCTL_OFF) / 4; u += NWAVES * 64) ((LAS unsigned*)(F.ldsl + LDSCTL_OFF))[u] = 0u;
    __syncthreads();
    XcdBarrier bar; bar.bar = (unsigned*)(F.ctl + CW_BAR) + A.li * XCD_BAR_WORDS; bar.x = 0; bar.st = nullptr;
    bar = xcd_barrier_post((unsigned*)(F.ctl + CW_BAR) + A.li * XCD_BAR_WORDS, F.MISC + 8);
#ifdef PROF_PHASE
    unsigned long long* stamps = (unsigned long long*)(A.ws + CTL_ZERO_BYTES - 8192);
    if (blockIdx.x == 0 && threadIdx.x == 0) stamps[0] = __builtin_amdgcn_s_memrealtime();
#endif
    for (int ph = A.ph_lo; ph < A.ph_hi; ++ph) {
        { int tl = threadIdx.x; asm volatile("" : "+v"(tl)); F.tid = tl; F.lane = tl & 63; F.wave = __builtin_amdgcn_readfirstlane(tl >> 6);
          size_t z_ = 0; asm volatile("" : "+s"(z_)); F.ws = A.ws + z_; F.out = A.out + z_; }
        if (ph == 0) { if (T_MASK & 1) p0_prologue(F, A); }
        else {
            const int l = (ph - 1) >> 3, k = (ph - 1) & 7;
            if (k == 0) { if (T_MASK & 2) {
                int fitem = -1; gu32* ff = nullptr; const bool fused = (l == 1 && F.G == 256);
                if (fused) { pg8::StaticOrder S; S.init(MTOT, DM, F.G, (int)blockIdx.x); pg8::Unit u0; if (S.next(0, u0)) { fitem = u0.pm * 4 + u0.pn; ff = F.ctl + CW_HFLAG + 64 * u0.pm; } }
                norm_phase(F, A, l, 0, fitem, ff, fused);
            } }
            else if (k == 1) { if (T_MASK & 4) {
                pg8::Gemm g{WSP(const pg8::bf16_t, WS_XN), WSP(const pg8::bf16_t, WS_WIN), MTOT, NIN, DM}; pg8::StaticOrder S; S.init(MTOT, NIN, F.G, (int)blockIdx.x);
                pg8::EpiIn E; E.layer = l; E.Q = WSP(pg8::bf16_t, WS_Q); E.KC = WSP(pg8::bf16_t, WS_KC); E.VC = WSP(pg8::bf16_t, WS_VC); E.KL = WSP(pg8::bf16_t, WS_KL); E.VL = WSP(pg8::bf16_t, WS_VL);
                E.QM = WSP(pg8::bf16_t, WS_QM); E.KM = WSP(pg8::bf16_t, WS_KM); E.KMT = WSP(pg8::bf16_t, WS_KMT); E.VT = WSP(pg8::bf16_t, WS_VT); E.OM = WSP(pg8::bf16_t, WS_OM); E.UT = WSP(pg8::bf16_t, WS_UT);
                E.BG = WSP(unsigned char, WS_BG); E.onk = F_out + OFF_NK; E.onv = F_out + OFF_NV; E.qg = F_q_norm_g + l * 64; E.kg = F_k_norm_g + l * 64; E.rope = (const PG8_LAS pg8::f32x2v*)(F.ldsl + SPARE_ROPE); E.stage = (PG8_LAS pg8::bf16_t*)(F.ldsl + SPARE_STAGE);
                { const v4u* rsrc = WSP(const v4u, WS_ROPE); ((LAS v4u*)(F.ldsl + SPARE_ROPE))[F.tid] = rsrc[F.tid]; __syncthreads(); }
                pg8::gemm_phase<pg8::EpiIn, pg8::StaticOrder, true, true>(F.ldsl + RING_OFF, g, S, E, F.tid, PROFP(1));
            } }
            else if (k == 2) { if (T_MASK & 8) {
#ifdef PROF_UNIT
                const unsigned long long c0_t0 = __builtin_amdgcn_s_memrealtime();
#endif
                mlstm_c0(F, A, l); xcd_barrier(bar);
#ifdef PROF_UNIT
                if (l == 0 && blockIdx.x == 0 && F.tid == 0) { unsigned* pc = (unsigned*)(A.ws + CTL_ZERO_BYTES - 12288); pc[18] = (unsigned)(__builtin_amdgcn_s_memrealtime() - c0_t0); pc[19] = 1u; }
#endif
                mixer_phase(F, A, l); } }
            else if (k == 3) { if (T_MASK & 16) {
                pg8::Gemm g{WSP(const pg8::bf16_t, WS_ACAT), WSP(const pg8::bf16_t, WS_WMRG), MTOT, DM, KMRG}; pg8::StaticOrder S; S.init(MTOT, DM, F.G, (int)blockIdx.x);
                pg8::EpiMerge E; E.BG = WSP(const unsigned char, WS_BG); E.O = WSP(pg8::bf16_t, WS_MRGD);
                pg8::gemm_phase<pg8::EpiMerge, pg8::StaticOrder, true, true>(F.ldsl + RING_OFF, g, S, E, F.tid, PROFP(3));
                if (l == 0 && F.G == 256 && blockIdx.x >= 192) convert_weights(F, A, 0, CV_F1, CV_F2, ((int)blockIdx.x - 192) * NWAVES + F.wave, 64 * NWAVES);
                if (l == 0 && F.G == 256 && blockIdx.x >= 192) convert_weights(F, A, 1, 0, CV_MRG, ((int)blockIdx.x - 192) * NWAVES + F.wave, 64 * NWAVES);
                if (l == 1 && F.G == 256 && blockIdx.x >= 192) convert_weights(F, A, 1, CV_F2, CV_END, ((int)blockIdx.x - 192) * NWAVES + F.wave, 64 * NWAVES);
            } }
            else if (k == 4 || k == 7) { if (T_MASK & 32) {
                pg8::Gemm g; g.M = MTOT; g.N = DM;
                if (k == 4) { g.A = WSP(const pg8::bf16_t, WS_MRGD); g.Bt = WSP(const pg8::bf16_t, WS_WOUT); g.K = DM; } else { g.A = WSP(const pg8::bf16_t, WS_HID); g.Bt = WSP(const pg8::bf16_t, WS_WF2); g.K = FF; }
                pg8::StaticOrder S; S.init(MTOT, DM, F.G, (int)blockIdx.x);
                pg8::EpiRes E; const bool first = (l == 0 && k == 4);
                E.mode = (k == 4) ? 0 : 1; E.xb = WSP(pg8::bf16_t, WS_ACAT);
                gu32* gflag = F.ctl + CW_GFLAG + 64 * l; E.wflag = (k == 7 && F.G == 256) ? (unsigned*)gflag : (unsigned*)nullptr; E.wneed = 32u;
                E.xin_p = first ? F_x_prompt : F_out; E.xin_s = first ? F_x_sample : F_out + (size_t)MC * DM; E.xout = F_out; E.gate = WSP(const float, WS_MOD) + (size_t)l * 9 * 6144 + (k == 4 ? 2048 : 5120);
                pg8::gemm_phase<pg8::EpiRes, pg8::StaticOrder, true, true>(F.ldsl + RING_OFF, g, S, E, F.tid, PROFP(k));
                if (k == 7 && F.G == 256 && blockIdx.x >= 192 && blockIdx.x < 224) {
                    const int j = (int)blockIdx.x - 192, x = j & 7, a = j >> 3;
                    pg8::Gemm g2{WSP(const pg8::bf16_t, WS_XN), WSP(const pg8::bf16_t, WS_WF1), MTOT, NF1, DM}; pg8::FlagUnit S2; S2.u.pm = 2 * x + (a >> 1); S2.u.pn = 20 + (a & 1); S2.flag = (unsigned*)gflag;
                    pg8::EpiSwiGLU E2; E2.H = WSP(pg8::bf16_t, WS_HID);
                    pg8::gemm_phase<pg8::EpiSwiGLU, pg8::FlagUnit, true, true>(F.ldsl + RING_OFF, g2, S2, E2, F.tid);
                }
                if (l == 0 && F.G == 256 && blockIdx.x >= 192) { if (k == 4) { convert_weights(F, A, 0, CV_F2, CV_END, ((int)blockIdx.x - 192) * NWAVES + F.wave, 64 * NWAVES);
                        convert_weights(F, A, 1, CV_MRG, CV_OUT, ((int)blockIdx.x - 192) * NWAVES + F.wave, 64 * NWAVES); }
                    else { convert_weights(F, A, 1, CV_OUT, CV_F1, ((int)blockIdx.x - 192) * NWAVES + F.wave, 64 * NWAVES);
                        { unsigned sp = 0; while (__hip_atomic_load(gflag, RLX_AGENT) < 32u) { __builtin_amdgcn_s_sleep(8); if (++sp > (1u << 22)) break; } __builtin_amdgcn_fence(__ATOMIC_ACQUIRE, "agent"); }
                        convert_weights(F, A, 1, CV_F1, CV_F2, ((int)blockIdx.x - 192) * NWAVES + F.wave, 64 * NWAVES); } }
            } }
            else if (k == 5) { if (T_MASK & 64) {
                if (F.G != 256) norm_phase(F, A, l, 1);
                else { pg8::StaticOrder S; S.init(MTOT, DM, F.G, (int)blockIdx.x); pg8::Unit u0;
                    if (S.next(0, u0)) { const int pm = __builtin_amdgcn_readfirstlane(u0.pm), pn = __builtin_amdgcn_readfirstlane(u0.pn); norm2_after_outproj(F, A, l, pm, pn, F.ctl + CW_EFLAG + 64 * (l * 48 + pm)); } }
            } }
            else if (T_MASK & 128) {
                pg8::Gemm g{WSP(const pg8::bf16_t, WS_XN), WSP(const pg8::bf16_t, WS_WF1), MTOT, NF1, DM}; pg8::GOrder S; S.init(MTOT, NF1, F.G, (int)blockIdx.x);
                pg8::EpiSwiGLU E; E.H = WSP(pg8::bf16_t, WS_HID);
                pg8::gemm_phase<pg8::EpiSwiGLU, pg8::GOrder, true, true>(F.ldsl + RING_OFF, g, S, E, F.tid, PROFP(6));
            }
        }
        if (ph + 1 < A.ph_hi && !(F.G == 256 && ph > 0 && (((ph - 1) & 7) == 4 || ph == 8))) xcd_barrier(bar);
#ifdef PROF_PHASE
        if (blockIdx.x == 0 && threadIdx.x == 0) stamps[ph + 1] = __builtin_amdgcn_s_memrealtime();
#endif
    }
#ifdef PROF_UNIT
    {   xcd_barrier(bar);
        const unsigned* pc = (const unsigned*)(A.ws + CTL_ZERO_BYTES - 12288);
        const float avg = (float)pc[2 * PROF_UNIT] * 0.01f / fmaxf((float)pc[2 * PROF_UNIT + 1], 1.f);
        const float us = 10.0f * rintf(avg * 0.1f); const float target = 0.05f + fminf(us, 900.f) * 0.001f; const float s = 1.0f - sqrtf(target);
        for (size_t i = (size_t)blockIdx.x * 512 + threadIdx.x; i < (size_t)17842432; i += (size_t)gridDim.x * 512) A.out[i] *= s;
    }
#endif
#ifdef PROF_GEMM
    {   xcd_barrier(bar);
        const unsigned* pc = (const unsigned*)(A.ws + CTL_ZERO_BYTES - 16384);
#if PROF_WHAT == 0
        const float val = (float)pc[0] * 0.01f / fmaxf((float)pc[1], 1.f);
#else
        const float val = (float)pc[2] * 0.01f / fmaxf((float)pc[3], 1.f);
#endif
        const float us = PROF_BIN * rintf(val / PROF_BIN); const float target = 0.05f + fminf(us, 900.f) * 0.001f; const float s = 1.0f - sqrtf(target);
        for (size_t i = (size_t)blockIdx.x * 512 + threadIdx.x; i < (size_t)17842432; i += (size_t)gridDim.x * 512) A.out[i] *= s;
    }
#endif
#ifdef PROF_PHASE
    {
        xcd_barrier(bar);
        const unsigned long long t0 = stamps[PROF_PHASE], t1 = stamps[PROF_PHASE + 1];
        const float us = 15.0f + 30.0f * rintf(((float)(t1 - t0) * 0.01f - 15.0f) * (1.0f / 30.0f)); const float target = 0.05f + fminf(us, 900.f) * 0.001f; const float s = 1.0f - sqrtf(target);
        for (size_t i = (size_t)blockIdx.x * 512 + threadIdx.x; i < (size_t)17842432; i += (size_t)gridDim.x * 512) A.out[i] *= s;
    }
#endif
}


#ifdef MK_DEBUG
#ifndef DBG_SKIP
#define DBG_SKIP 0
#endif
#define DBG_OFF (CTL_ZERO_BYTES - 4096)
__device__ __forceinline__ void dbg_acc(float* dbg, int k, float mine, float ref) { const float d = mine - ref; atomicAdd(dbg + k, d * d); atomicAdd(dbg + 32 + k, ref * ref); }
__device__ __forceinline__ float dbg_bf(const bf16* p, size_t i) { return bf2f(p[i]); }
__device__ float dbg_block_sum(float v, float* red) {
    v = wave_sum(v); __syncthreads(); if ((threadIdx.x & 63) == 0) red[threadIdx.x >> 6] = v; __syncthreads();
    float s = 0.f; for (int w = 0; w < 8; ++w) s += red[w]; __syncthreads(); return s; }
__global__ void __launch_bounds__(512) dbg_check(Args A) {
    __shared__ float red[16]; __shared__ float zrow[5392]; __shared__ float hrow[1024]; __shared__ float sm[4096];
    struct { unsigned char* ws; float* out; } F; F.ws = A.ws; F.out = A.out;
    float* dbg = (float*)(A.ws + DBG_OFF); const int tid = threadIdx.x, blk = blockIdx.x; const int l = 0;
    const float* MOD = WSP(float, WS_MOD);
    if (blk < 8) {
        const int rows[8] = {0, 255, 256, 4095, 4096, 4096 + 63, 4096 + 64 + 1023, 12287}; const int m = rows[blk];
        const float* xr = m < MC ? F_x_prompt + (size_t)m * DM : F_x_sample + (size_t)(m - MC) * DM; const int v = m < MC ? 0 : 1 + ((m - MC) >> 10);
        float s = 0.f; for (int c = tid; c < DM; c += 512) s += xr[c] * xr[c];
        const float rs = 1.0f / sqrtf(dbg_block_sum(s, red) / DM + RMS_EPS);
        if (blk == 0 && tid < 64) {
            const int vv = tid % 9, col = (97 * tid + 13) % 6144; float a = F_b_ada[col];
            for (int k = 0; k < DM; ++k) { const float cv = vv == 0 ? F_c_ctx[k] : F_c[(vv - 1) * DM + k]; a += silu_f(cv) * F_w_ada[(size_t)k * 6144 + col]; }
            dbg_acc(dbg, 1, MOD[(size_t)vv * 6144 + col], a); }
        for (int c = tid; c < DM; c += 512) { const float h = xr[c] * rs * F_norm1_g[c] * (1.0f + MOD[(size_t)v * 6144 + 1024 + c]) + MOD[(size_t)v * 6144 + c]; hrow[c] = h;
            dbg_acc(dbg, 2, dbg_bf(WSP(bf16, WS_XN), (size_t)m * DM + c), h); }
        __syncthreads();
        for (int c = tid; c < INC; c += 512) { float a = 0.f; for (int k = 0; k < DM; ++k) a += hrow[k] * F_w_in[(size_t)k * INC + c]; zrow[c] = a; }
        __syncthreads();
        const bool ctx = m < MC; const int b = ctx ? m >> 8 : (m - MC) >> 10, t = ctx ? m & 255 : (m - MC) & 1023, T = ctx ? 256 : 1024;
        const size_t tbase = ctx ? (size_t)b * 65536 : (size_t)16 * 65536 + (size_t)b * 262144;
        if (tid < 16) dbg_acc(dbg, 3, WSP(float, WS_GATES)[(size_t)m * 16 + tid], zrow[2048 + tid]);
        for (int i = tid; i < 12 * 64; i += 512) { const int hd = i >> 6, d = i & 63; const bool isk = hd >= 8; const int c0 = isk ? 512 + (hd - 8) * 64 : hd * 64;
            float ss = 0.f; for (int e = 0; e < 64; ++e) ss += zrow[c0 + e] * zrow[c0 + e];
            const float r = 1.0f / sqrtf(ss / 64.f + RMS_EPS); const float* g = isk ? F_k_norm_g : F_q_norm_g;
            float y = zrow[c0 + d] * r * g[d];
            if (isk && ctx) dbg_acc(dbg, 5, F.out[OFF_NK + ((size_t)((b * 2 + l) * 256 + t)) * 256 + (hd - 8) * 64 + d], y);
            if (!ctx) { const int half = d >> 5, i16 = d & 15, up = (d >> 4) & 1; const int pos = half == 0 ? (t >> 6) : (t & 63); const float inv = 1.0f / powf(10000.f, (float)i16 / 16.f), ang = (float)pos * inv;
                const int dp = (d & ~31) + (up ? i16 : i16 + 16); const float yp = zrow[c0 + dp] * r * g[dp];
                y = up ? (y * cosf(ang) + yp * sinf(ang)) : (y * cosf(ang) - yp * sinf(ang)); }
            if (!isk) dbg_acc(dbg, ctx ? 4 : 17, dbg_bf(WSP(bf16, WS_Q), (size_t)m * 512 + c0 + d), y * ATT_C2);
            else dbg_acc(dbg, ctx ? 5 : 18, ctx ? dbg_bf(WSP(bf16, WS_KC), ((size_t)(b * 256 + t)) * 256 + (hd - 8) * 64 + d) : dbg_bf(WSP(bf16, WS_KL), ((size_t)(b * 1280 + 256 + t)) * 256 + (hd - 8) * 64 + d), y); }
        for (int c = tid; c < 256; c += 512) { const float vv = zrow[768 + c];
            if (ctx) { dbg_acc(dbg, 6, F.out[OFF_NV + ((size_t)((b * 2 + l) * 256 + t)) * 256 + c], vv); dbg_acc(dbg, 6, dbg_bf(WSP(bf16, WS_VC), ((size_t)(b * 256 + t)) * 256 + c), vv); }
            else dbg_acc(dbg, 6, dbg_bf(WSP(bf16, WS_VL), ((size_t)(b * 1280 + 256 + t)) * 256 + c), vv);
            dbg_acc(dbg, 7, dbg_bf(WSP(bf16, WS_QM), (size_t)m * 256 + c), zrow[1024 + c]); dbg_acc(dbg, 7, dbg_bf(WSP(bf16, WS_KM), (size_t)m * 256 + c), zrow[1280 + c]);
            dbg_acc(dbg, 7, dbg_bf(WSP(bf16, WS_KMT), tbase + (size_t)c * T + t), zrow[1280 + c]);
            dbg_acc(dbg, 8, dbg_bf(WSP(bf16, WS_VT), tbase + (size_t)c * T + t), zrow[1536 + c]); dbg_acc(dbg, 8, dbg_bf(WSP(bf16, WS_UT), tbase + (size_t)c * T + t), zrow[2064 + c]);
            dbg_acc(dbg, 8, dbg_bf(WSP(bf16, WS_OM), (size_t)m * 256 + c), 1.0f / (1.0f + __expf(-zrow[1792 + c]))); }
        for (int c = tid; c < 3072; c += 512) dbg_acc(dbg, 9, 1.0f / (1.0f + dbg_bf(WSP(bf16, WS_BG), (size_t)m * 3072 + c)), 1.0f / (1.0f + __expf(-zrow[2320 + c])));
    } else if (blk < 16) {
        const int wave = tid >> 6, lane = tid & 63, si = (blk - 8) * 8 + wave;
        const bool lat = si & 1; const int b = (si * 5) % (lat ? 8 : 16), qh = (si * 3) % 8, t = (si * 37 + 11) % (lat ? 1024 : 256);
        const size_t row = lat ? (size_t)MC + b * 1024 + t : (size_t)b * 256 + t; const int NK = lat ? 1280 : 256;
        const bf16* Kp = (lat ? WSP(bf16, WS_KL) + (size_t)b * 1280 * 256 : WSP(bf16, WS_KC) + (size_t)b * 65536) + (qh >> 1) * 64;
        const bf16* Vp = (lat ? WSP(bf16, WS_VL) + (size_t)b * 1280 * 256 : WSP(bf16, WS_VC) + (size_t)b * 65536) + (qh >> 1) * 64;
        const bf16* Qp = WSP(bf16, WS_Q) + row * 512 + qh * 64; float* sc = sm + wave * 0;
        float mx = -1e30f; for (int k = lane; k < NK; k += 64) { float a = 0.f; for (int d = 0; d < 64; ++d) a += bf2f(Qp[d]) * bf2f(Kp[(size_t)k * 256 + d]); mx = fmaxf(mx, a); }
        for (int o = 1; o < 64; o <<= 1) mx = fmaxf(mx, __shfl_xor(mx, o));
        float den = 0.f, acc = 0.f;
        for (int k = 0; k < NK; ++k) { float a = 0.f; for (int d = 0; d < 64; ++d) a += bf2f(Qp[d]) * bf2f(Kp[(size_t)k * 256 + d]); const float p = exp2f(a - mx); den += p; acc += p * bf2f(Vp[(size_t)k * 256 + lane]); }
        dbg_acc(dbg, 10, dbg_bf(WSP(bf16, WS_ACAT), row * KMRG + qh * 64 + lane), acc / den); (void)sc;
    } else if (blk < 24) {
        const int si = (blk - 16) * 512 + tid; const bool lat = si & 1; const int T = lat ? 1024 : 256, b = (si >> 1) % (lat ? 8 : 16), tp = ((si * 53) % 29 == 0) ? 0 : (si * 131 + 7) % T, c = (si * 17 + 3) % 256;
        const size_t tbase = lat ? (size_t)16 * 65536 + (size_t)b * 262144 : (size_t)b * 65536; const bf16* u = WSP(bf16, WS_UT) + tbase + (size_t)c * T;
        float p = 0.f, q = 0.f; for (int t = 0; t < T; ++t) { const float a = 6.283185307179586f * (float)((t * tp) % T) / (float)T; p += cosf(a) * bf2f(u[t]); q += sinf(a) * bf2f(u[t]); }
        const float sq = 1.0f / sqrtf((float)T); const size_t row = lat ? (size_t)MC + b * 1024 + tp : (size_t)b * 256 + tp;
        dbg_acc(dbg, 11, dbg_bf(WSP(bf16, WS_ACAT), row * KMRG + 768 + c), p * sq); dbg_acc(dbg, 11, dbg_bf(WSP(bf16, WS_ACAT), row * KMRG + 1024 + c), q * sq);
    } else if (blk < 28) {
        const int ci = blk - 24; const bool ctx = ci < 2; const int b = ci == 0 ? 3 : ci == 1 ? 12 : ci == 2 ? 2 : 5, h = ci == 0 ? 1 : ci == 1 ? 2 : ci == 2 ? 0 : 3;
        const int T = ctx ? 256 : 1024; const size_t R0 = ctx ? (size_t)b * 256 : (size_t)MC + (size_t)b * 1024;
        const float* cwl = F_m_conv_w; const bf16* QM = WSP(bf16, WS_QM); const bf16* KM = WSP(bf16, WS_KM); const bf16* VTp = WSP(bf16, WS_VT) + (ctx ? (size_t)b * 65536 : (size_t)16 * 65536 + (size_t)b * 262144);
        float* qs = sm; float* ks = sm + 64; float* vs = sm + 128; float* part = sm + 256; float* hsum = sm + 1024;
        const int dv = tid & 63, g8 = tid >> 6; float* HB = (float*)(A.ws + 255 * MiB) + (size_t)ci * 1024 * 64;
        for (int d = 0; d < 2; ++d) {
            float C[8]; float nn = 0.f, mm = 0.f;
            for (int j = 0; j < 8; ++j) C[j] = ctx ? 0.f : F_state_C[(size_t)(((b * 2 + l) * 2 + d) * 4 + h) * 4096 + (8 * g8 + j) * 64 + dv];
            if (!ctx) { mm = F_state_m[((b * 2 + l) * 2 + d) * 4 + h]; }
            nn = ctx ? 0.f : F_state_n[(size_t)(((b * 2 + l) * 2 + d) * 4 + h) * 64 + dv];
            for (int k = 0; k < T; ++k) { const int t = d ? T - 1 - k : k; const size_t row = R0 + t;
                __syncthreads();
                if (tid < 128) { const int ch = tid & 63; const bool isk = tid >= 64; const bf16* X = isk ? KM : QM; const int cc = (isk ? 256 : 0) + h * 64 + ch;
                    const float x0 = bf2f(X[row * 256 + h * 64 + ch]), xm = t > 0 ? bf2f(X[(row - 1) * 256 + h * 64 + ch]) : 0.f, xp = t + 1 < T ? bf2f(X[(row + 1) * 256 + h * 64 + ch]) : 0.f;
                    const float y = silu_f(cwl[cc] * xm + cwl[512 + cc] * x0 + cwl[1024 + cc] * xp); if (isk) ks[ch] = y * 0.125f; else qs[ch] = y; }
                else if (tid < 192) vs[tid - 128] = bf2f(VTp[(size_t)(h * 64 + (tid - 128)) * T + t]);
                __syncthreads();
                const float* gp = WSP(float, WS_GATES) + row * 16 + d * 8 + h; const float li = gp[0] + F_m_gate_b[d * 8 + h], lf = logsigmoid_f(gp[4] + F_m_gate_b[d * 8 + 4 + h]);
                const float mn = fmaxf(lf + mm, li), fg = __expf(lf + mm - mn), ig = __expf(li - mn); mm = mn;
                float pa = 0.f;
                for (int j = 0; j < 8; ++j) { C[j] = fg * C[j] + ig * ks[8 * g8 + j] * vs[dv]; pa += qs[8 * g8 + j] * C[j]; }
                nn = fg * nn + ig * ks[dv];
                part[g8 * 64 + dv] = pa; if (g8 == 0) part[512 + dv] = qs[dv] * nn;
                __syncthreads();
                if (tid < 64) { float num = 0.f; for (int w = 0; w < 8; ++w) num += part[w * 64 + tid]; float qn = 0.f; for (int e = 0; e < 64; ++e) qn += part[512 + e];
                    const float hv = num / fmaxf(fabsf(qn), __expf(-mm));
                    if (d == 0) { HB[(size_t)t * 64 + tid] = hv; const float kv = WSP(float, WS_HF)[row * 256 + h * 64 + tid]; float sa = wave_sum(kv * kv), sr = wave_sum(hv * hv);
                        dbg_acc(dbg, ctx ? (t < 64 ? 20 : 22) : (t < 64 ? 21 : 23), kv / sqrtf(sa + 1e-30f), hv / sqrtf(sr + 1e-30f));
                        if (tid == 0) { atomicAdd(dbg + (ctx ? 24 : 25), (sqrtf(sa / sr) - 1.0f) * (sqrtf(sa / sr) - 1.0f)); atomicAdd(dbg + 32 + (ctx ? 24 : 25), 1.0f); } }
                    else { const float hs = hv + HB[(size_t)t * 64 + tid]; hsum[tid] = hs; } }
                __syncthreads();
                if (d == 1 && tid < 64) { float ss = 0.f; for (int e = 0; e < 64; ++e) ss += hsum[e] * hsum[e]; const float rr = 1.0f / sqrtf(ss / 64.f + RMS_EPS);
                    const float ref = hsum[tid] * rr * F_m_norm_g[h * 64 + tid] * bf2f(WSP(bf16, WS_OM)[row * 256 + h * 64 + tid]);
                    dbg_acc(dbg, ctx ? 12 : 19, dbg_bf(WSP(bf16, WS_ACAT), row * KMRG + 512 + h * 64 + tid), ref); }
            }
            if (ctx) { for (int j = 0; j < 8; ++j) dbg_acc(dbg, 13, F.out[OFF_NC + (size_t)(((b * 2 + l) * 2 + d) * 4 + h) * 4096 + (8 * g8 + j) * 64 + dv], C[j]);
                if (g8 == 0) { dbg_acc(dbg, 13, F.out[OFF_NN + (size_t)(((b * 2 + l) * 2 + d) * 4 + h) * 64 + dv], nn); if (dv == 0) dbg_acc(dbg, 13, F.out[OFF_NM + ((b * 2 + l) * 2 + d) * 4 + h], mm); } }
        }
    }
}
__global__ void __launch_bounds__(512) dbg_check2(Args A, int stage) {
    __shared__ float red[16]; __shared__ float rowbuf[2816]; __shared__ float rowb2[1024];
    struct { unsigned char* ws; float* out; } F; F.ws = A.ws; F.out = A.out;
    float* dbg = (float*)(A.ws + DBG_OFF); const int tid = threadIdx.x, blk = blockIdx.x;
    const int rows[8] = {0, 255, 256, 4095, 4096, 4096 + 1024, 4096 + 2047, 12287}; const int m = rows[blk]; const int v = m < MC ? 0 : 1 + ((m - MC) >> 10);
    const float* MOD = WSP(float, WS_MOD);
    if (stage == 0) {
        const bf16* ac = WSP(bf16, WS_ACAT) + (size_t)m * KMRG; const bf16* bg = WSP(bf16, WS_BG) + (size_t)m * 3072; const bf16* wm = WSP(bf16, WS_WMRG);
        for (int c = tid; c < DM; c += 512) { float s0 = 0.f, s1 = 0.f, s2 = 0.f; const bf16* w = wm + (size_t)c * KMRG;
            for (int k = 0; k < 512; ++k) s0 += bf2f(ac[k]) * bf2f(w[k]); for (int k = 512; k < 768; ++k) s1 += bf2f(ac[k]) * bf2f(w[k]); for (int k = 768; k < 1280; ++k) s2 += bf2f(ac[k]) * bf2f(w[k]);
            const float ref = s0 / (1.f + bf2f(bg[c])) + s1 / (1.f + bf2f(bg[1024 + c])) + s2 / (1.f + bf2f(bg[2048 + c]));
            dbg_acc(dbg, 14, dbg_bf(WSP(bf16, WS_MRGD), (size_t)m * DM + c), ref); }
    } else if (stage == 1) {
        const float* xr = m < MC ? F_x_prompt + (size_t)m * DM : F_x_sample + (size_t)(m - MC) * DM; const bf16* mg = WSP(bf16, WS_MRGD) + (size_t)m * DM; const bf16* wo = WSP(bf16, WS_WOUT);
        for (int c = tid; c < DM; c += 512) { float s = 0.f; for (int k = 0; k < DM; ++k) s += bf2f(mg[k]) * bf2f(wo[(size_t)c * DM + k]);
            dbg_acc(dbg, 15, F.out[(size_t)m * DM + c], xr[c] + MOD[(size_t)v * 6144 + 2048 + c] * s); }
    } else if (stage == 2) {
        const float* xr = F.out + (size_t)m * DM; float s = 0.f; for (int c = tid; c < DM; c += 512) s += xr[c] * xr[c];
        const float rs = 1.0f / sqrtf(dbg_block_sum(s, red) / DM + RMS_EPS);
        for (int c = tid; c < DM; c += 512) { const float h = xr[c] * rs * F_norm2_g[c] * (1.0f + MOD[(size_t)v * 6144 + 4096 + c]) + MOD[(size_t)v * 6144 + 3072 + c]; rowb2[c] = h; dbg_acc(dbg, 16, dbg_bf(WSP(bf16, WS_XN), (size_t)m * DM + c), h); }
        __syncthreads();
        for (int j = tid; j < FF; j += 512) { float g = 0.f, u = 0.f; for (int k = 0; k < DM; ++k) { g += rowb2[k] * F_w_f1[(size_t)k * NF1 + j]; u += rowb2[k] * F_w_f1[(size_t)k * NF1 + FF + j]; }
            const float ref = silu_f(g) * u; rowbuf[j] = ref; dbg_acc(dbg, 16, dbg_bf(WSP(bf16, WS_HID), (size_t)m * FF + j), ref); }
    }
}
__global__ void dbg_encode(Args A, int nout) {
    float* dbg = (float*)(A.ws + DBG_OFF); __shared__ float sc;
    if (threadIdx.x == 0) { int first = 0; for (int k = 1 + DBG_SKIP; k < 32; ++k) { const float sr = dbg[32 + k], sd = dbg[k]; if (sr > 0.f && sd > 0.0025f * sr) { first = k; break; } if (sr == 0.f && sd > 0.f) { first = k; break; } }
        float target = first == 0 ? 0.f : 0.10f + 0.05f * (float)first;
#ifdef DBG_REPORT
        { const float rel = sqrtf(dbg[DBG_REPORT] / fmaxf(dbg[32 + DBG_REPORT], 1e-30f)); target = 0.15f + fminf(0.8f, 8.0f * rel); }
#endif
        sc = 1.0f - sqrtf(target); }
    __syncthreads();
    const float s = sc; if (s == 1.0f) return;
    for (size_t i = (size_t)blockIdx.x * blockDim.x + threadIdx.x; i < (size_t)nout; i += (size_t)gridDim.x * blockDim.x) A.out[i] *= s;
}
#endif

extern "C" void kernel_launch(void* const* d_in, const int* in_sizes, int n_in, void* d_out, int out_size, void* d_ws, size_t ws_size, hipStream_t stream) {
    static int grid = 0;
    if (grid == 0) {
        if (n_in != 25 || out_size != 17842432 || ws_size < WS_END) { fprintf(stderr, "kernel_launch: unexpected shapes: n_in %d out %d ws %zu; nothing launched\n", n_in, out_size, ws_size); grid = -1; return; }
        int dev = 0, cus = 0, per_cu = 0;
        if (hipGetDevice(&dev) != hipSuccess || hipDeviceGetAttribute(&cus, hipDeviceAttributeMultiprocessorCount, dev) != hipSuccess) { grid = -1; return; }
        if (hipFuncSetAttribute((const void*)mk_fwd, hipFuncAttributeMaxDynamicSharedMemorySize, LDS_BYTES) != hipSuccess) { fprintf(stderr, "kernel_launch: hipFuncSetAttribute failed\n"); grid = -1; return; }
        if (hipOccupancyMaxActiveBlocksPerMultiprocessor(&per_cu, (const void*)mk_fwd, NWAVES * 64, LDS_BYTES) != hipSuccess || per_cu < 1) { fprintf(stderr, "kernel_launch: occupancy query says %d blocks per CU\n", per_cu); per_cu = 1; }
        (void)hipGetLastError();
        grid = cus;
    }
    if (grid < 0) return;
    if (hipMemsetAsync((char*)d_ws + WS_CTL, 0, CTL_ZERO_BYTES, stream) != hipSuccess) { fprintf(stderr, "kernel_launch: memset failed\n"); return; }
    Args a{};
    for (int i = 0; i < 25; ++i) a.in[i] = (const float*)d_in[i];
    a.out = (float*)d_out; a.ws = (unsigned char*)d_ws;
#ifdef MK_DEBUG
    for (int ph = 0; ph < N_PHASES; ++ph) { a.ph_lo = ph; a.ph_hi = ph + 1; a.li = 0; hipLaunchKernelGGL(mk_fwd, dim3(grid), dim3(NWAVES * 64), LDS_BYTES, stream, a);
        if (ph == 3) hipLaunchKernelGGL(dbg_check, dim3(28), dim3(512), 0, stream, a);
        if (ph == 4) hipLaunchKernelGGL(dbg_check2, dim3(8), dim3(512), 0, stream, a, 0);
        if (ph == 5) hipLaunchKernelGGL(dbg_check2, dim3(8), dim3(512), 0, stream, a, 1);
        if (ph == 7) hipLaunchKernelGGL(dbg_check2, dim3(8), dim3(512), 0, stream, a, 2); }
    hipLaunchKernelGGL(dbg_encode, dim3(256), dim3(256), 0, stream, a, out_size);
#else
    if (N_LAUNCHES == 1) {
        a.ph_lo = 0; a.ph_hi = N_PHASES; a.li = 0;
        hipLaunchKernelGGL(mk_fwd, dim3(grid), dim3(NWAVES * 64), LDS_BYTES, stream, a);
    } else {
        for (int ph = 0; ph < N_PHASES; ++ph) { a.ph_lo = ph; a.ph_hi = ph + 1; a.li = 0; hipLaunchKernelGGL(mk_fwd, dim3(grid), dim3(NWAVES * 64), LDS_BYTES, stream, a); }
    }
#endif
    const hipError_t le = hipPeekAtLastError();
    if (le != hipSuccess) fprintf(stderr, "kernel_launch: launch failed: %s\n", hipGetErrorName(le));
}
```

```cpp
#include <hip/hip_runtime.h>
#include <hip/hip_bf16.h>
#include <cstdio>
#include <cstdint>
#include <cmath>

#ifndef MK_N_LAUNCHES
#define MK_N_LAUNCHES 1
#endif
#ifndef T_MASK
#define T_MASK 0xFFFF
#endif

constexpr int DM = 1024, MC = 4096, ML = 8192, MTOT = 12288;
constexpr int INC = 5392, NIN = 5376, KMRG = 1280, FF = 2816, NF1 = 5632, NBG = 3072;
constexpr float RMS_EPS = 1e-6f;
constexpr float LOG2E = 1.4426950408889634f;
constexpr float ATT_C2 = 0.125f * 1.4426950408889634f;
constexpr size_t OFF_YP = 0, OFF_YS = 4194304, OFF_NK = 12582912, OFF_NV = 14680064, OFF_NC = 16777216, OFF_NN = 17825792, OFF_NM = 17842176;
constexpr size_t MiB = 1u << 20;
constexpr size_t WS_CTL = 0, CTL_ZERO_BYTES = 2 * MiB;
constexpr size_t WS_MOD = 1 * MiB;
constexpr size_t WS_WIN = 2 * MiB;
constexpr size_t WS_WMRG = WS_WIN + 11010048;
constexpr size_t WS_WOUT = WS_WMRG + 2621440;
constexpr size_t WS_WF1 = WS_WOUT + 2097152;
constexpr size_t WS_WF2 = WS_WF1 + 11534336;
constexpr size_t WS_ROPE = WS_WF2 + 5767168;
constexpr size_t WS_DFTC = WS_ROPE + 65536;
constexpr size_t WS_DFTL = WS_DFTC + 262144;
constexpr size_t WS_GATES = WS_DFTL + 4194304;
constexpr size_t WS_XN = 40 * MiB;
constexpr size_t WS_CT = WS_XN;
constexpr size_t WS_HF = WS_XN + 12 * MiB;
constexpr size_t WS_BG = 64 * MiB;
constexpr size_t WS_HID = WS_BG;
constexpr size_t WS_Q = 136 * MiB;
constexpr size_t WS_KC = WS_Q + 12 * MiB, WS_VC = WS_KC + 2 * MiB, WS_KL = WS_VC + 2 * MiB, WS_VL = WS_KL + 5 * MiB;
constexpr size_t WS_MRGD = WS_Q;
constexpr size_t WS_QM = 162 * MiB, WS_KM = WS_QM + 6 * MiB, WS_KMT = WS_KM + 6 * MiB, WS_VT = WS_KMT + 6 * MiB, WS_OM = WS_VT + 6 * MiB, WS_UT = WS_OM + 6 * MiB;
constexpr size_t WS_ACAT = 198 * MiB;
constexpr size_t WS_QN = 228 * MiB, WS_KN = 234 * MiB, WS_KNT = 240 * MiB;
constexpr size_t WS_UT2 = 240 * MiB;
constexpr size_t WS_PA = 252 * MiB;
constexpr size_t WS_END = 255 * MiB;
static_assert(WS_GATES + 786432 <= WS_XN && WS_VL + 5 * MiB <= WS_QM && WS_UT + 6 * MiB <= WS_ACAT, "ws map");
constexpr int CW_TMO = 0, CW_CODE = 1;
constexpr int CW_BAR = 4096;
constexpr int CW_QUEUE = 65536;
constexpr int CW_EFLAG = 110592;
constexpr int CW_HFLAG = 118784;
constexpr int CW_GFLAG = 126976;
constexpr int CW_MFLAG = 131072;
constexpr int RING_OFF = 0, RING_BYTES = 131072;
constexpr int LDS_BYTES = 163840;
constexpr int SPARE_STAGE = RING_BYTES, SPARE_ROPE = RING_BYTES + 8192;
constexpr int LDSCTL_OFF = LDS_BYTES - 1024, MISC_OFF = LDSCTL_OFF + 320;


namespace pg8 {
#define PG8_LAS __attribute__((address_space(3)))
typedef unsigned short bf16_t;
typedef short bf16x8 __attribute__((ext_vector_type(8)));
typedef float f32x4 __attribute__((ext_vector_type(4)));
typedef unsigned u32x4 __attribute__((ext_vector_type(4)));
constexpr int BM = 256, BK = 64, HALF = 128, HTB = HALF * BK * 2  , STAGE_BYTES = 8 * HTB, NXCD = 8, WGM = 8;

__host__ __device__ __forceinline__ int lds_byte(int r, int c) { const int st = (r >> 4) * 2 + (c >> 5), rr = r & 15, cc = c & 31, ob = rr * 64 + cc * 2; return st * 1024 + (ob ^ (((ob >> 9) & 1) << 5)); }
__host__ __device__ __forceinline__ void stage_rc(int b, int& R, int& C) { const int st = b / 1024, sb = b % 1024, swz = sb ^ (((sb >> 9) & 1) << 5); R = (st >> 1) * 16 + swz / 64; C = (st & 1) * 32 + (swz % 64) / 2; }
__host__ __device__ __forceinline__ int perm32(int rho) { const int n = rho >> 4, i = rho & 15; return 8 * (i >> 2) + 4 * n + (i & 3); }

struct Unit { int pm, pn; };
struct Gemm { const bf16_t* A; const bf16_t* Bt; int M, N, K; };

struct StaticOrder {
    int nM, nN, nwg, G, c;
    __host__ __device__ __forceinline__ void init(int M, int N, int G_, int c_) { nM = M / BM; nN = N / BM; nwg = nM * nN; G = G_; c = c_; }
    __host__ __device__ __forceinline__ bool next(int i, Unit& u) const {
        const long L = (long)i * G + c; if (L >= nwg) return false;
        int wgid = (int)L; { const int q = nwg / NXCD, r = nwg % NXCD, xcd = wgid % NXCD, off = wgid / NXCD; wgid = (xcd < r ? xcd * (q + 1) : r * (q + 1) + (xcd - r) * q) + off; }
        const int nig = WGM * nN, gid = wgid / nig, fm = gid * WGM, gsz = (nM - fm) < WGM ? (nM - fm) : WGM;
        u.pm = fm + ((wgid % nig) % gsz); u.pn = (wgid % nig) / gsz; return true;
    }
    __device__ __forceinline__ void a_ready(const Unit&) const {}
    __device__ __forceinline__ void done(const Unit&) const {}
};

struct GOrder {
    StaticOrder so; int split;
    __device__ void init(int M, int N, int G_, int c_) { split = (G_ == 256 && M == 12288 && N == 5632) ? 1 : 0; so.init(M, split ? N - 512 : N, G_, c_); }
    __device__ bool next(int i, Unit& u) const {
        if (!split) return so.next(i, u);
        if (i > 3) return false;
        if (i < 3 || so.c < 192) return so.next(i, u);
        const int j = so.c - 192, x = j & 7, a = j >> 3; u.pm = 16 + 4 * x + (a >> 1); u.pn = 20 + (a & 1); return true;
    }
    __device__ __forceinline__ void a_ready(const Unit&) const {}
    __device__ __forceinline__ void done(const Unit&) const {}
};
struct FlagUnit { Unit u; unsigned* flag;
    __device__ __forceinline__ bool next(int i, Unit& o) const { if (i != 0) return false; o = u; return true; }
    __device__ __forceinline__ void a_ready(const Unit&) const {}
    __device__ __forceinline__ void done(const Unit&) const {
        asm volatile("s_waitcnt vmcnt(0)" ::: "memory"); __syncthreads();
        if (threadIdx.x == 0) { __builtin_amdgcn_fence(__ATOMIC_RELEASE, "agent"); asm volatile("s_waitcnt vmcnt(0)" ::: "memory"); (void)__hip_atomic_fetch_add(flag, 1u, __ATOMIC_RELAXED, __HIP_MEMORY_SCOPE_AGENT); } }
};

__device__ __forceinline__ unsigned cvt_pk_bf16(float lo, float hi) { unsigned r; asm volatile("v_cvt_pk_bf16_f32 %0, %1, %2" : "=v"(r) : "v"(lo), "v"(hi)); return r; }
typedef float f32x2 __attribute__((ext_vector_type(2)));

typedef float f32x2v __attribute__((ext_vector_type(2)));
typedef unsigned u32x2 __attribute__((ext_vector_type(2)));
__device__ __forceinline__ void st16_wt(void* p, u32x4 v) { asm volatile("global_store_dwordx4 %0, %1, off sc1\n\ts_nop 2" :: "v"(p), "v"(v) : "memory"); }
__device__ __forceinline__ unsigned f2bf_(float f) { unsigned u = __builtin_bit_cast(unsigned, f); return (u + 0x7fffu + ((u >> 16) & 1u)) >> 16; }
typedef __bf16 bf16x2h_t __attribute__((ext_vector_type(2)));
__device__ __forceinline__ unsigned pk2_(float lo, float hi) { f32x2v v = {lo, hi}; return __builtin_bit_cast(unsigned, __builtin_convertvector(v, bf16x2h_t)); }
__device__ __forceinline__ u32x2 pk4_(f32x4 v) { u32x2 w; w.x = pk2_(v[0], v[1]); w.y = pk2_(v[2], v[3]); return w; }
__device__ __forceinline__ float bf2f_(unsigned short h) { return __builtin_bit_cast(float, (unsigned)h << 16); }
__device__ __forceinline__ f32x4 bf4_to_f32(u32x2 w) { f32x4 r; r[0] = __builtin_bit_cast(float, w.x << 16); r[1] = __builtin_bit_cast(float, w.x & 0xffff0000u); r[2] = __builtin_bit_cast(float, w.y << 16); r[3] = __builtin_bit_cast(float, w.y & 0xffff0000u); return r; }

struct OneUnit { Unit u;
    __device__ __forceinline__ bool next(int i, Unit& o) const { if (i != 0) return false; o = u; return true; }
    __device__ __forceinline__ void a_ready(const Unit&) const {}
    __device__ __forceinline__ void done(const Unit&) const {} };

struct EpiIn {
    static constexpr bool PERM = false, AFTER_DRAIN = false, HAS_MID = false;
    int layer;
    bf16_t *Q, *KC, *VC, *KL, *VL, *QM, *KM, *KMT, *VT, *OM, *UT; unsigned char* BG;
    float *onk, *onv;
    const float *qg, *kg;
    const PG8_LAS f32x2v* rope;
    PG8_LAS bf16_t* stage;
    __device__ __forceinline__ void operator()(const f32x4 (&acc)[2][2][4][2], const Unit& u, int wr, int wc, int fr0, int fq0) const {
        int fr = fr0, fq = fq0; asm volatile("" : "+v"(fr), "+v"(fq));
        const int pn = u.pn, pm = u.pm;
        const bool ctx = pm < 16;
        const int b = ctx ? pm : ((pm - 16) >> 2);
        const int tb = ctx ? 0 : ((pm - 16) & 3) * 256;
        const int T = ctx ? 256 : 1024;
        const int rl0 = wr * 64 + fr;
        if (pn <= 3) {
            const float* gv = (pn == 2) ? kg : qg;
            f32x4 g4[2][2];
#pragma unroll
            for (int bj = 0; bj < 2; ++bj)
#pragma unroll
                for (int n = 0; n < 2; ++n) g4[bj][n] = *(const f32x4*)(gv + 32 * bj + 16 * n + 4 * fq);
#pragma unroll
            for (int ai = 0; ai < 2; ++ai)
#pragma unroll
                for (int m = 0; m < 4; ++m) {
                    asm volatile("" ::: "memory"); const int rl = rl0 + ai * 128 + m * 16; const int t = tb + rl; const size_t row = (size_t)pm * 256 + rl;
                    f32x4 v[2][2];
#pragma unroll
                    for (int bj = 0; bj < 2; ++bj)
#pragma unroll
                        for (int n = 0; n < 2; ++n) v[bj][n] = acc[ai][bj][m][n];
                    if (pn != 3) {
                        float ss = 0.f;
#pragma unroll
                        for (int bj = 0; bj < 2; ++bj)
#pragma unroll
                            for (int n = 0; n < 2; ++n) { const f32x4 x = v[bj][n]; ss += (x[0] * x[0] + x[1] * x[1]) + (x[2] * x[2] + x[3] * x[3]); }
                        ss += __shfl_xor(ss, 16); ss += __shfl_xor(ss, 32);
                        const float rs = 1.0f / sqrtf(ss * (1.0f / 64.0f) + RMS_EPS);
#pragma unroll
                        for (int bj = 0; bj < 2; ++bj)
#pragma unroll
                            for (int n = 0; n < 2; ++n) v[bj][n] = v[bj][n] * rs * g4[bj][n];
                        if (!ctx) {
#pragma unroll
                            for (int bj = 0; bj < 2; ++bj) {
                                const int pos = bj == 0 ? (t >> 6) : (t & 63);
                                const PG8_LAS f32x2v* rp = rope + pos * 16 + 4 * fq;
#pragma unroll
                                for (int j = 0; j < 4; ++j) { const f32x2v cs = rp[j]; const float x1 = v[bj][0][j], x2 = v[bj][1][j];
                                    v[bj][0][j] = x1 * cs.x - x2 * cs.y; v[bj][1][j] = x2 * cs.x + x1 * cs.y; }
                            }
                        }
                    }
                    if (pn <= 1) {
                        bf16_t* dst = Q + row * 512 + (4 * pn + wc) * 64 + 8 * fq;
#pragma unroll
                        for (int bj = 0; bj < 2; ++bj) { const u32x2 p0 = pk4_(v[bj][0] * ATT_C2), p1 = pk4_(v[bj][1] * ATT_C2); const u32x4 w = {p0.x, p0.y, p1.x, p1.y}; *(u32x4*)(dst + 32 * bj) = w; }
                    } else {
                        const int hb = wc * 64 + 8 * fq; const int hf = wc * 64 + (pn == 2 ? 4 * fq : 8 * fq), nf = pn == 2 ? 16 : 4;
                        if (ctx) {
                            float* of = (pn == 2 ? onk : onv) + ((size_t)((b * 2 + layer) * 256 + t)) * 256 + hf;
                            bf16_t* dst = (pn == 2 ? KC : VC) + ((size_t)(b * 256 + t)) * 256 + hb;
#pragma unroll
                            for (int bj = 0; bj < 2; ++bj) {
#pragma unroll
                                for (int n = 0; n < 2; ++n) *(f32x4*)(of + 32 * bj + nf * n) = v[bj][n];
                                const u32x2 p0 = pk4_(v[bj][0]), p1 = pk4_(v[bj][1]); const u32x4 w = {p0.x, p0.y, p1.x, p1.y}; *(u32x4*)(dst + 32 * bj) = w; }
                        } else {
                            bf16_t* dst = (pn == 2 ? KL : VL) + ((size_t)(b * 1280 + 256 + t)) * 256 + hb;
#pragma unroll
                            for (int bj = 0; bj < 2; ++bj) { const u32x2 p0 = pk4_(v[bj][0]), p1 = pk4_(v[bj][1]); const u32x4 w = {p0.x, p0.y, p1.x, p1.y}; *(u32x4*)(dst + 32 * bj) = w; }
                        }
                    }
                }
        } else {
            const int c0 = 32 * wc + 8 * fq;
            const size_t tbase = ctx ? (size_t)b * 65536 : (size_t)16 * 65536 + (size_t)b * 262144;
            const size_t tsel = pn == 5 ? (size_t)(KMT - UT) : pn == 6 ? (size_t)(VT - UT) : 0;
#pragma unroll
            for (int ai = 0; ai < 2; ++ai)
#pragma unroll
                for (int m = 0; m < 4; ++m) {
                    asm volatile("" ::: "memory"); const int rl = rl0 + ai * 128 + m * 16; const int t = tb + rl; const size_t row = (size_t)pm * 256 + rl; u32x4 gw4 = {0u, 0u, 0u, 0u};
#pragma unroll
                    for (int bj = 0; bj < 2; ++bj)
#pragma unroll
                        for (int n = 0; n < 2; ++n) {
                            const f32x4 x = acc[ai][bj][m][n]; const int c = c0 + 128 * bj;
                            if (pn == 4) { const u32x2 p = pk4_(x); if (n == 0) { gw4[0] = p.x; gw4[1] = p.y; } else { gw4[2] = p.x; gw4[3] = p.y; *(u32x4*)(QM + row * 256 + c) = gw4; } }
                            else if (pn == 5 || pn == 6 || pn == 8) {
                                if (pn == 5) { const u32x2 p = pk4_(x); if (n == 0) { gw4[0] = p.x; gw4[1] = p.y; } else { gw4[2] = p.x; gw4[3] = p.y; *(u32x4*)(KM + row * 256 + c) = gw4; } }
                                PG8_LAS bf16_t* sw = stage + (wr * 4 + wc) * 512;
#pragma unroll
                                for (int j = 0; j < 4; ++j) sw[(8 * fq + 4 * n + j) * 16 + fr] = (bf16_t)f2bf_(x[j]);
                                if (n == 1) {
                                    const int L = fq * 16 + fr; const u32x4 tv = *(const PG8_LAS u32x4*)(sw + (L >> 1) * 16 + (L & 1) * 8);
                                    bf16_t* tp = UT + tsel + tbase + (size_t)(128 * bj + 32 * wc + (L >> 1)) * T + tb + ai * 128 + wr * 64 + m * 16 + (L & 1) * 8;
                                    *(u32x4*)tp = tv;
                                }
                            }
                            else if (pn == 7) { f32x4 s;
#pragma unroll
                                for (int j = 0; j < 4; ++j) s[j] = 1.0f / (1.0f + __expf(-x[j]));
                                const u32x2 p = pk4_(s); if (n == 0) { gw4[0] = p.x; gw4[1] = p.y; } else { gw4[2] = p.x; gw4[3] = p.y; *(u32x4*)(OM + row * 256 + c) = gw4; } }
                            else {
                                unsigned w = 0u;
#pragma unroll
                                for (int j = 0; j < 4; ++j) { const float gq = fmaxf(255.0f * __builtin_amdgcn_rcpf(1.0f + __expf(-x[j])), 1.0f); w = __builtin_amdgcn_cvt_pk_u8_f32(gq, j, w); }
                                gw4[bj * 2 + n] = w;
                                if (bj == 1 && n == 1) *(u32x4*)(BG + ((size_t)(((pn - 9) >> 2) * 48 + pm) * 4 + ((pn - 9) & 3)) * 65536 + (size_t)rl * 256 + (wc * 4 + fq) * 16) = gw4; }
                        }
                }
        }
    }
};

__device__ __forceinline__ f32x4 u8x4_to_f32(unsigned w) { f32x4 r; r[0] = (float)(w & 0xffu); r[1] = (float)((w >> 8) & 0xffu); r[2] = (float)((w >> 16) & 0xffu); r[3] = (float)(w >> 24); return r; }
struct EpiMerge {
    static constexpr bool PERM = false, AFTER_DRAIN = false, HAS_MID = true;
    const unsigned char* BG; bf16_t* O;
    __device__ __forceinline__ void mid(f32x4 (&acc)[2][2][4][2], const Unit& u, int t, int wr, int wc, int fr0, int fq0) const {
        if (t != 8 && t != 12) return;
        int fr = fr0, fq = fq0; asm volatile("" : "+v"(fr), "+v"(fq));
        const int gn = (t == 8) ? 0 : 1, gd = (t == 8) ? 1 : 2;
        const size_t lo = (size_t)(wr * 64 + fr) * 256 + (wc * 4 + fq) * 16;
        const unsigned char* bn0 = BG + ((size_t)(gn * 48 + u.pm) * 4 + u.pn) * 65536 + lo;
        const unsigned char* bd0 = BG + ((size_t)(gd * 48 + u.pm) * 4 + u.pn) * 65536 + lo;
#pragma unroll
        for (int ai = 0; ai < 2; ++ai) {
            u32x4 cn[4], cd[4];
#pragma unroll
            for (int m = 0; m < 4; ++m) { cn[m] = *(const u32x4*)(bn0 + (ai * 128 + m * 16) * 256); cd[m] = *(const u32x4*)(bd0 + (ai * 128 + m * 16) * 256); }
            asm volatile("" ::: "memory");
#pragma unroll
            for (int m = 0; m < 4; ++m)
#pragma unroll
                for (int bj = 0; bj < 2; ++bj)
#pragma unroll
                    for (int n = 0; n < 2; ++n) { const f32x4 en = u8x4_to_f32(cn[m][bj * 2 + n]), ed = u8x4_to_f32(cd[m][bj * 2 + n]); f32x4 f;
#pragma unroll
                        for (int j = 0; j < 4; ++j) f[j] = en[j] * __builtin_amdgcn_rcpf(ed[j]);
                        acc[ai][bj][m][n] = acc[ai][bj][m][n] * f; }
            asm volatile("" ::: "memory");
        }
    }
    __device__ __forceinline__ void operator()(const f32x4 (&acc)[2][2][4][2], const Unit& u, int wr, int wc, int fr0, int fq0) const {
        int fr = fr0, fq = fq0; asm volatile("" : "+v"(fr), "+v"(fq));
        const size_t row0 = (size_t)u.pm * 256 + wr * 64 + fr; const int c0 = u.pn * 256 + 32 * wc + 8 * fq;
        const unsigned char* bf0 = BG + ((size_t)(2 * 48 + u.pm) * 4 + u.pn) * 65536 + (size_t)(wr * 64 + fr) * 256 + (wc * 4 + fq) * 16; bf16_t* op0 = O + row0 * 1024 + c0;
#pragma unroll
        for (int ai = 0; ai < 2; ++ai) {
            u32x4 cf[4];
#pragma unroll
            for (int m = 0; m < 4; ++m) cf[m] = *(const u32x4*)(bf0 + (ai * 128 + m * 16) * 256);
            asm volatile("" ::: "memory");
#pragma unroll
            for (int m = 0; m < 4; ++m) { bf16_t* op = op0 + (size_t)(ai * 128 + m * 16) * 1024;
#pragma unroll
                for (int bj = 0; bj < 2; ++bj) { const f32x4 g0 = u8x4_to_f32(cf[m][bj * 2]) * (1.0f / 255.0f), g1 = u8x4_to_f32(cf[m][bj * 2 + 1]) * (1.0f / 255.0f);
                    const u32x2 p0 = pk4_(acc[ai][bj][m][0] * g0), p1 = pk4_(acc[ai][bj][m][1] * g1); const u32x4 w = {p0.x, p0.y, p1.x, p1.y}; *(u32x4*)(op + 128 * bj) = w; } }
            asm volatile("" ::: "memory");
        }
    }
};

struct EpiRes {
    static constexpr bool PERM = false, AFTER_DRAIN = false, HAS_MID = true;
    int mode;
    unsigned* wflag; unsigned wneed;
    __device__ __forceinline__ void mid(f32x4 (&)[2][2][4][2], const Unit& u, int t, int, int, int, int) const {
        if (t != 38 || wflag == nullptr || u.pm >= 16) return;
        unsigned sp = 0; while (__hip_atomic_load(wflag, __ATOMIC_RELAXED, __HIP_MEMORY_SCOPE_AGENT) < wneed) { __builtin_amdgcn_s_sleep(4); if (++sp > (1u << 22)) break; }
        asm volatile("" ::: "memory");
    }
    const float *xin_p, *xin_s;
    bf16_t* xb;
    float* xout;
    const float* gate;
    __device__ __forceinline__ void operator()(const f32x4 (&acc)[2][2][4][2], const Unit& u, int wr, int wc, int fr0, int fq0) const {
        int fr = fr0, fq = fq0; asm volatile("" : "+v"(fr), "+v"(fq));
        const int pm = u.pm; const int v = pm < 16 ? 0 : 1 + ((pm - 16) >> 2);
        const float* xin = pm < 16 ? xin_p + (size_t)pm * 256 * 1024 : xin_s + (size_t)(pm - 16) * 256 * 1024;
        const int c0 = u.pn * 256 + 32 * wc + 8 * fq;
        f32x4 g4[2][2];
#pragma unroll
        for (int bj = 0; bj < 2; ++bj)
#pragma unroll
            for (int n = 0; n < 2; ++n) g4[bj][n] = *(const f32x4*)(gate + (size_t)v * 6144 + c0 + 128 * bj + 4 * n);
        const size_t r0 = (size_t)pm * 256 + wr * 64 + fr;
        if (mode == 0) {
            const float* xp0 = xin + (size_t)(wr * 64 + fr) * 1024 + c0; bf16_t* op0 = xb + r0 * 1024 + c0;
#pragma unroll
            for (int ai = 0; ai < 2; ++ai) {
                f32x4 cx[4][2][2];
#pragma unroll
                for (int m = 0; m < 4; ++m) { const float* xp = xp0 + (size_t)(ai * 128 + m * 16) * 1024;
#pragma unroll
                    for (int bj = 0; bj < 2; ++bj)
#pragma unroll
                        for (int n = 0; n < 2; ++n) cx[m][bj][n] = *(const f32x4*)(xp + 128 * bj + 4 * n); }
                asm volatile("" ::: "memory");
#pragma unroll
                for (int m = 0; m < 4; ++m) { bf16_t* op = op0 + (size_t)(ai * 128 + m * 16) * 1024;
#pragma unroll
                    for (int bj = 0; bj < 2; ++bj) { const u32x2 p0 = pk4_(cx[m][bj][0] + g4[bj][0] * acc[ai][bj][m][0]), p1 = pk4_(cx[m][bj][1] + g4[bj][1] * acc[ai][bj][m][1]);
                        const u32x4 w = {p0.x, p0.y, p1.x, p1.y}; st16_wt(op + 128 * bj, w); } }
                asm volatile("" ::: "memory");
            }
        } else {
            const bf16_t* xp0 = xb + r0 * 1024 + c0; float* op0 = xout + r0 * 1024 + c0;
#pragma unroll
            for (int ai = 0; ai < 2; ++ai) {
                u32x4 cx[4][2];
#pragma unroll
                for (int m = 0; m < 4; ++m) { const bf16_t* xp = xp0 + (size_t)(ai * 128 + m * 16) * 1024;
#pragma unroll
                    for (int bj = 0; bj < 2; ++bj) cx[m][bj] = *(const u32x4*)(xp + 128 * bj); }
                asm volatile("" ::: "memory");
#pragma unroll
                for (int m = 0; m < 4; ++m) { float* op = op0 + (size_t)(ai * 128 + m * 16) * 1024;
#pragma unroll
                    for (int bj = 0; bj < 2; ++bj)
#pragma unroll
                        for (int n = 0; n < 2; ++n) { const u32x2 h = {cx[m][bj][2 * n], cx[m][bj][2 * n + 1]}; *(f32x4*)(op + 128 * bj + 4 * n) = bf4_to_f32(h) + g4[bj][n] * acc[ai][bj][m][n]; } }
                asm volatile("" ::: "memory");
            }
        }
    }
};

struct EpiSwiGLU {
    static constexpr bool PERM = false, AFTER_DRAIN = false, HAS_MID = false;
    bf16_t* H;
    __device__ __forceinline__ void operator()(const f32x4 (&acc)[2][2][4][2], const Unit& u, int wr, int wc, int fr0, int fq0) const {
        int fr = fr0, fq = fq0; asm volatile("" : "+v"(fr), "+v"(fq));
        const int c0 = u.pn * 128 + 32 * wc + 8 * fq;
#pragma unroll
        for (int ai = 0; ai < 2; ++ai)
#pragma unroll
            for (int m = 0; m < 4; ++m) {
                asm volatile("" ::: "memory"); const size_t row = (size_t)u.pm * 256 + ai * 128 + wr * 64 + m * 16 + fr; bf16_t* op = H + row * FF + c0; u32x4 w;
#pragma unroll
                for (int n = 0; n < 2; ++n) { const f32x4 g = acc[ai][0][m][n], v = acc[ai][1][m][n]; f32x4 o;
#pragma unroll
                    for (int j = 0; j < 4; ++j) o[j] = g[j] * __builtin_amdgcn_rcpf(1.0f + __expf(-g[j])) * v[j];
                    const u32x2 p = pk4_(o); w[2 * n] = p.x; w[2 * n + 1] = p.y; }
                *(u32x4*)op = w;
            }
    }
};

struct EpiFourier {
    static constexpr bool PERM = false, AFTER_DRAIN = false, HAS_MID = false;
    bf16_t* AC; int lat;
    __device__ __forceinline__ void operator()(const f32x4 (&acc)[2][2][4][2], const Unit& u, int wr, int wc, int fr0, int fq0) const {
        int fr = fr0, fq = fq0; asm volatile("" : "+v"(fr), "+v"(fq));
        const size_t tok0 = lat ? (size_t)4096 + (size_t)u.pn * 1024 : (size_t)u.pn * 256;
        const int T = lat ? 1024 : 256, half = T >> 1;
        const int c0 = 32 * wc + 4 * fq;
#pragma unroll
        for (int ai = 0; ai < 2; ++ai)
#pragma unroll
            for (int m = 0; m < 4; ++m) {
                asm volatile("" ::: "memory");
                const int s = lat ? (u.pm >> 1) : ai; const int tp = lat ? 256 * (u.pm & 1) + ai * 128 + wr * 64 + m * 16 + fr : wr * 64 + m * 16 + fr;
                const bool special = (s == 1 && tp == 0);
                bf16_t* p1 = AC + (tok0 + (special ? half : tp)) * KMRG + 768 + (special ? 0 : 256 * s) + c0;
                bf16_t* p2 = AC + (tok0 + (T - tp)) * KMRG + 768 + 256 * s + c0;
#pragma unroll
                for (int bj = 0; bj < 2; ++bj)
#pragma unroll
                    for (int n = 0; n < 2; ++n) { const f32x4 v = acc[ai][bj][m][n]; const int co = 128 * bj + 16 * n;
                        *(u32x2*)(p1 + co) = pk4_(v);
                        if (tp >= 1) *(u32x2*)(p2 + co) = pk4_(s ? -v : v);
                        if (special) { const u32x2 z = {0u, 0u}; *(u32x2*)(AC + tok0 * KMRG + 1024 + c0 + co) = z; *(u32x2*)(AC + (tok0 + half) * KMRG + 1024 + c0 + co) = z; } }
            }
    }
};

template <class Epi, class Sched, bool ALIGN_EPI = false, bool SP2 = false>
__device__ __forceinline__ void gemm_phase(PG8_LAS unsigned char* lds, const Gemm g, const Sched& S, const Epi& E, const int tid_in, unsigned* prof = nullptr) {
#ifdef PROF_GEMM
    unsigned long long pg_start = 0; if (prof && tid_in == 0) pg_start = __builtin_amdgcn_s_memrealtime();
#endif
    const int tid = tid_in, wid = __builtin_amdgcn_readfirstlane(tid >> 6), lane = tid & 63, wr = wid >> 2, wc = wid & 3, fr = lane & 15, fq = lane >> 4;
    const int K = g.K, nt = K / BK;
    unsigned voffA[2], voffB[2];
#pragma unroll
    for (int i = 0; i < 2; ++i) { int R, C; stage_rc(tid * 16 + i * 8192, R, C); const int Rb = Epi::PERM ? ((R & ~31) + perm32(R & 31)) : R;
        voffA[i] = (unsigned)(R * K + C) * 2u; voffB[i] = (unsigned)(Rb * K + C) * 2u; }
    const size_t kstep = (size_t)(BK * 2);
    const size_t hstep = (size_t)HALF * K * 2;
    const size_t tstep = 2 * hstep;
    const unsigned ldsw = (unsigned)wid * 1024u;
    const int aoff = lds_byte(wr * 64 + fr, fq * 8), boff = lds_byte(wc * 32 + fr, fq * 8);
#define PG8_SA(b, h) (((b) * 2 + (h)) * HTB)
#define PG8_SB(b, h) ((4 + (b) * 2 + (h)) * HTB)
#define PG8_STAGE(bufoff, gbase, voff) do { _Pragma("unroll") for (int _i = 0; _i < 2; ++_i) \
        __builtin_amdgcn_global_load_lds((const unsigned*)((const char*)(gbase) + (voff)[_i]), (PG8_LAS unsigned*)(lds + (bufoff) + ldsw + _i * 8192), 16, 0, 0); } while (0)
#define PG8_LDA(dst, b, h) do { _Pragma("unroll") for (int m = 0; m < 4; ++m) _Pragma("unroll") for (int k = 0; k < 2; ++k) dst[m][k] = *(const PG8_LAS bf16x8*)(lds + PG8_SA(b, h) + aoff + m * 2048 + k * 1024); } while (0)
#define PG8_LDB(dst, b, h) do { _Pragma("unroll") for (int n = 0; n < 2; ++n) _Pragma("unroll") for (int k = 0; k < 2; ++k) dst[n][k] = *(const PG8_LAS bf16x8*)(lds + PG8_SB(b, h) + boff + n * 2048 + k * 1024); } while (0)
#define PG8_MMA(ai, bj, At, Bt) do { __builtin_amdgcn_s_setprio(1); _Pragma("unroll") for (int m = 0; m < 4; ++m) _Pragma("unroll") for (int n = 0; n < 2; ++n) _Pragma("unroll") for (int k = 0; k < 2; ++k) \
        acc[ai][bj][m][n] = __builtin_amdgcn_mfma_f32_16x16x32_bf16(Bt[n][k], At[m][k], acc[ai][bj][m][n], 0, 0, 0); __builtin_amdgcn_s_setprio(0); } while (0)
#define PG8_WAIT_V(n) asm volatile("s_waitcnt vmcnt(" #n ")" ::: "memory")
#define PG8_WAIT_L(n) asm volatile("s_waitcnt lgkmcnt(" #n ")" ::: "memory")
#define PG8_BAR __builtin_amdgcn_s_barrier()
#define PG8_SCHED __builtin_amdgcn_sched_barrier(0)
    Unit cur, nxt; int ui = 0;
    if (!S.next(0, cur)) return;
    f32x4 acc[2][2][4][2];
#pragma unroll
    for (int a = 0; a < 2; ++a)
#pragma unroll
        for (int b = 0; b < 2; ++b)
#pragma unroll
            for (int m = 0; m < 4; ++m)
#pragma unroll
                for (int n = 0; n < 2; ++n) acc[a][b][m][n] = (f32x4){0.f, 0.f, 0.f, 0.f};
    bf16x8 At[4][2], B0[2][2], B1[2][2];
    const char* cA = (const char*)g.A + (size_t)cur.pm * tstep; const char* cB = (const char*)g.Bt + (size_t)cur.pn * tstep;
    S.a_ready(cur);
    if constexpr (SP2) {
        PG8_STAGE(PG8_SB(0, 0), cB, voffB); PG8_STAGE(PG8_SB(0, 1), cB + hstep, voffB); PG8_STAGE(PG8_SA(0, 0), cA, voffA); PG8_STAGE(PG8_SA(0, 1), cA + hstep, voffA);
        if (wr == 1) PG8_BAR;
        PG8_WAIT_V(2); PG8_BAR;
        PG8_STAGE(PG8_SB(1, 0), cB + kstep, voffB); PG8_STAGE(PG8_SA(1, 0), cA + kstep, voffA); PG8_STAGE(PG8_SB(1, 1), cB + hstep + kstep, voffB);
        PG8_WAIT_V(6); PG8_BAR;
    } else {
        PG8_STAGE(PG8_SB(0, 0), cB, voffB); PG8_STAGE(PG8_SA(0, 0), cA, voffA); PG8_STAGE(PG8_SB(0, 1), cB + hstep, voffB); PG8_STAGE(PG8_SA(0, 1), cA + hstep, voffA);
        if (wr == 1) PG8_BAR;
        PG8_WAIT_V(4); PG8_BAR;
        PG8_STAGE(PG8_SB(1, 0), cB + kstep, voffB); PG8_STAGE(PG8_SA(1, 0), cA + kstep, voffA); PG8_STAGE(PG8_SB(1, 1), cB + hstep + kstep, voffB);
        PG8_WAIT_V(6); PG8_BAR;
    }
    for (;;) {
        const bool has_next = S.next(ui + 1, nxt);
        const char* nA = has_next ? (const char*)g.A + (size_t)nxt.pm * tstep : cA; const char* nB = has_next ? (const char*)g.Bt + (size_t)nxt.pn * tstep : cB;
        for (int t = 0; t < nt; t += 2) {
            if constexpr (Epi::HAS_MID) { E.mid(acc, cur, t, wr, wc, fr, fq); }
            const bool last = (t == nt - 2);
            const char* a1 = cA + (size_t)(t + 1) * kstep;
            const char* a2 = last ? nA : cA + (size_t)(t + 2) * kstep; const char* b2 = last ? nB : cB + (size_t)(t + 2) * kstep;
            const char* a3 = a2 + kstep; const char* b3 = b2 + kstep;
            if (last && has_next) S.a_ready(nxt);
            if constexpr (SP2) {
            PG8_LDB(B0, 0, 0); PG8_LDB(B1, 0, 1); PG8_SCHED; PG8_LDA(At, 0, 0); PG8_STAGE(PG8_SA(1, 1), a1 + hstep, voffA);
            PG8_WAIT_V(8); PG8_WAIT_L(0); PG8_BAR; PG8_MMA(0, 0, At, B0); PG8_MMA(0, 1, At, B1); PG8_BAR; PG8_SCHED;
            PG8_LDA(At, 0, 1); PG8_STAGE(PG8_SB(0, 0), b2, voffB); PG8_STAGE(PG8_SB(0, 1), b2 + hstep, voffB); PG8_STAGE(PG8_SA(0, 0), a2, voffA);
            PG8_WAIT_V(8); PG8_WAIT_L(0); PG8_BAR; PG8_MMA(1, 0, At, B0); PG8_MMA(1, 1, At, B1); PG8_BAR; PG8_SCHED;
            PG8_LDB(B0, 1, 0); PG8_LDB(B1, 1, 1); PG8_SCHED; PG8_LDA(At, 1, 0); PG8_STAGE(PG8_SA(0, 1), a2 + hstep, voffA);
            PG8_WAIT_V(8); PG8_WAIT_L(0); PG8_BAR; PG8_MMA(0, 0, At, B0); PG8_MMA(0, 1, At, B1); PG8_BAR; PG8_SCHED;
            PG8_LDA(At, 1, 1); PG8_STAGE(PG8_SB(1, 0), b3, voffB); PG8_STAGE(PG8_SB(1, 1), b3 + hstep, voffB); PG8_STAGE(PG8_SA(1, 0), a3, voffA);
            PG8_WAIT_V(8); PG8_WAIT_L(0); PG8_BAR; PG8_MMA(1, 0, At, B0); PG8_MMA(1, 1, At, B1); PG8_BAR; PG8_SCHED;
            } else {
            PG8_LDB(B0, 0, 0); PG8_SCHED; PG8_LDA(At, 0, 0); PG8_STAGE(PG8_SA(1, 1), a1 + hstep, voffA);
            PG8_WAIT_L(8); PG8_BAR; PG8_WAIT_L(0); PG8_MMA(0, 0, At, B0); PG8_BAR; PG8_SCHED;
            PG8_LDB(B1, 0, 1); PG8_STAGE(PG8_SB(0, 0), b2, voffB);
            PG8_BAR; PG8_WAIT_L(0); PG8_MMA(0, 1, At, B1); PG8_BAR;
            PG8_LDA(At, 0, 1); PG8_STAGE(PG8_SA(0, 0), a2, voffA);
            PG8_BAR; PG8_WAIT_L(0); PG8_MMA(1, 0, At, B0); PG8_BAR; PG8_SCHED;
            PG8_STAGE(PG8_SB(0, 1), b2 + hstep, voffB);
            PG8_WAIT_V(6); PG8_BAR; PG8_MMA(1, 1, At, B1); PG8_BAR;
            PG8_LDB(B0, 1, 0); PG8_SCHED; PG8_LDA(At, 1, 0); PG8_STAGE(PG8_SA(0, 1), a2 + hstep, voffA);
            PG8_WAIT_L(8); PG8_BAR; PG8_WAIT_L(0); PG8_MMA(0, 0, At, B0); PG8_BAR; PG8_SCHED;
            PG8_LDB(B1, 1, 1); PG8_STAGE(PG8_SB(1, 0), b3, voffB);
            PG8_BAR; PG8_WAIT_L(0); PG8_MMA(0, 1, At, B1); PG8_BAR;
            PG8_LDA(At, 1, 1); PG8_STAGE(PG8_SA(1, 0), a3, voffA);
            PG8_BAR; PG8_WAIT_L(0); PG8_MMA(1, 0, At, B0); PG8_BAR; PG8_SCHED;
            PG8_STAGE(PG8_SB(1, 1), b3 + hstep, voffB);
            PG8_WAIT_V(6); PG8_BAR; PG8_MMA(1, 1, At, B1); PG8_BAR;
            }
        }
        if constexpr (ALIGN_EPI) { if (wr == 0) PG8_BAR; }
#ifdef PROF_GEMM
        unsigned long long pg_t0 = 0; if (prof && tid == 0) pg_t0 = __builtin_amdgcn_s_memrealtime();
#endif
        if constexpr (!Epi::AFTER_DRAIN) { E(acc, cur, wr, wc, fr, fq); S.done(cur); }
#ifdef PROF_GEMM
#ifndef PROF_PN_LO
#define PROF_PN_LO 0
#define PROF_PN_HI 1000
#endif
        if (prof && tid == 0 && cur.pn >= PROF_PN_LO && cur.pn <= PROF_PN_HI) { atomicAdd(prof, (unsigned)(__builtin_amdgcn_s_memrealtime() - pg_t0)); atomicAdd(prof + 1, 1u); }
#endif
        if (!has_next) break;
#pragma unroll
        for (int a = 0; a < 2; ++a)
#pragma unroll
            for (int b = 0; b < 2; ++b)
#pragma unroll
                for (int m = 0; m < 4; ++m)
#pragma unroll
                    for (int n = 0; n < 2; ++n) acc[a][b][m][n] = (f32x4){0.f, 0.f, 0.f, 0.f};
        cur = nxt; cA = nA; cB = nB; ++ui;
        if constexpr (ALIGN_EPI) { if (wr == 1) PG8_BAR; }
    }
    PG8_WAIT_V(0);
    if constexpr (!ALIGN_EPI) { if (wr == 0) PG8_BAR; }
    PG8_BAR;
    if constexpr (Epi::AFTER_DRAIN) { E.fused(acc, cur, wr, wc, fr, fq, lds, wid, lane); S.done(cur); }
#ifdef PROF_GEMM
    if (prof && tid == 0) { atomicAdd(prof + 2, (unsigned)(__builtin_amdgcn_s_memrealtime() - pg_start)); atomicAdd(prof + 3, 1u); }
#endif
#undef PG8_SA
#undef PG8_SB
#undef PG8_STAGE
#undef PG8_LDA
#undef PG8_LDB
#undef PG8_MMA
#undef PG8_WAIT_V
#undef PG8_WAIT_L
#undef PG8_BAR
#undef PG8_SCHED
}
}

#define ATTN_STORE16(p,v) (*(u32x4*)(p)=(v))

#include <hip/hip_bf16.h>
#include <cmath>
namespace attn_body {
using bf16=__hip_bfloat16;
using bf16x8=__attribute__((ext_vector_type(8)))short;
using s16x4=__attribute__((ext_vector_type(4)))short;
using f32x16=__attribute__((ext_vector_type(16)))float;
using u32x4=__attribute__((ext_vector_type(4)))unsigned;
constexpr int D=64;
constexpr int NW=8,QBLK=32,QB=QBLK*NW,KVBLK=64;
constexpr int ATTN_UNIT_ROWS=QB;
__device__ __forceinline__ int crow(int r,int hi){return (r&3)+8*(r>>2)+4*hi;}
#define SBAR() __builtin_amdgcn_sched_barrier(0)
__device__ __forceinline__ void cmask(f32x16&p0,f32x16&p1,int jb,int qrel,int hi){
  const float NEG=-INFINITY; int kb=64*jb+4*hi;
  #pragma unroll
  for(int r=0;r<16;++r){int kv=kb+(r&3)+8*(r>>2); if(kv>qrel)p0[r]=NEG; if(kv+32>qrel)p1[r]=NEG;}
}

constexpr int NSLOT=3, SLOTB=8192;
constexpr int LDS_K=0, LDS_V=NSLOT*SLOTB, LDS_WS=2*NSLOT*SLOTB, LDS_OST=LDS_WS+NW*64*4, LDS_BYTES=LDS_OST+NW*4096;
constexpr float C2=0.125f*1.4426950408889634f;
__device__ __forceinline__ void glds16(const void*gsrc,unsigned lds_dst){unsigned keep;
  asm volatile("s_mov_b32 %0, m0\n\ts_mov_b32 m0, %2\n\ts_nop 0\n\tglobal_load_lds_dwordx4 %1, off\n\ts_mov_b32 m0, %0":"=&s"(keep):"v"(gsrc),"s"(lds_dst):"memory");}
__device__ __forceinline__ float max3f(float a,float b,float c){float r;asm("v_max3_f32 %0, %1, %2, %3":"=v"(r):"v"(a),"v"(b),"v"(c));return r;}
__device__ __forceinline__ float max2f(float a,float b){float r;asm("v_max_f32_e32 %0, %1, %2":"=v"(r):"v"(a),"v"(b));return r;}
__device__ __forceinline__ float fadd_s(float a,float b){float r;asm("v_add_f32_e32 %0, %1, %2":"=v"(r):"v"(a),"v"(b));return r;}
__device__ __forceinline__ float fsub_s(float a,float b){float r;asm("v_sub_f32_e32 %0, %1, %2":"=v"(r):"v"(a),"v"(b));return r;}
typedef float f32x2_t __attribute__((ext_vector_type(2))); typedef __bf16 bf16x2_t __attribute__((ext_vector_type(2)));
__device__ __forceinline__ unsigned cvtpk_s(float lo,float hi){f32x2_t v={lo,hi};bf16x2_t b=__builtin_convertvector(v,bf16x2_t);return __builtin_bit_cast(unsigned,b);}
#define WAIT_BAR(N) asm volatile("s_waitcnt vmcnt(" #N ") lgkmcnt(0)\n\ts_barrier":::"memory")

__device__ __forceinline__ void qkt(f32x16&p0,f32x16&p1,const char*Kslot,const bf16x8*qr,const f32x16&negm,int r32,int hi){
  const char*kb=Kslot+hi*1024+r32*16;
  #pragma unroll
  for(int d0=0;d0<4;++d0){
    const bf16x8 b0=*reinterpret_cast<const bf16x8*>(kb+d0*2048);
    const bf16x8 b1=*reinterpret_cast<const bf16x8*>(kb+d0*2048+512);
    if(d0==0){p0=__builtin_amdgcn_mfma_f32_32x32x16_bf16(b0,qr[0],negm,0,0,0);p1=__builtin_amdgcn_mfma_f32_32x32x16_bf16(b1,qr[0],negm,0,0,0);}
    else{p0=__builtin_amdgcn_mfma_f32_32x32x16_bf16(b0,qr[d0],p0,0,0,0);p1=__builtin_amdgcn_mfma_f32_32x32x16_bf16(b1,qr[d0],p1,0,0,0);}}
}
typedef __attribute__((address_space(3))) const char* lds_cptr;
typedef short v4i16_t __attribute__((ext_vector_type(4)));
__device__ __forceinline__ void kload8(bf16x8*kf,lds_cptr kp){
  kf[0]=*(const __attribute__((address_space(3))) bf16x8*)(kp);      kf[1]=*(const __attribute__((address_space(3))) bf16x8*)(kp+512);
  kf[2]=*(const __attribute__((address_space(3))) bf16x8*)(kp+2048); kf[3]=*(const __attribute__((address_space(3))) bf16x8*)(kp+2560);
  kf[4]=*(const __attribute__((address_space(3))) bf16x8*)(kp+4096); kf[5]=*(const __attribute__((address_space(3))) bf16x8*)(kp+4608);
  kf[6]=*(const __attribute__((address_space(3))) bf16x8*)(kp+6144); kf[7]=*(const __attribute__((address_space(3))) bf16x8*)(kp+6656);
}
__device__ __forceinline__ void kload2(bf16x8*kf,lds_cptr kp,int j){ kf[2*j]=*(const __attribute__((address_space(3))) bf16x8*)(kp+j*2048); kf[2*j+1]=*(const __attribute__((address_space(3))) bf16x8*)(kp+j*2048+512); }
__device__ __forceinline__ s16x4 vtr(lds_cptr p){ return __builtin_bit_cast(s16x4,__builtin_amdgcn_ds_read_tr16_b64_v4i16((__attribute__((address_space(3))) v4i16_t*)p)); }
__device__ __forceinline__ float rowmax(const f32x16&p0,const f32x16&p1){
  float a=max3f(p0[0],p0[1],p1[0]),b=max3f(p0[2],p0[3],p1[1]);a=max3f(a,p1[2],p1[3]);
  #pragma unroll
  for(int r=4;r<16;r+=4){a=max3f(a,p0[r],p0[r+1]);b=max3f(b,p0[r+2],p0[r+3]);a=max3f(a,p1[r],p1[r+1]);b=max3f(b,p1[r+2],p1[r+3]);}
  const float m=max2f(a,b);
  auto rr=__builtin_amdgcn_permlane32_swap(__float_as_uint(m),__float_as_uint(m),false,false);
  return max2f(__uint_as_float(rr[0]),__uint_as_float(rr[1]));
}
__device__ __forceinline__ void pv(f32x16*o,int vb,bf16x8 pa0,bf16x8 pa1,bf16x8 pa2,bf16x8 pa3){
  #pragma unroll
  for(int d0=0;d0<2;++d0){s16x4 lo[4],hi[4];
    #pragma unroll
    for(int ks=0;ks<4;++ks){
      asm volatile("ds_read_b64_tr_b16 %0,%1 offset:%c2":"=&v"(lo[ks]):"v"(vb),"i"(d0*4096+ks*1024):"memory");
      asm volatile("ds_read_b64_tr_b16 %0,%1 offset:%c2":"=&v"(hi[ks]):"v"(vb),"i"(d0*4096+ks*1024+512):"memory");}
    asm volatile("s_waitcnt lgkmcnt(0)":::"memory");SBAR();
    #define PK(k) (bf16x8){lo[k][0],lo[k][1],lo[k][2],lo[k][3],hi[k][0],hi[k][1],hi[k][2],hi[k][3]}
    o[d0]=__builtin_amdgcn_mfma_f32_32x32x16_bf16(pa0,PK(0),o[d0],0,0,0);
    o[d0]=__builtin_amdgcn_mfma_f32_32x32x16_bf16(pa1,PK(1),o[d0],0,0,0);
    o[d0]=__builtin_amdgcn_mfma_f32_32x32x16_bf16(pa2,PK(2),o[d0],0,0,0);
    o[d0]=__builtin_amdgcn_mfma_f32_32x32x16_bf16(pa3,PK(3),o[d0],0,0,0);
    #undef PK
  }
}

#ifndef ATTN_STORE16
#define ATTN_STORE16(p,v) (*(u32x4*)(p)=(v))
#endif
template<int THRL> __device__ __forceinline__ void attn_unit(const bf16*Qb,int QP,const bf16*__restrict__ Kh,const bf16*__restrict__ Vh,int KP,int NT,bf16*Ob,int OP,char*shm,const int tid_in){
  const int tid=tid_in,lane=tid&63,r32=lane&31,hi=lane>>5; const int wid=__builtin_amdgcn_readfirstlane(tid>>6);
  const bf16*Qw=Qb+(long)(wid*QBLK)*QP;
  const unsigned lds0=(unsigned)(uintptr_t)shm;
  float*wsf=(float*)(shm+LDS_WS)+wid*64;
  const bf16*ksrc=Kh+(long)lane*KP+wid*8;
  const bf16*vsrc=Vh+(long)(16*(wid&3)+(lane>>2))*KP+(wid>>2)*32+(lane&3)*8;
  const unsigned kdst=lds0+LDS_K+wid*1024, vdst=lds0+LDS_V+wid*1024;
  #define DMA_K(t,slot) glds16(ksrc+(long)(t)*KVBLK*KP,(unsigned)__builtin_amdgcn_readfirstlane(kdst+(slot)))
  #define DMA_V(t,slot) glds16(vsrc+(long)(t)*KVBLK*KP,(unsigned)__builtin_amdgcn_readfirstlane(vdst+(slot)))
  const int vb0=(int)(lds0+LDS_V)+((lane>>4)&1)*32+(lane&3)*8+(4*hi+((lane&15)>>2))*64;
  const char*Kbase=shm+LDS_K; bf16x8 kf[8];
  const lds_cptr shm3=(lds_cptr)shm; const lds_cptr kp0=shm3+LDS_K+hi*1024+r32*16; const lds_cptr vp0=shm3+LDS_V+((lane>>4)&1)*32+(lane&3)*8+(4*hi+((lane&15)>>2))*64;
  DMA_K(0,0);DMA_V(0,0);DMA_K(1,SLOTB);
  bf16x8 qr[4];
  #pragma unroll
  for(int d0=0;d0<4;++d0)qr[d0]=*reinterpret_cast<const bf16x8*>(&Qw[(long)r32*QP+d0*16+hi*8]);
  float mhat=0.f,l_reg=0.f;f32x16 o[2];o[0]=f32x16{};o[1]=f32x16{};f32x16 negm=f32x16{};asm volatile("":"+v"(negm));
  #define CMASK(P0,P1,t) do{}while(0)
  bool resc=false;
  #define START(P0,P1) do{ const float rm=rowmax(P0,P1); resc=false; \
    { const float dl=rm; mhat=fadd_s(mhat,dl); \
      _Pragma("unroll") for(int r=0;r<16;++r){P0[r]=fsub_s(P0[r],dl);P1[r]=fsub_s(P1[r],dl);} \
      _Pragma("unroll") for(int r=0;r<16;++r)negm[r]=-mhat; asm volatile("":"+v"(negm)); } \
    _Pragma("unroll") for(int r=0;r<16;++r)P0[r]=__builtin_amdgcn_exp2f(P0[r]); }while(0)
  #define RESC() do{ if(resc){ asm volatile("s_waitcnt lgkmcnt(0)":::"memory"); \
      _Pragma("unroll") for(int d_=0;d_<2;++d_) _Pragma("unroll") for(int r=0;r<16;++r)o[d_][r]*=wsf[crow(r,hi)]; } }while(0)
  f32x16 pA0,pA1,pB0,pB1;
  int sl_prev=0,sl_cur=0,sl_next=SLOTB;
  #define ROT() do{sl_prev=sl_cur;sl_cur=sl_next;sl_next=(sl_next==(NSLOT-1)*SLOTB)?0:sl_next+SLOTB;}while(0)
  DMA_K(2,2*SLOTB);
  WAIT_BAR(3);
  qkt(pA0,pA1,Kbase,qr,negm,r32,hi);asm volatile("s_nop 15\n\ts_nop 7":"+v"(pA0),"+v"(pA1));CMASK(pA0,pA1,0);
  START(pA0,pA1);
  _Pragma("unroll") for(int r=0;r<16;++r)pA1[r]=__builtin_amdgcn_exp2f(pA1[r]);
  WAIT_BAR(0);
  DMA_K(3,0);DMA_V(1,SLOTB);
  ROT();
  kload8(kf,kp0+sl_cur);
  WAIT_BAR(2);
  s16x4 vlo[8],vhi[8]; u32x4 pw0,pw1,pw2,pw3;
  #define PKW(P,B) cvtpk_s(P[B],P[B+1])
  #define PAF(k) __builtin_bit_cast(bf16x8,pw##k)
  #define VFR(i) (bf16x8){vlo[i][0],vlo[i][1],vlo[i][2],vlo[i][3],vhi[i][0],vhi[i][1],vhi[i][2],vhi[i][3]}
  #define PIN(x) asm volatile("":"+v"(x))
  #define MX3(a,b,c) __builtin_fmaxf(__builtin_fmaxf((a),(b)),(c))
  #define GAPA(MF,A0,A1,A2,A3,W0,W1,PW) do{ MF; sacc+=A0; sacc+=A1; sacc+=A2; sacc+=A3; PIN(sacc); W0; W1; PIN(PW); SBAR(); }while(0)
  #define EX(v) __builtin_amdgcn_exp2f(v)
  #define GAPB(MF,X,B) do{ MF; X[B]=EX(X[B]); X[B+1]=EX(X[B+1]); X[B+2]=EX(X[B+2]); X[B+3]=EX(X[B+3]); PIN(X); SBAR(); }while(0)
  #define VRD(i) do{ vlo[i]=vtr(vp_+(((i)>>2)*4096+((i)&3)*1024)); vhi[i]=vtr(vp_+(((i)>>2)*4096+((i)&3)*1024+512)); }while(0)
  #define KRD(G,j) do{ if(G){ kload2(kf,kp0+sl_next,j); SBAR(); } }while(0)
  #define STEP(C0,C1,P0,P1,t,GK,GV,GL) do{ SBAR(); \
    const lds_cptr vp_=vp0+sl_prev; \
    VRD(0); SBAR(); float sacc=(P0[0]+P0[1]); \
    GAPA(C0=__builtin_amdgcn_mfma_f32_32x32x16_bf16(kf[0],qr[0],negm,0,0,0), P0[2],P0[3],P0[4],P0[5],     pw0[0]=PKW(P0,0), pw0[1]=PKW(P0,2), pw0); \
    VRD(4); SBAR(); GAPA(C1=__builtin_amdgcn_mfma_f32_32x32x16_bf16(kf[1],qr[0],negm,0,0,0), P0[6],P0[7],P0[8],P0[9],     pw0[2]=PKW(P0,4), pw0[3]=PKW(P0,6), pw0); \
    VRD(1); SBAR(); GAPA(C0=__builtin_amdgcn_mfma_f32_32x32x16_bf16(kf[2],qr[1],C0,0,0,0),   P0[10],P0[11],P0[12],P0[13], pw1[0]=PKW(P0,8), pw1[1]=PKW(P0,10), pw1); \
    VRD(5); SBAR(); GAPA(C1=__builtin_amdgcn_mfma_f32_32x32x16_bf16(kf[3],qr[1],C1,0,0,0),   P0[14],P0[15],P1[0],P1[1],   pw1[2]=PKW(P0,12),pw1[3]=PKW(P0,14), pw1); \
    VRD(2); SBAR(); GAPA(C0=__builtin_amdgcn_mfma_f32_32x32x16_bf16(kf[4],qr[2],C0,0,0,0),   P1[2],P1[3],P1[4],P1[5],     pw2[0]=PKW(P1,0), pw2[1]=PKW(P1,2), pw2); \
    VRD(6); SBAR(); GAPA(C1=__builtin_amdgcn_mfma_f32_32x32x16_bf16(kf[5],qr[2],C1,0,0,0),   P1[6],P1[7],P1[8],P1[9],     pw2[2]=PKW(P1,4), pw2[3]=PKW(P1,6), pw2); \
    VRD(3); SBAR(); GAPA(C0=__builtin_amdgcn_mfma_f32_32x32x16_bf16(kf[6],qr[3],C0,0,0,0),   P1[10],P1[11],P1[12],P1[13], pw3[0]=PKW(P1,8), pw3[1]=PKW(P1,10), pw3); \
    VRD(7); SBAR(); GAPA(C1=__builtin_amdgcn_mfma_f32_32x32x16_bf16(kf[7],qr[3],C1,0,0,0),   P1[14],P1[15],0.f,0.f,       pw3[2]=PKW(P1,12),pw3[3]=PKW(P1,14), pw3); \
    l_reg+=sacc; \
    if(GK){DMA_K((t)+3,sl_cur);} if(GV){DMA_V((t)+1,sl_next);} \
    CMASK(C0,C1,t); \
    { float a=MX3(C0[0],C0[1],C1[0]),b=MX3(C0[2],C0[3],C1[1]); a=MX3(a,C1[2],C1[3]); \
      _Pragma("unroll") for(int r=4;r<16;r+=4){a=MX3(a,C0[r],C0[r+1]);b=MX3(b,C0[r+2],C0[r+3]);a=MX3(a,C1[r],C1[r+1]);b=MX3(b,C1[r+2],C1[r+3]);} \
      float rm=__builtin_fmaxf(a,b); { auto rr=__builtin_amdgcn_permlane32_swap(__float_as_uint(rm),__float_as_uint(rm),false,false); rm=__builtin_fmaxf(__uint_as_float(rr[0]),__uint_as_float(rr[1])); } \
      resc=false; \
      if(__builtin_expect(__any(rm>(float)THRL),0)){ const float dl=__builtin_fmaxf(rm,0.f); mhat+=dl; \
        _Pragma("unroll") for(int r=0;r<16;++r){C0[r]-=dl;C1[r]-=dl;} \
        _Pragma("unroll") for(int r=0;r<16;++r)negm[r]=-mhat; asm volatile("":"+v"(negm)); \
        const float f=__builtin_amdgcn_exp2f(-dl); l_reg*=f; if(hi==0)wsf[r32]=f; resc=true; } } \
    SBAR(); \
    GAPB(o[0]=__builtin_amdgcn_mfma_f32_32x32x16_bf16(PAF(0),VFR(0),o[0],0,0,0), C0,0); \
    GAPB(o[1]=__builtin_amdgcn_mfma_f32_32x32x16_bf16(PAF(0),VFR(4),o[1],0,0,0), C0,4); \
    KRD(GL,0); GAPB(o[0]=__builtin_amdgcn_mfma_f32_32x32x16_bf16(PAF(1),VFR(1),o[0],0,0,0), C0,8); \
    KRD(GL,1); GAPB(o[1]=__builtin_amdgcn_mfma_f32_32x32x16_bf16(PAF(1),VFR(5),o[1],0,0,0), C0,12); \
    KRD(GL,2); GAPB(o[0]=__builtin_amdgcn_mfma_f32_32x32x16_bf16(PAF(2),VFR(2),o[0],0,0,0), C1,0); \
    KRD(GL,3); GAPB(o[1]=__builtin_amdgcn_mfma_f32_32x32x16_bf16(PAF(2),VFR(6),o[1],0,0,0), C1,4); \
    GAPB(o[0]=__builtin_amdgcn_mfma_f32_32x32x16_bf16(PAF(3),VFR(3),o[0],0,0,0), C1,8); \
    GAPB(o[1]=__builtin_amdgcn_mfma_f32_32x32x16_bf16(PAF(3),VFR(7),o[1],0,0,0), C1,12); \
    }while(0)
  int t=1;
  #undef CMASK
  #define CMASK(P0,P1,t) do{}while(0)
  for(;t+5<NT;t+=2){
    STEP(pB0,pB1,pA0,pA1,t,true,true,true);     WAIT_BAR(2); RESC(); ROT();
    STEP(pA0,pA1,pB0,pB1,t+1,true,true,true);   WAIT_BAR(2); RESC(); ROT();
  }
  #undef CMASK
  #define CMASK(P0,P1,t) do{}while(0)
  #define ENDW(tt) do{ if((tt)+3<NT){WAIT_BAR(2);} else if((tt)+2<NT){WAIT_BAR(1);} else {WAIT_BAR(0);} }while(0)
  for(;t+1<NT;t+=2){
    STEP(pB0,pB1,pA0,pA1,t,(t+3<NT),(t+1<NT),(t+1<NT));       ENDW(t);   RESC(); ROT();
    STEP(pA0,pA1,pB0,pB1,t+1,(t+4<NT),(t+2<NT),(t+2<NT));     ENDW(t+1); RESC(); ROT();
  }
  STEP(pB0,pB1,pA0,pA1,NT-1,false,false,false); RESC();
  { float sacc=pB0[0]+pB0[1]; _Pragma("unroll") for(int r=2;r<16;++r)sacc+=pB0[r]; _Pragma("unroll") for(int r=0;r<16;++r)sacc+=pB1[r]; l_reg+=sacc;
    pw0=(u32x4){PKW(pB0,0),PKW(pB0,2),PKW(pB0,4),PKW(pB0,6)};pw1=(u32x4){PKW(pB0,8),PKW(pB0,10),PKW(pB0,12),PKW(pB0,14)};pw2=(u32x4){PKW(pB1,0),PKW(pB1,2),PKW(pB1,4),PKW(pB1,6)};pw3=(u32x4){PKW(pB1,8),PKW(pB1,10),PKW(pB1,12),PKW(pB1,14)};
    SBAR(); pv(o,vb0+sl_cur,PAF(0),PAF(1),PAF(2),PAF(3)); }
  #undef PKW
  #undef PAF
  #undef VFR
  #undef PIN
  #undef MX3
  #undef GAPA
  #undef GAPB
  #undef EX
  #undef VRD
  #undef KRD
  #undef STEP
  #undef ENDW
  {auto rr=__builtin_amdgcn_permlane32_swap(__float_as_uint(l_reg),__float_as_uint(l_reg),false,false);l_reg=__uint_as_float(rr[0])+__uint_as_float(rr[1]);}
  if(hi==0)wsf[32+r32]=l_reg;asm volatile("s_waitcnt lgkmcnt(0)":::"memory");
  float rli[16];
  #pragma unroll
  for(int r=0;r<16;++r)rli[r]=__builtin_amdgcn_rcpf(wsf[32+crow(r,hi)]);
  bf16*Ow=Ob+(long)(wid*QBLK)*OP;
  { bf16*stg=(bf16*)(shm+LDS_OST)+wid*2048;
    #pragma unroll
    for(int r=0;r<16;++r){const int orow=crow(r,hi);
      #pragma unroll
      for(int d0=0;d0<2;++d0)stg[orow*64+d0*32+r32]=__float2bfloat16(o[d0][r]*rli[r]);}
    asm volatile("s_waitcnt lgkmcnt(0)":::"memory");
    #pragma unroll
    for(int i=0;i<4;++i){const int row=i*8+(lane>>3),ch=lane&7; const u32x4 v=*(const u32x4*)(stg+row*64+ch*8); ATTN_STORE16(Ow+(long)row*OP+ch*8,v);} }
  asm volatile("s_waitcnt lgkmcnt(0)\n\ts_barrier":::"memory");
  #undef DMA_K
  #undef DMA_V
  #undef CMASK
  #undef START
  #undef RESC
  #undef ROT
}
constexpr int ATTN_LDS_BYTES=LDS_BYTES;
#undef SBAR
#undef WAIT_BAR
}

#define GAS __attribute__((address_space(1)))
#define LAS __attribute__((address_space(3)))
typedef unsigned short bf16;
typedef unsigned v4u __attribute__((ext_vector_type(4)));
typedef float f32x4 __attribute__((ext_vector_type(4)));
typedef short bf16x8 __attribute__((ext_vector_type(8)));
typedef GAS unsigned gu32;
typedef GAS unsigned long long gu64;
#define RLX_AGENT __ATOMIC_RELAXED, __HIP_MEMORY_SCOPE_AGENT
#define LDS_WAIT() asm volatile("s_waitcnt lgkmcnt(0)" ::: "memory")
#define VM_WAIT() asm volatile("s_waitcnt vmcnt(0)" ::: "memory")
__device__ __forceinline__ unsigned long long rt() { return __builtin_amdgcn_s_memrealtime(); }
__device__ __forceinline__ unsigned f2bf(float f) { unsigned u = __builtin_bit_cast(unsigned, f); return (u + 0x7fffu + ((u >> 16) & 1u)) >> 16; }
typedef __bf16 bf16x2g_t __attribute__((ext_vector_type(2))); typedef float f32x2g_t __attribute__((ext_vector_type(2)));
__device__ __forceinline__ unsigned pk2(float lo, float hi) { f32x2g_t v = {lo, hi}; return __builtin_bit_cast(unsigned, __builtin_convertvector(v, bf16x2g_t)); }

#define XB_TMO      128
#define XB_XCNT(j)  (256  + 64 * (j))
#define XB_XSUB(j)  (1280 + 64 * (j))
#define XB_XGEN(j)  (2304 + 64 * (j))
#define XB_TOP      3328
#define XB_TOPGEN   3392
#define XCD_BAR_WORDS 3456
#define XB_SPIN_CAP (1u << 18)

__device__ __forceinline__ unsigned xb_ld(unsigned* p)              { return __hip_atomic_load(p, __ATOMIC_RELAXED, __HIP_MEMORY_SCOPE_AGENT); }
__device__ __forceinline__ unsigned xb_add(unsigned* p, unsigned v) { return __hip_atomic_fetch_add(p, v, __ATOMIC_RELAXED, __HIP_MEMORY_SCOPE_AGENT); }
__device__ __forceinline__ unsigned xb_xcc_id() { return (unsigned)__builtin_amdgcn_s_getreg((3 << 11) | 20) & 0xFu; }
#define XB_SPIN(cond, bar) do { unsigned _sp = 0; while (cond) { __builtin_amdgcn_s_sleep(1); \
    if ((++_sp & 255u) == 0u) { if (xb_ld(&(bar)[XB_TMO])) break; if (_sp > XB_SPIN_CAP) { atomicAdd(&(bar)[XB_TMO], 1u); break; } } } } while (0)

struct XcdBarrier {
    unsigned* bar; unsigned x;
    volatile LAS unsigned* st;
};

__device__ __forceinline__ XcdBarrier xcd_barrier_post(unsigned* bar, volatile LAS unsigned* st) {
    XcdBarrier b; b.bar = bar; b.x = xb_xcc_id(); b.st = st;
    if (threadIdx.x == 0) (void)xb_add(&bar[XB_XCNT(b.x)], 1u);
    return b;
}
__device__ __forceinline__ void xcd_barrier_complete(unsigned* bar, unsigned x, unsigned& nloc, unsigned& nx) {
    const unsigned G = gridDim.x * gridDim.y * gridDim.z;
    unsigned sum, cnt, mine, sp = 0u;
    for (;;) {
        sum = 0u; cnt = 0u; mine = 0u;
#pragma unroll
        for (unsigned j = 0; j < 16; ++j) { const unsigned c = xb_ld(&bar[XB_XCNT(j)]); sum += c; cnt += (c > 0u) ? 1u : 0u; mine = (j == x) ? c : mine; }
        if (sum == G) break;
        __builtin_amdgcn_s_sleep(1);
        if ((++sp & 255u) == 0u) { if (xb_ld(&bar[XB_TMO])) break; if (sp > XB_SPIN_CAP) { atomicAdd(&bar[XB_TMO], 1u); break; } }
    }
    nloc = mine > 0u ? mine : 1u; nx = cnt > 0u ? cnt : 1u;
}

__device__ __forceinline__ void xcd_barrier(const XcdBarrier& b) {
    asm volatile("s_waitcnt vmcnt(0)" ::: "memory");
    __syncthreads();
    if (threadIdx.x == 0) {
        unsigned* bar = b.bar;
        __builtin_amdgcn_s_waitcnt(0);
        unsigned nloc = b.st[0], nx = b.st[1];
        if (nloc == 0u) { xcd_barrier_complete(bar, b.x, nloc, nx); b.st[0] = nloc; b.st[1] = nx; }
        asm volatile("buffer_inv sc1" ::: "memory");
        const unsigned old = xb_add(&bar[XB_XSUB(b.x)], 1u);
        const unsigned gen = old / nloc;
        if (old + 1u == (gen + 1u) * nloc) {
            __builtin_amdgcn_fence(__ATOMIC_RELEASE, "agent");
            asm volatile("s_waitcnt vmcnt(0)" ::: "memory");
            const unsigned og = xb_add(&bar[XB_TOP], 1u);
            const unsigned tg = og / nx;
            if (og + 1u == (tg + 1u) * nx) xb_add(&bar[XB_TOPGEN], 1u);
            else XB_SPIN(xb_ld(&bar[XB_TOPGEN]) == tg, bar);
            asm volatile("" ::: "memory");
            xb_add(&bar[XB_XGEN(b.x)], 1u);
            asm volatile("s_waitcnt vmcnt(0)" ::: "memory");
        } else {
            XB_SPIN(xb_ld(&bar[XB_XGEN(b.x)]) == gen, bar);
            asm volatile("" ::: "memory");
            asm volatile("s_waitcnt vmcnt(0)" ::: "memory");
        }
    }
    __syncthreads();
}

constexpr int NWAVES = 8;
constexpr int N_LAUNCHES = MK_N_LAUNCHES;
constexpr int N_PHASES = 17;
typedef unsigned u32x2 __attribute__((ext_vector_type(2)));
typedef float f32x2v __attribute__((ext_vector_type(2)));

struct Frame {
    unsigned char* lds;
    LAS unsigned char* ldsl;
    volatile LAS unsigned* MISC;
    gu32* ctl;
    int tid, lane, wave, vcu, G;
    unsigned char* ws; float* out;
};
struct Args { const float* in[25]; float* out; unsigned char* ws; int ph_lo, ph_hi, li, pad; };
#define F_x_prompt (A.in[0])
#define F_x_sample (A.in[1])
#define F_cache_k (A.in[2])
#define F_cache_v (A.in[3])
#define F_state_C (A.in[4])
#define F_state_n (A.in[5])
#define F_state_m (A.in[6])
#define F_c (A.in[7])
#define F_c_ctx (A.in[8])
#define F_w_ada (A.in[9])
#define F_b_ada (A.in[10])
#define F_norm1_g (A.in[11])
#define F_w_in (A.in[12])
#define F_q_norm_g (A.in[13])
#define F_k_norm_g (A.in[14])
#define F_m_conv_w (A.in[15])
#define F_m_gate_b (A.in[16])
#define F_m_norm_g (A.in[17])
#define F_w_pa (A.in[18])
#define F_w_pm (A.in[19])
#define F_w_pf (A.in[20])
#define F_w_out (A.in[21])
#define F_norm2_g (A.in[22])
#define F_w_f1 (A.in[23])
#define F_w_f2 (A.in[24])
#define F_out (F.out)
#define WSP(T, off) ((T*)(F.ws + (off)))

__device__ __forceinline__ float wave_sum(float v) {
#pragma unroll
    for (int o = 1; o < 64; o <<= 1) v += __shfl_xor(v, o);
    return v;
}
__device__ __forceinline__ float bf2f(unsigned short h) { return __builtin_bit_cast(float, (unsigned)h << 16); }
__device__ __forceinline__ float silu_f(float y) { return y / (1.0f + __expf(-y)); }

template <bool PN = false>
__device__ __forceinline__ void transpose_item(const float* W, int ldw, int k0, int c0, bf16* WT, int dpitch, int drow0, int dk0, float* scr, int lane) {
    const int h = 4 * (lane & 7), pcol = PN ? 16 * ((h >> 2) & 1) + 4 * ((h >> 3) & 3) : h, kr = lane >> 3;
    f32x4 v[8];
#pragma unroll
    for (int i = 0; i < 8; ++i) v[i] = *(const f32x4*)(W + (size_t)(k0 + 8 * i + kr) * ldw + c0 + h);
#pragma unroll
    for (int i = 0; i < 8; ++i) { float* s = scr + (8 * i + kr) * 33 + pcol; s[0] = v[i][0]; s[1] = v[i][1]; s[2] = v[i][2]; s[3] = v[i][3]; }
    LDS_WAIT(); asm volatile("" ::: "memory");
    const int c = lane & 7;
#pragma unroll
    for (int j = 0; j < 4; ++j) { const int n = (lane >> 3) + 8 * j; const float* s = scr + (8 * c) * 33 + n;
        v4u o; o.x = pk2(s[0 * 33], s[1 * 33]); o.y = pk2(s[2 * 33], s[3 * 33]); o.z = pk2(s[4 * 33], s[5 * 33]); o.w = pk2(s[6 * 33], s[7 * 33]);
        *(v4u*)(WT + (size_t)(drow0 + n) * dpitch + dk0 + 8 * c) = o; }
    LDS_WAIT(); asm volatile("" ::: "memory");
}
__device__ __forceinline__ int win_src_col(int tile, int g) {
    if (tile <= 3) return tile * 256 + 64 * (g & 3) + 32 * (g >> 2);
    if (tile <= 7) return 1024 + (tile - 4) * 256 + 32 * g;
    if (tile == 8) return 2064 + 32 * g;
    return 2320 + (tile - 9) * 256 + 32 * g;
}
constexpr int CV_I1 = 168 * 16, CV_I2 = 32 * 8, CV_I3 = 32 * 4, CV_I4 = 512, CV_I5 = 32 * 16, CV_I6 = 176 * 16, CV_I7 = 32 * 44;
constexpr int CV_MRG = CV_I1, CV_OUT = CV_I1 + CV_I2 + CV_I3 + CV_I4, CV_F1 = CV_OUT + CV_I5, CV_F2 = CV_F1 + CV_I6, CV_END = CV_F2 + CV_I7;
__device__ __forceinline__ void convert_weights(Frame& F, const Args& A, int l, int it_lo, int it_hi, int wi, int nw) {
    float* scr = (float*)(F.lds + RING_OFF + F.wave * 16384);
    float* trig = scr + 64 * 33;
    trig[F.lane] = cosf(6.283185307179586f * (float)F.lane / 64.0f); trig[64 + F.lane] = sinf(6.283185307179586f * (float)F.lane / 64.0f);
    LDS_WAIT(); asm volatile("" ::: "memory");
    const float* w_in = F_w_in + (size_t)l * DM * INC; const float* w_pa = F_w_pa + (size_t)l * 512 * DM; const float* w_pm = F_w_pm + (size_t)l * 256 * DM;
    const float* w_pf = F_w_pf + (size_t)l * 256 * DM; const float* w_out = F_w_out + (size_t)l * DM * DM; const float* w_f1 = F_w_f1 + (size_t)l * DM * NF1; const float* w_f2 = F_w_f2 + (size_t)l * FF * DM;
    bf16* WIN = WSP(bf16, WS_WIN); bf16* WMRG = WSP(bf16, WS_WMRG); bf16* WOUT = WSP(bf16, WS_WOUT); bf16* WF1 = WSP(bf16, WS_WF1); bf16* WF2 = WSP(bf16, WS_WF2);
    constexpr int I1 = CV_I1, I2 = CV_I2, I3 = CV_I3, I4 = CV_I4, I5 = CV_I5, I6 = CV_I6;
    for (int it = it_lo + wi; it < it_hi; it += nw) {
        int r = it;
        if (r < I1) { const int dg = r >> 4, kb = r & 15; if ((dg >> 3) >= 3) transpose_item<true>(w_in, INC, 64 * kb, win_src_col(dg >> 3, dg & 7), WIN, DM, 32 * dg, 64 * kb, scr, F.lane);
            else transpose_item(w_in, INC, 64 * kb, win_src_col(dg >> 3, dg & 7), WIN, DM, 32 * dg, 64 * kb, scr, F.lane);
            continue; } r -= I1;
        if (r < I2) { const int cg = r >> 3, kb = r & 7; transpose_item<true>(w_pa, DM, 64 * kb, 32 * cg, WMRG, KMRG, 32 * cg, 64 * kb, scr, F.lane); continue; } r -= I2;
        if (r < I3) { const int cg = r >> 2, kb = r & 3; transpose_item<true>(w_pm, DM, 64 * kb, 32 * cg, WMRG, KMRG, 32 * cg, 512 + 64 * kb, scr, F.lane); continue; } r -= I3;
        if (r < I4) {
            const int g = r >> 7, nb = (r >> 3) & 15, cb = r & 7; const int n = 64 * nb + F.lane;
            const int nr = (n & ~31) + 16 * ((n >> 2) & 1) + 4 * ((n >> 3) & 3) + (n & 3);
            float pc[8], ps[8];
#pragma unroll
            for (int cc = 0; cc < 8; ++cc) { pc[cc] = 0.f; ps[cc] = 0.f; }
            for (int cp0 = 0; cp0 < 64; cp0 += 16) { float w[16];
#pragma unroll
                for (int q = 0; q < 16; ++q) w[q] = w_pf[(size_t)(g * 64 + cp0 + q) * DM + n];
#pragma unroll
                for (int q = 0; q < 16; ++q)
#pragma unroll
                    for (int cc = 0; cc < 8; ++cc) { const int j = ((8 * cb + cc) * (cp0 + q)) & 63; pc[cc] += trig[j] * w[q]; ps[cc] -= trig[64 + j] * w[q]; } }
            v4u oc, os; oc.x = pk2(pc[0] * 0.125f, pc[1] * 0.125f); oc.y = pk2(pc[2] * 0.125f, pc[3] * 0.125f); oc.z = pk2(pc[4] * 0.125f, pc[5] * 0.125f); oc.w = pk2(pc[6] * 0.125f, pc[7] * 0.125f);
            os.x = pk2(ps[0] * 0.125f, ps[1] * 0.125f); os.y = pk2(ps[2] * 0.125f, ps[3] * 0.125f); os.z = pk2(ps[4] * 0.125f, ps[5] * 0.125f); os.w = pk2(ps[6] * 0.125f, ps[7] * 0.125f);
            *(v4u*)(WMRG + (size_t)nr * KMRG + 768 + g * 64 + 8 * cb) = oc; *(v4u*)(WMRG + (size_t)nr * KMRG + 1024 + g * 64 + 8 * cb) = os;
            continue; } r -= I4;
        if (r < I5) { const int cg = r >> 4, kb = r & 15; transpose_item<true>(w_out, DM, 64 * kb, 32 * cg, WOUT, DM, 32 * cg, 64 * kb, scr, F.lane); continue; } r -= I5;
        if (r < I6) { const int dg = r >> 4, kb = r & 15, tile = dg >> 3, g = dg & 7; const int c0 = g < 4 ? 128 * tile + 32 * g : FF + 128 * tile + 32 * (g - 4);
            transpose_item<true>(w_f1, NF1, 64 * kb, c0, WF1, DM, 32 * dg, 64 * kb, scr, F.lane); continue; } r -= I6;
        { const int cg = r / 44, kb = r % 44; transpose_item<true>(w_f2, DM, 64 * kb, 32 * cg, WF2, FF, 32 * cg, 64 * kb, scr, F.lane); }
    }
}

__device__ __forceinline__ void p0_prologue(Frame& F, const Args& A) {
    const int gw = F.vcu * NWAVES + F.wave, NGW = F.G * NWAVES;
    float* PMOD = WSP(float, WS_BG);
    if (F.vcu < 2 * 24 * 4) {
      float* scv = (float*)(F.lds + RING_OFF);
      f32x4* red = (f32x4*)(F.lds + RING_OFF + 40960);
      for (int i = F.tid; i < 9 * DM; i += NWAVES * 64) { const int v = i >> 10, k = i & 1023; scv[i] = silu_f(v == 0 ? F_c_ctx[k] : F_c[(v - 1) * DM + k]); }
      __syncthreads();
      for (int it = F.vcu; it < 2 * 24 * 4; it += F.G) {
        const int q = it & 3, cg = (it >> 2) % 24, l = it / 96; const int col = 256 * cg + 4 * F.lane;
        f32x4 acc[9];
#pragma unroll
        for (int v = 0; v < 9; ++v) acc[v] = (f32x4){0.f, 0.f, 0.f, 0.f};
        const int kb = 256 * q + 32 * F.wave;
        const float* wa = F_w_ada + ((size_t)l * DM + kb) * 6144 + col;
        for (int k0 = 0; k0 < 32; k0 += 16) {
            f32x4 w4[16];
#pragma unroll
            for (int k = 0; k < 16; ++k) w4[k] = __builtin_nontemporal_load((const f32x4*)(wa + (size_t)(k0 + k) * 6144));
#pragma unroll
            for (int k = 0; k < 16; ++k) { const int kk = kb + k0 + k;
#pragma unroll
                for (int v = 0; v < 9; ++v) acc[v] = acc[v] + w4[k] * scv[v * 1024 + kk]; }
        }
#pragma unroll
        for (int v = 0; v < 9; ++v) red[(F.wave * 9 + v) * 64 + F.lane] = acc[v];
        __syncthreads();
        for (int o = F.tid; o < 9 * 64; o += NWAVES * 64) { const int v = o >> 6, ln = o & 63; f32x4 s = red[v * 64 + ln];
#pragma unroll
            for (int w = 1; w < 8; ++w) s = s + red[(w * 9 + v) * 64 + ln];
            *(f32x4*)(PMOD + (((size_t)q * 2 + l) * 9 + v) * 6144 + 256 * cg + 4 * ln) = s; }
        __syncthreads();
      } }
    { bf16* DL = WSP(bf16, WS_DFTL); const int gt = (F.vcu * NWAVES + F.wave) * 64 + F.lane, NT_ = F.G * NWAVES * 64;
      for (int i = gt; i < 1024 * 128; i += NT_) { const int r = i >> 7, t0 = (i & 127) * 8; const bool cs = (r <= 512); const int rr = r < 512 ? r : (r == 512 ? 512 : r - 512); float vv[8];
#pragma unroll
          for (int j = 0; j < 8; ++j) { const int ph = (rr * (t0 + j)) & 1023; const float a = (float)ph * (1.0f / 1024.0f); vv[j] = (cs ? __builtin_amdgcn_cosf(a) : __builtin_amdgcn_sinf(a)) * (1.0f / 32.0f); }
          v4u o; o.x = pk2(vv[0], vv[1]); o.y = pk2(vv[2], vv[3]); o.z = pk2(vv[4], vv[5]); o.w = pk2(vv[6], vv[7]); *(v4u*)(DL + (size_t)r * 1024 + t0) = o; }
      bf16* DC = WSP(bf16, WS_DFTC);
      for (int i = gt; i < 256 * 32; i += NT_) { const int r = i >> 5, t0 = (i & 31) * 8; const bool cs = (r <= 128); const int rr = r < 128 ? r : (r == 128 ? 128 : r - 128); float vv[8];
#pragma unroll
          for (int j = 0; j < 8; ++j) { const int ph = (rr * (t0 + j)) & 255; const float a = (float)ph * (1.0f / 256.0f); vv[j] = (cs ? __builtin_amdgcn_cosf(a) : __builtin_amdgcn_sinf(a)) * (1.0f / 16.0f); }
          v4u o; o.x = pk2(vv[0], vv[1]); o.y = pk2(vv[2], vv[3]); o.z = pk2(vv[4], vv[5]); o.w = pk2(vv[6], vv[7]); *(v4u*)(DC + (size_t)r * 256 + t0) = o; }
      f32x2v* RP = WSP(f32x2v, WS_ROPE);
      for (int i = gt; i < 64 * 16; i += NT_) { const int pos = i >> 4, fi = i & 15; const float inv = 1.0f / powf(10000.0f, (float)fi / 16.0f); const float a = (float)pos * inv; RP[i] = (f32x2v){cosf(a), sinf(a)}; }
    }
}

__device__ __forceinline__ void norm_phase(Frame& F, const Args& A, int l, int which, int fitem = -1, gu32* fflag = nullptr, bool fused = false) {
    const int gw = F.vcu * NWAVES + F.wave, NGW = F.G * NWAVES;
    if (fused) { asm volatile("s_waitcnt vmcnt(0)" ::: "memory"); __syncthreads();
        if (fitem >= 0 && F.tid == 0) { __builtin_amdgcn_fence(__ATOMIC_RELEASE, "agent"); asm volatile("s_waitcnt vmcnt(0)" ::: "memory"); (void)__hip_atomic_fetch_add(fflag, 1u, RLX_AGENT); } }
    const float* MOD = WSP(float, WS_MOD) + (size_t)l * 9 * 6144;
    bf16* XN = WSP(bf16, WS_XN);
    float* gml = (float*)(F.lds + RING_OFF); float* shl = gml + 9 * 1024;
    bf16* wgb = (bf16*)(F.lds + RING_OFF + 73728);
    float* gpart = (float*)(F.lds + RING_OFF + 73728 + 32768);
    const bool idle0 = (which == 0 && l == 0 && F.G == 256 && F.vcu >= 192);
    if (which == 0 && l > 0 && F.G != 256) { convert_weights(F, A, l, 0, CV_END, F.vcu * NWAVES + F.wave, F.G * NWAVES); __syncthreads(); }
    if (which == 0 && l == 0) {
        const float* PMOD = WSP(float, WS_BG); float* MODW = WSP(float, WS_MOD); const size_t QS = (size_t)2 * 9 * 6144;
        for (int i4 = gw * 64 + F.lane; i4 < 2 * 9 * 6144 / 4; i4 += NGW * 64) { const size_t i = (size_t)i4 * 4;
            *(f32x4*)(MODW + i) = ((*(const f32x4*)(PMOD + i) + *(const f32x4*)(PMOD + QS + i)) + (*(const f32x4*)(PMOD + 2 * QS + i) + *(const f32x4*)(PMOD + 3 * QS + i))) + *(const f32x4*)(F_b_ada + (i / (9 * 6144)) * 6144 + (i % 6144)); }
        if (!idle0)
        for (int i4 = F.tid; i4 < 9 * 256; i4 += NWAVES * 64) { const int v = i4 >> 8, c = (i4 & 255) * 4; const size_t isc = (size_t)v * 6144 + 1024 + c, ish = (size_t)v * 6144 + c;
            const f32x4 sc = ((*(const f32x4*)(PMOD + isc) + *(const f32x4*)(PMOD + QS + isc)) + (*(const f32x4*)(PMOD + 2 * QS + isc) + *(const f32x4*)(PMOD + 3 * QS + isc))) + *(const f32x4*)(F_b_ada + 1024 + c);
            const f32x4 sh = ((*(const f32x4*)(PMOD + ish) + *(const f32x4*)(PMOD + QS + ish)) + (*(const f32x4*)(PMOD + 2 * QS + ish) + *(const f32x4*)(PMOD + 3 * QS + ish))) + *(const f32x4*)(F_b_ada + c);
            *(f32x4*)(gml + v * 1024 + c) = *(const f32x4*)(F_norm1_g + c) * (sc + 1.0f); *(f32x4*)(shl + v * 1024 + c) = sh; }
    } else { const float* ng = (which == 0 ? F_norm1_g : F_norm2_g) + (size_t)l * DM; const int o_sh = which == 0 ? 0 : 3072, o_sc = which == 0 ? 1024 : 4096;
      for (int i4 = F.tid; i4 < 9 * 256; i4 += NWAVES * 64) { const int v = i4 >> 8, c = (i4 & 255) * 4;
          *(f32x4*)(gml + v * 1024 + c) = *(const f32x4*)(ng + c) * (*(const f32x4*)(MOD + (size_t)v * 6144 + o_sc + c) + 1.0f); *(f32x4*)(shl + v * 1024 + c) = *(const f32x4*)(MOD + (size_t)v * 6144 + o_sh + c); } }
    if (which == 0) {
        const float* w_in = F_w_in + (size_t)l * DM * INC;
        if (!idle0)
        for (int i = F.tid; i < 4 * 1024; i += NWAVES * 64) { const int k = i >> 2, g4 = (i & 3) * 4; const f32x4 w4 = *(const f32x4*)(w_in + (size_t)k * INC + 2048 + g4);
#pragma unroll
            for (int j = 0; j < 4; ++j) wgb[(g4 + j) * 1024 + k] = (bf16)f2bf(w4[j]); }
        { bf16* KL = WSP(bf16, WS_KL); bf16* VL = WSP(bf16, WS_VL); const int gt = gw * 64 + F.lane, NT_ = NGW * 64;
          for (int i = gt; i < 2 * 8 * 8192; i += NT_) { const int kv = i >= 8 * 8192, r = i - kv * 8 * 8192, b = r >> 13, e = (r & 8191) * 8;
              const int es = kv ? e : (e & ~31) + ((e >> 3) & 3) * 4; const int e2 = kv ? e + 4 : es + 16;
              const float* src = (kv ? F_cache_v : F_cache_k) + ((size_t)(b * 2 + l)) * 65536; const f32x4 a = *(const f32x4*)(src + es), c4 = *(const f32x4*)(src + e2);
              v4u o; o.x = pk2(a[0], a[1]); o.y = pk2(a[2], a[3]); o.z = pk2(c4[0], c4[1]); o.w = pk2(c4[2], c4[3]);
              *(v4u*)((kv ? VL : KL) + (size_t)b * 1280 * 256 + e) = o; } }
    }
    __syncthreads();
    float* GATES = WSP(float, WS_GATES);
    const bool from_in = (l == 0 && which == 0);
    const float* xbp = from_in ? F_x_prompt : F_out; const float* xbs = from_in ? F_x_sample : F_out + (size_t)MC * DM;
    const bf16* xb16 = WSP(bf16, WS_ACAT);
    if (fused && fitem >= 0) {
        if (F.tid < 64) { asm volatile("buffer_inv sc1" ::: "memory"); unsigned sp = 0; while ((unsigned)__builtin_amdgcn_readfirstlane(__hip_atomic_load(fflag, RLX_AGENT)) < 4u) { __builtin_amdgcn_s_sleep(2); if (++sp > (1u << 22)) { if (F.tid == 0) __hip_atomic_store(F.ctl + CW_TMO, 0xBAD3u, RLX_AGENT); break; } }
            asm volatile("s_waitcnt vmcnt(0)" ::: "memory"); }
        __syncthreads(); }
    const int n_it = which == 0 ? 192 : 1;
    for (int item = fused ? (fitem >= 0 ? fitem : 192) : (which == 0 ? F.vcu : 0); item < n_it; item += fused ? 192 : (which == 0 ? F.G : 1)) {
        const int m_first = which == 0 ? 64 * item + 8 * F.wave : gw, m_step = which == 0 ? 1 : NGW, m_end = which == 0 ? 64 * item + 8 * F.wave + 8 : MTOT;
        for (int m0 = m_first; m0 < m_end; m0 += 4 * m_step) {
            f32x4 xr[4][4];
#pragma unroll
            for (int r = 0; r < 4; ++r) { const int m = m0 + r * m_step;
                if (m < m_end) { const float* xrow = m < MC ? xbp + (size_t)m * DM : xbs + (size_t)(m - MC) * DM;
#pragma unroll
                    for (int j = 0; j < 4; ++j) { if (which == 0) xr[r][j] = *(const f32x4*)(xrow + 4 * F.lane + 256 * j);
                        else { const u32x2 w = *(const u32x2*)(xb16 + (size_t)m * DM + 4 * F.lane + 256 * j); xr[r][j][0] = __builtin_bit_cast(float, w.x << 16); xr[r][j][1] = __builtin_bit_cast(float, w.x & 0xffff0000u); xr[r][j][2] = __builtin_bit_cast(float, w.y << 16); xr[r][j][3] = __builtin_bit_cast(float, w.y & 0xffff0000u); } } } }
            asm volatile("" ::: "memory");
#pragma unroll
            for (int r = 0; r < 4; ++r) { const int m = m0 + r * m_step;
                if (m < m_end) {
                    const int v = m < MC ? 0 : 1 + ((m - MC) >> 10); float s = 0.f;
#pragma unroll
                    for (int j = 0; j < 4; ++j) s += (xr[r][j][0] * xr[r][j][0] + xr[r][j][1] * xr[r][j][1]) + (xr[r][j][2] * xr[r][j][2] + xr[r][j][3] * xr[r][j][3]);
                    const float rs = 1.0f / sqrtf(wave_sum(s) * (1.0f / DM) + RMS_EPS);
#pragma unroll
                    for (int j = 0; j < 4; ++j) { const int c = 4 * F.lane + 256 * j; const f32x4 g = *(const f32x4*)(gml + v * 1024 + c), sh = *(const f32x4*)(shl + v * 1024 + c);
                        const f32x4 y = xr[r][j] * rs * g + sh;
                        u32x2 w; w.x = pk2(y[0], y[1]); w.y = pk2(y[2], y[3]); *(u32x2*)(XN + (size_t)m * DM + c) = w; }
                } }
        }
        if (which == 0) {
            __syncthreads();
            const int r16 = F.lane & 15, kq = F.lane >> 4, mt = F.wave & 3, kh = F.wave >> 2;
            const bf16* arow = XN + (size_t)(64 * item + 16 * mt + r16) * DM + 512 * kh + 8 * kq; const bf16* brow = wgb + r16 * 1024 + 512 * kh + 8 * kq;
            bf16x8 af[16];
#pragma unroll
            for (int ks = 0; ks < 16; ++ks) af[ks] = *(const bf16x8*)(arow + 32 * ks);
            f32x4 acc = (f32x4){0.f, 0.f, 0.f, 0.f};
#pragma unroll
            for (int ks = 0; ks < 16; ++ks) acc = __builtin_amdgcn_mfma_f32_16x16x32_bf16(af[ks], *(const bf16x8*)(brow + 32 * ks), acc, 0, 0, 0);
            if (kh == 1) { *(f32x4*)(gpart + ((mt * 16 + r16) * 4 + kq) * 4) = acc; }
            __syncthreads();
            if (kh == 0) { const f32x4 o = acc + *(const f32x4*)(gpart + ((mt * 16 + r16) * 4 + kq) * 4);
#pragma unroll
                for (int rg = 0; rg < 4; ++rg) GATES[(size_t)(64 * item + 16 * mt + 4 * kq + rg) * 16 + r16] = o[rg]; }
            __syncthreads();
        }
    }
    __syncthreads();
    if (which == 0 && l == 0) {
        if (F.G == 256) {
            const int I4LO = CV_MRG + CV_I2 + CV_I3;
            for (int r = 0; r < 2; ++r) {
                int lo, hi, wi, nw;
                if (idle0) { const int w = (F.vcu - 192) * NWAVES + F.wave; lo = r == 0 ? I4LO : 0; hi = r == 0 ? CV_OUT : 2048; wi = w; nw = 512; }
                else { const int w = F.vcu * NWAVES + F.wave; lo = r == 0 ? 2048 : CV_OUT; hi = r == 0 ? I4LO : CV_F1; wi = r == 0 ? w : (w + 512) % 1536; nw = 1536; }
                convert_weights(F, A, 0, lo, hi, wi, nw);
            }
        } else convert_weights(F, A, 0, 0, CV_END, F.vcu * NWAVES + F.wave, F.G * NWAVES);
    }
}

__device__ __forceinline__ void norm2_after_outproj(Frame& F, const Args& A, int l, int pm, int pn, gu32* flag) {
    asm volatile("s_waitcnt vmcnt(0)" ::: "memory"); __syncthreads();
    if (F.tid < 64) {
        if (F.tid == 0) { asm volatile("s_waitcnt vmcnt(0)" ::: "memory"); (void)__hip_atomic_fetch_add(flag, 1u, RLX_AGENT); }
        asm volatile("buffer_inv sc1" ::: "memory");
        unsigned sp = 0; while ((unsigned)__builtin_amdgcn_readfirstlane(__hip_atomic_load(flag, RLX_AGENT)) < 4u) { __builtin_amdgcn_s_sleep(2); if (++sp > (1u << 22)) { if (F.tid == 0) __hip_atomic_store(F.ctl + CW_TMO, 0xBAD2u, RLX_AGENT); break; } }
        asm volatile("s_waitcnt vmcnt(0)" ::: "memory");
    }
    __syncthreads();
    const float* MOD = WSP(float, WS_MOD) + (size_t)l * 9 * 6144; const int v = pm < 16 ? 0 : 1 + ((pm - 16) >> 2);
    const bf16* xb16 = WSP(bf16, WS_ACAT); bf16* XN = WSP(bf16, WS_XN);
    f32x4 gg[4], sh[4];
#pragma unroll
    for (int j = 0; j < 4; ++j) { const int c = 4 * F.lane + 256 * j; gg[j] = *(const f32x4*)(F_norm2_g + (size_t)l * DM + c) * (*(const f32x4*)(MOD + (size_t)v * 6144 + 4096 + c) + 1.0f); sh[j] = *(const f32x4*)(MOD + (size_t)v * 6144 + 3072 + c); }
    const int m_base = pm * 256 + pn * 64 + F.wave * 8;
#pragma unroll
    for (int ch = 0; ch < 2; ++ch) {
        u32x2 xr[4][4];
#pragma unroll
        for (int r = 0; r < 4; ++r)
#pragma unroll
            for (int j = 0; j < 4; ++j) xr[r][j] = *(const u32x2*)(xb16 + (size_t)(m_base + 4 * ch + r) * DM + 4 * F.lane + 256 * j);
        asm volatile("" ::: "memory");
#pragma unroll
        for (int r = 0; r < 4; ++r) { const int m = m_base + 4 * ch + r; f32x4 x[4]; float s = 0.f;
#pragma unroll
            for (int j = 0; j < 4; ++j) { const u32x2 w = xr[r][j]; x[j][0] = __builtin_bit_cast(float, w.x << 16); x[j][1] = __builtin_bit_cast(float, w.x & 0xffff0000u); x[j][2] = __builtin_bit_cast(float, w.y << 16); x[j][3] = __builtin_bit_cast(float, w.y & 0xffff0000u);
                s += (x[j][0] * x[j][0] + x[j][1] * x[j][1]) + (x[j][2] * x[j][2] + x[j][3] * x[j][3]); }
            const float rs = 1.0f / sqrtf(wave_sum(s) * (1.0f / DM) + RMS_EPS);
#pragma unroll
            for (int j = 0; j < 4; ++j) { const f32x4 y = x[j] * rs * gg[j] + sh[j]; u32x2 w; w.x = pk2(y[0], y[1]); w.y = pk2(y[2], y[3]); *(u32x2*)(XN + (size_t)m * DM + 4 * F.lane + 256 * j) = w; }
        }
    }
}

constexpr int L_AU = 0, L_AR = 8192, L_AWI = 16384, L_AEMJ = 24576, L_AWK = 32768, L_CH = 40960, L_NST = 41984, L_IV = 50176, L_SL = 52224, SL_PITCH = 72;
static_assert(L_SL + 8 * 64 * SL_PITCH * 2 <= RING_BYTES, "mLSTM LDS map");
typedef float f32x4m __attribute__((ext_vector_type(4)));
__device__ __forceinline__ f32x4 mfma16(bf16x8 a, bf16x8 b, f32x4 c) { return __builtin_amdgcn_mfma_f32_16x16x32_bf16(a, b, c, 0, 0, 0); }
__device__ __forceinline__ bf16x8 pack8(const float (&v)[8]) { v4u o; o.x = pk2(v[0], v[1]); o.y = pk2(v[2], v[3]); o.z = pk2(v[4], v[5]); o.w = pk2(v[6], v[7]); return __builtin_bit_cast(bf16x8, o); }
__device__ __forceinline__ void unpack8(bf16x8 p, float (&v)[8]) { const v4u o = __builtin_bit_cast(v4u, p);
    v[0] = __builtin_bit_cast(float, o.x << 16); v[1] = __builtin_bit_cast(float, o.x & 0xffff0000u); v[2] = __builtin_bit_cast(float, o.y << 16); v[3] = __builtin_bit_cast(float, o.y & 0xffff0000u);
    v[4] = __builtin_bit_cast(float, o.z << 16); v[5] = __builtin_bit_cast(float, o.z & 0xffff0000u); v[6] = __builtin_bit_cast(float, o.w << 16); v[7] = __builtin_bit_cast(float, o.w & 0xffff0000u); }
__device__ __forceinline__ bf16x8 conv8_nat(bf16x8 xm, bf16x8 x0, bf16x8 xp, const float* cw, float post) {
    float a[8], b[8], c[8], o[8]; unpack8(xm, a); unpack8(x0, b); unpack8(xp, c);
    const f32x4 w0a = *(const f32x4*)(cw), w0b = *(const f32x4*)(cw + 4), w1a = *(const f32x4*)(cw + 512), w1b = *(const f32x4*)(cw + 516), w2a = *(const f32x4*)(cw + 1024), w2b = *(const f32x4*)(cw + 1028);
#pragma unroll
    for (int j = 0; j < 8; ++j) { const float w0 = j < 4 ? w0a[j & 3] : w0b[j & 3], w1 = j < 4 ? w1a[j & 3] : w1b[j & 3], w2 = j < 4 ? w2a[j & 3] : w2b[j & 3];
        o[j] = silu_f(w0 * a[j] + w1 * b[j] + w2 * c[j]) * post; }
    return pack8(o);
}
template <int MASK> __device__ __forceinline__ float swz_xor(float v) { return __shfl_xor(v, MASK); }
__device__ __forceinline__ float sum_xor32(float v) { auto rr = __builtin_amdgcn_permlane32_swap(__builtin_bit_cast(unsigned, v), __builtin_bit_cast(unsigned, v), false, false); return __builtin_bit_cast(float, rr[0]) + __builtin_bit_cast(float, rr[1]); }
__device__ __forceinline__ float sum_kq(float v) { v += __shfl_xor(v, 16); v += __shfl_xor(v, 32); return v; }
__device__ __forceinline__ float sum_r16(float v) { v += swz_xor<1>(v); v += swz_xor<2>(v); v += swz_xor<4>(v); v += swz_xor<8>(v); return v; }
__device__ __forceinline__ float logsigmoid_f(float x) { return fminf(x, 0.f) - log1pf(__expf(-fabsf(x))); }

constexpr size_t PA_PLANE = (size_t)2 * 4 * MTOT;
constexpr size_t NSLOT_M = (size_t)192 * 4 * 2;
__device__ __forceinline__ void mlstm_c0(Frame& F, const Args& A, int l) {
    const int gw = F.vcu * NWAVES + F.wave, NGW = F.G * NWAVES; const int gt = gw * 64 + F.lane, NT_ = NGW * 64; const int lane = F.lane;
    const float* cwl = F_m_conv_w + (size_t)l * 3 * 512; const float* gb = F_m_gate_b + l * 16; const float* GATES = WSP(float, WS_GATES);
    const bf16* QM = WSP(bf16, WS_QM); const bf16* KM = WSP(bf16, WS_KM); const bf16* KMT = WSP(bf16, WS_KMT); const bf16* VTb = WSP(bf16, WS_VT);
    bf16* QN = WSP(bf16, WS_QN); bf16* KN = WSP(bf16, WS_KN); bf16* UT2 = WSP(bf16, WS_UT2);
    float* PA = WSP(float, WS_PA); float* CS = PA + 3 * PA_PLANE; float* NU = CS + NSLOT_M * 4 + NSLOT_M * 64;
    float* wkl = (float*)(F.lds + RING_OFF) + F.wave * 64;
    for (int it = gw; it < 192 * 4 * 2; it += NGW) { const int d = it & 1, h = (it >> 1) & 3, cgk = it >> 3; const size_t row = (size_t)cgk * 64 + lane;
        const float* gp = GATES + row * 16 + d * 8 + h; const float g_i = gp[0], g_f = gp[4];
        const bool lat = cgk >= 64; const int T = lat ? 1024 : 256; const int b = lat ? (cgk - 64) >> 4 : cgk >> 2, oc = lat ? (cgk - 64) & 15 : cgk & 3;
        const size_t tbase = lat ? (size_t)16 * 65536 + (size_t)b * 262144 : (size_t)b * 65536;
        int r16 = lane & 15, kq = lane >> 4; asm volatile("" : "+v"(r16), "+v"(kq));
        bf16x8 bfr[2][4], kfr[2][4]; float kxl[2][4], kxh[2][4];
#pragma unroll
        for (int ks = 0; ks < 2; ++ks) { const int t0 = 64 * oc + 32 * ks + 8 * kq;
#pragma unroll
            for (int nt = 0; nt < 4; ++nt) { bfr[ks][nt] = *(const bf16x8*)(VTb + tbase + (size_t)(h * 64 + 16 * nt + r16) * T + t0);
                const bf16* kr = KMT + tbase + (size_t)(h * 64 + 16 * nt + r16) * T; kfr[ks][nt] = *(const bf16x8*)(kr + t0); kxl[ks][nt] = t0 > 0 ? bf2f(kr[t0 - 1]) : 0.f; kxh[ks][nt] = t0 + 8 < T ? bf2f(kr[t0 + 8]) : 0.f; } }
        const float li = g_i + gb[d * 8 + h]; const float lf = logsigmoid_f(g_f + gb[d * 8 + 4 + h]);
        float bs = lf;
#pragma unroll
        for (int off = 1; off < 64; off <<= 1) { const float o = d ? __shfl_down(bs, off) : __shfl_up(bs, off); const bool ok = d ? (lane + off < 64) : (lane >= off); if (ok) bs += o; }
        const float r = li - bs; float pm = r;
#pragma unroll
        for (int off = 1; off < 64; off <<= 1) { const float o = d ? __shfl_down(pm, off) : __shfl_up(pm, off); const bool ok = d ? (lane + off < 64) : (lane >= off); if (ok) pm = fmaxf(pm, o); }
        const float bl = __shfl(bs, d ? 0 : 63), rmax = __shfl(pm, d ? 0 : 63);
        float* pp = PA + ((size_t)d * 4 + h) * MTOT + row; pp[0] = bs; pp[PA_PLANE] = r; pp[2 * PA_PLANE] = pm;
        const size_t slot = ((size_t)cgk * 4 + h) * 2 + d;
        if (lane == 0) { float* cs = CS + slot * 4; cs[0] = bl; cs[1] = bl + rmax; }
        wkl[lane] = __expf(r - rmax);
        f32x4 U[4][4];
#pragma unroll
        for (int mt = 0; mt < 4; ++mt)
#pragma unroll
            for (int nt = 0; nt < 4; ++nt) U[mt][nt] = (f32x4){0.f, 0.f, 0.f, 0.f};
        float nsum[4] = {0.f, 0.f, 0.f, 0.f};
#pragma unroll
        for (int ks = 0; ks < 2; ++ks) {
            const f32x4 wk0 = *(const f32x4*)(wkl + 32 * ks + 8 * kq), wk1 = *(const f32x4*)(wkl + 32 * ks + 8 * kq + 4);
#pragma unroll
            for (int mt = 0; mt < 4; ++mt) { const int ch = h * 64 + 16 * mt + r16;
                const float cw0 = cwl[256 + ch], cw1 = cwl[512 + 256 + ch], cw2 = cwl[1024 + 256 + ch];
                float x[10]; { float xx[8]; unpack8(kfr[ks][mt], xx);
#pragma unroll
                    for (int j = 0; j < 8; ++j) x[j + 1] = xx[j]; }
                x[0] = kxl[ks][mt]; x[9] = kxh[ks][mt];
                float kt[8];
#pragma unroll
                for (int j = 0; j < 8; ++j) { kt[j] = silu_f(cw0 * x[j] + cw1 * x[j + 1] + cw2 * x[j + 2]) * 0.125f * (j < 4 ? wk0[j & 3] : wk1[j & 3]); nsum[mt] += kt[j]; }
                const bf16x8 af = pack8(kt);
#pragma unroll
                for (int nt = 0; nt < 4; ++nt) U[mt][nt] = mfma16(af, bfr[ks][nt], U[mt][nt]); }
        }
        bf16* us = UT2 + slot * 4096;
#pragma unroll
        for (int mt = 0; mt < 4; ++mt) { const float ns = sum_kq(nsum[mt]); if (kq == 0) NU[slot * 64 + 16 * mt + r16] = ns;
#pragma unroll
            for (int nt = 0; nt < 4; ++nt) { u32x2 w; w.x = pk2(U[mt][nt][0], U[mt][nt][1]); w.y = pk2(U[mt][nt][2], U[mt][nt][3]); *(u32x2*)(us + (16 * nt + r16) * 64 + 16 * mt + 4 * kq) = w; } }
    }
    { const bf16x8 z8 = {0, 0, 0, 0, 0, 0, 0, 0};
      for (int i = gt; i < MTOT * 32; i += NT_) { const int row = i >> 5, col = 8 * (i & 31); const int t = row < MC ? (row & 255) : ((row - MC) & 1023), T = row < MC ? 256 : 1024; const size_t off = (size_t)row * 256 + col;
        const bf16x8 q0 = *(const bf16x8*)(QM + off), qm_ = t > 0 ? *(const bf16x8*)(QM + off - 256) : z8, qp = t + 1 < T ? *(const bf16x8*)(QM + off + 256) : z8;
        const bf16x8 k0 = *(const bf16x8*)(KM + off), km_ = t > 0 ? *(const bf16x8*)(KM + off - 256) : z8, kp = t + 1 < T ? *(const bf16x8*)(KM + off + 256) : z8;
        *(bf16x8*)(QN + off) = conv8_nat(qm_, q0, qp, cwl + col, 1.0f); *(bf16x8*)(KN + off) = conv8_nat(km_, k0, kp, cwl + 256 + col, 0.125f); } }
}
__device__ __forceinline__ void mlstm_m1(Frame& F, const Args& A, int l, int b, int h, bool ctx, gu32* flag) {
    const int T = ctx ? 256 : 1024, nc = T >> 6;
    const size_t R0 = ctx ? (size_t)b * 256 : (size_t)MC + (size_t)b * 1024;
    int tid = F.tid; asm volatile("" : "+v"(tid));
    float* CDEC = (float*)(F.lds + L_CH); float* CE = CDEC + 32;
    bf16* CT = WSP(bf16, WS_CT); const bf16* UT2 = WSP(bf16, WS_UT2); float* PA = WSP(float, WS_PA); float* CS = PA + 3 * PA_PLANE; float* NSTG = CS + NSLOT_M * 4; const float* NU = NSTG + NSLOT_M * 64;
    if (tid < 2) { const int d = tid; float mm = ctx ? 0.f : F_state_m[((b * 2 + l) * 2 + d) * 4 + h];
        float bl_[16], a_[16];
#pragma unroll
        for (int k = 0; k < 16; ++k) { if (k < nc) { const float* cs = CS + ((((R0 >> 6) + k) * 4 + h) * 2 + d) * 4; bl_[k] = cs[0]; a_[k] = cs[1]; } else { bl_[k] = 0.f; a_[k] = 0.f; } }
#pragma unroll
        for (int k = 0; k < 16; ++k) { const int oc = d ? nc - 1 - k : k;
            if (k < nc) { float bl = 0.f, aa = 0.f;
#pragma unroll
                for (int q = 0; q < 16; ++q) { if (q == oc) { bl = bl_[q]; aa = a_[q]; } }
                float* cs = CS + ((((R0 >> 6) + oc) * 4 + h) * 2 + d) * 4; cs[2] = mm; const float mn = fmaxf(bl + mm, aa);
                CDEC[d * 16 + oc] = __expf(bl + mm - mn); CE[d * 16 + oc] = __expf(aa - mn); cs[3] = mn; mm = mn; } }
        if (ctx) F_out[OFF_NM + ((b * 2 + l) * 2 + d) * 4 + h] = mm; }
    __syncthreads();
    {
        const int d = tid >> 8, e = tid & 255, dv = e >> 2, dk0 = (e & 3) * 16;
        float C[16]; float nval = 0.f;
        if (ctx) {
#pragma unroll
            for (int i = 0; i < 16; ++i) C[i] = 0.f;
        } else {
            const float* sc = F_state_C + (size_t)(((b * 2 + l) * 2 + d) * 4 + h) * 4096;
#pragma unroll
            for (int i = 0; i < 16; ++i) C[i] = sc[(dk0 + i) * 64 + dv];
            if (e < 64) nval = F_state_n[(size_t)(((b * 2 + l) * 2 + d) * 4 + h) * 64 + e];
        }
        for (int k0 = 0; k0 < nc; k0 += 4) {
            bf16x8 u[4][2]; float nu[4];
#pragma unroll
            for (int kk = 0; kk < 4; ++kk) { const int oc = d ? nc - 1 - (k0 + kk) : k0 + kk; const size_t slot = (((R0 >> 6) + oc) * 4 + h) * 2 + d;
                u[kk][0] = *(const bf16x8*)(UT2 + slot * 4096 + 16 * e); u[kk][1] = *(const bf16x8*)(UT2 + slot * 4096 + 16 * e + 8); nu[kk] = e < 64 ? NU[slot * 64 + e] : 0.f; }
#pragma unroll
            for (int kk = 0; kk < 4; ++kk) { const int oc = d ? nc - 1 - (k0 + kk) : k0 + kk; const size_t slot = (((R0 >> 6) + oc) * 4 + h) * 2 + d;
                float lo[8], hi[8];
#pragma unroll
                for (int i = 0; i < 8; ++i) { lo[i] = C[i]; hi[i] = C[8 + i]; }
                *(bf16x8*)(CT + slot * 4096 + 16 * e) = pack8(lo); *(bf16x8*)(CT + slot * 4096 + 16 * e + 8) = pack8(hi);
                if (e < 64) NSTG[slot * 64 + e] = nval;
                const float dec = CDEC[d * 16 + oc], we = CE[d * 16 + oc]; float ul[8], uh[8]; unpack8(u[kk][0], ul); unpack8(u[kk][1], uh);
#pragma unroll
                for (int i = 0; i < 8; ++i) { C[i] = dec * C[i] + we * ul[i]; C[8 + i] = dec * C[8 + i] + we * uh[i]; }
                nval = dec * nval + we * nu[kk]; }
        }
        if (ctx) {
            float* oc_ = F_out + OFF_NC + (size_t)(((b * 2 + l) * 2 + d) * 4 + h) * 4096;
#pragma unroll
            for (int i = 0; i < 16; ++i) oc_[(dk0 + i) * 64 + dv] = C[i];
            if (e < 64) F_out[OFF_NN + (size_t)(((b * 2 + l) * 2 + d) * 4 + h) * 64 + e] = nval;
        }
    }
    asm volatile("s_waitcnt vmcnt(0)" ::: "memory");
    __syncthreads();
    if (tid == 0) { __builtin_amdgcn_fence(__ATOMIC_RELEASE, "agent"); asm volatile("s_waitcnt vmcnt(0)" ::: "memory"); __hip_atomic_store(flag, 1u, RLX_AGENT); }
}
__device__ __forceinline__ void mlstm_wait(Frame& F, gu32* flag) {
    if (F.tid < 64) { asm volatile("buffer_inv sc1" ::: "memory"); unsigned sp = 0; while ((unsigned)__builtin_amdgcn_readfirstlane(__hip_atomic_load(flag, RLX_AGENT)) == 0u) { __builtin_amdgcn_s_sleep(4); if (++sp > (1u << 24)) { if (F.tid == 0) __hip_atomic_store(F.ctl + CW_TMO, 0xBAD1u, RLX_AGENT); break; } }
        asm volatile("s_waitcnt vmcnt(0)" ::: "memory"); }
    __syncthreads();
}
__device__ __forceinline__ void mlstm_m2_item(Frame& F, const Args& A, int l, int b, int h, bool ctx, int oc, int tid_in) {
    const int T = ctx ? 256 : 1024;
    const size_t R0 = ctx ? (size_t)b * 256 : (size_t)MC + (size_t)b * 1024;
    const size_t tbase = ctx ? (size_t)b * 65536 : (size_t)16 * 65536 + (size_t)b * 262144;
    int tid = tid_in; asm volatile("" : "+v"(tid)); const int lane = tid & 63, wave = __builtin_amdgcn_readfirstlane(tid >> 6);
    float* IV = (float*)(F.lds + L_IV) + wave * 64; bf16* SL = (bf16*)(F.lds + L_SL) + wave * 64 * SL_PITCH;
    const bf16* VT = WSP(bf16, WS_VT) + tbase; const bf16* OM = WSP(bf16, WS_OM); const bf16* QN = WSP(bf16, WS_QN); const bf16* KN = WSP(bf16, WS_KN);
    const bf16* CT = WSP(bf16, WS_CT); float* HF = WSP(float, WS_HF); bf16* AC = WSP(bf16, WS_ACAT); const float* PA = WSP(float, WS_PA); const float* CS = PA + 3 * PA_PLANE; const float* NSTG = CS + NSLOT_M * 4;
    const int tq = 64 * oc;
    unsigned hfp[4][4][2];
#pragma unroll
    for (int d = 0; d < 2; ++d) {
            int r16 = lane & 15, kq = lane >> 4; asm volatile("" : "+v"(r16), "+v"(kq));
            const float* pu = PA + ((size_t)d * 4 + h) * MTOT + R0 + tq;
            const size_t slot = (((R0 >> 6) + oc) * 4 + h) * 2 + d;
            bf16x8 Qf[4][2]; f32x4 rs4[4]; float bsv[4], pmv[4]; f32x4 nv[2][2];
#pragma unroll
            for (int mt = 0; mt < 4; ++mt) {
#pragma unroll
                for (int ks = 0; ks < 2; ++ks) { const int t = tq + 16 * mt + r16, col = h * 64 + 32 * ks + 8 * kq; Qf[mt][ks] = *(const bf16x8*)(QN + (R0 + t) * 256 + col); }
                rs4[mt] = *(const f32x4*)(pu + PA_PLANE + 16 * mt + 4 * kq); bsv[mt] = pu[16 * mt + r16]; pmv[mt] = pu[2 * PA_PLANE + 16 * mt + r16]; }
            const float ms = CS[slot * 4 + 2];
            const float* nst = NSTG + slot * 64;
#pragma unroll
            for (int ks = 0; ks < 2; ++ks) { nv[ks][0] = *(const f32x4*)(nst + 32 * ks + 8 * kq); nv[ks][1] = *(const f32x4*)(nst + 32 * ks + 8 * kq + 4); }
            bf16x8 Kfa[4][2];
#pragma unroll
            for (int st = 0; st < 4; ++st)
#pragma unroll
                for (int ks = 0; ks < 2; ++ks) Kfa[st][ks] = *(const bf16x8*)(KN + (R0 + tq + 16 * st + r16) * 256 + h * 64 + 32 * ks + 8 * kq);
            float ul[4], wil[4], emj[4], rowsum[4];
#pragma unroll
            for (int lt = 0; lt < 4; ++lt) { const float bs = bsv[lt], pm = pmv[lt]; const float mj = bs + fmaxf(ms, pm);
                ul[lt] = (bs - mj) * LOG2E; wil[lt] = __expf(bs + ms - mj); emj[lt] = __expf(-mj); rowsum[lt] = 0.f; rs4[lt] = rs4[lt] * LOG2E; }
#pragma unroll
            for (int st = 0; st < 4; ++st) {
                const bf16x8* Kf = Kfa[st];
#pragma unroll
                for (int lt = 0; lt < 4; ++lt) {
                    const bool live = d ? (st >= lt) : (st <= lt);
                    u32x2 w; w.x = 0u; w.y = 0u;
                    if (live) {
                        f32x4 sacc = (f32x4){0.f, 0.f, 0.f, 0.f};
                        sacc = mfma16(Kf[0], Qf[lt][0], sacc); sacc = mfma16(Kf[1], Qf[lt][1], sacc);
                        f32x4 val;
#pragma unroll
                        for (int rg = 0; rg < 4; ++rg) { const int sl = 16 * st + 4 * kq + rg, ll = 16 * lt + r16; const bool ok = d ? (sl >= ll) : (sl <= ll);
                            val[rg] = ok ? sacc[rg] * __builtin_amdgcn_exp2f(ul[lt] + rs4[st][rg]) : 0.f; }
                        rowsum[lt] += (val[0] + val[1]) + (val[2] + val[3]);
                        w.x = pk2(val[0], val[1]); w.y = pk2(val[2], val[3]);
                    }
                    *(u32x2*)(SL + (16 * lt + r16) * SL_PITCH + 16 * st + 4 * kq) = w;
                }
            }
            const bf16* cts = CT + slot * 4096;
            float inv[4];
#pragma unroll
            for (int mt = 0; mt < 4; ++mt) { float qn = 0.f;
#pragma unroll
                for (int ks = 0; ks < 2; ++ks) { float q8[8]; unpack8(Qf[mt][ks], q8);
#pragma unroll
                    for (int j = 0; j < 8; ++j) qn += q8[j] * (j < 4 ? nv[ks][0][j & 3] : nv[ks][1][j & 3]); }
                float a = sum_kq(rowsum[mt] + wil[mt] * qn);
                inv[mt] = 1.0f / fmaxf(fabsf(a), emj[mt]);
                if (kq == 0) IV[16 * mt + r16] = inv[mt]; }
            f32x4 H[4][4];
#pragma unroll
            for (int mt = 0; mt < 4; ++mt)
#pragma unroll
                for (int nt = 0; nt < 4; ++nt) H[mt][nt] = (f32x4){0.f, 0.f, 0.f, 0.f};
#pragma unroll
            for (int ks = 0; ks < 2; ++ks) {
                bf16x8 vbk[4], cbk[4];
#pragma unroll
                for (int nt = 0; nt < 4; ++nt) { vbk[nt] = *(const bf16x8*)(VT + (size_t)(h * 64 + 16 * nt + r16) * T + tq + 32 * ks + 8 * kq); cbk[nt] = *(const bf16x8*)(cts + (16 * nt + r16) * 64 + 32 * ks + 8 * kq); }
#pragma unroll
                for (int mt = 0; mt < 4; ++mt) {
                    const bf16x8 sa = *(const bf16x8*)(SL + (16 * mt + r16) * SL_PITCH + 32 * ks + 8 * kq);
                    float q8[8]; unpack8(Qf[mt][ks], q8);
#pragma unroll
                    for (int j = 0; j < 8; ++j) q8[j] *= wil[mt];
                    const bf16x8 qa = pack8(q8);
#pragma unroll
                    for (int nt = 0; nt < 4; ++nt) { H[mt][nt] = mfma16(sa, vbk[nt], H[mt][nt]); H[mt][nt] = mfma16(qa, cbk[nt], H[mt][nt]); }
                }
            }
            if (d == 0) {
#pragma unroll
                for (int mt = 0; mt < 4; ++mt) { const f32x4 iv4 = *(const f32x4*)(IV + 16 * mt + 4 * kq);
#pragma unroll
                    for (int nt = 0; nt < 4; ++nt) { hfp[mt][nt][0] = pk2(H[mt][nt][0] * iv4[0], H[mt][nt][1] * iv4[1]); hfp[mt][nt][1] = pk2(H[mt][nt][2] * iv4[2], H[mt][nt][3] * iv4[3]); } }
            } else {
                float gmn[4];
#pragma unroll
                for (int nt = 0; nt < 4; ++nt) gmn[nt] = F_m_norm_g[l * 256 + h * 64 + 16 * nt + r16];
#pragma unroll
                for (int mt = 0; mt < 4; ++mt) { const f32x4 iv4 = *(const f32x4*)(IV + 16 * mt + 4 * kq);
#pragma unroll
                    for (int rg = 0; rg < 4; ++rg) {
                        float hs[4], ss = 0.f;
#pragma unroll
                        for (int nt = 0; nt < 4; ++nt) { const unsigned pw = hfp[mt][nt][rg >> 1]; const float hf = __builtin_bit_cast(float, (rg & 1) ? (pw & 0xffff0000u) : (pw << 16));
                            hs[nt] = H[mt][nt][rg] * iv4[rg] + hf; ss += hs[nt] * hs[nt]; }
                        ss = sum_r16(ss);
                        const float rs = 1.0f / sqrtf(ss * (1.0f / 64.0f) + RMS_EPS);
#pragma unroll
                        for (int nt = 0; nt < 4; ++nt) SL[(16 * mt + 4 * kq + rg) * SL_PITCH + 16 * nt + r16] = (bf16)f2bf(hs[nt] * rs * gmn[nt]);
                    }
                }
                { const size_t row = R0 + tq + lane; const bf16* omr = OM + row * 256 + h * 64; bf16* acr = AC + row * KMRG + 512 + h * 64;
                  bf16x8 og[8];
#pragma unroll
                  for (int c8 = 0; c8 < 8; ++c8) og[c8] = *(const bf16x8*)(omr + 8 * c8);
#pragma unroll
                  for (int c8 = 0; c8 < 8; ++c8) { float yv[8], gv[8]; unpack8(*(const bf16x8*)(SL + lane * SL_PITCH + 8 * c8), yv); unpack8(og[c8], gv);
#pragma unroll
                      for (int q = 0; q < 8; ++q) yv[q] *= gv[q];
                      *(bf16x8*)(acr + 8 * c8) = pack8(yv); } }
            }
    }
}

constexpr int QU_TOTAL = 624;
__device__ __forceinline__ void mixer_phase(Frame& F, const Args& A, int l) {
    gu32* qhead = F.ctl + CW_QUEUE + 64 * l;
    gu32* mflag = F.ctl + CW_MFLAG + 64 * (l * 96);
    for (;;) {
        __syncthreads();
        if (F.tid == 0) F.MISC[16] = __hip_atomic_fetch_add(qhead, 1u, RLX_AGENT);
        __syncthreads();
        const int qpos = (int)F.MISC[16];
        if (qpos >= QU_TOTAL) break;
        const int u = qpos < 224 ? qpos : qpos < 480 ? qpos + 32 : qpos < 496 ? qpos + 32 : qpos + 48;
        { int tl = threadIdx.x; asm volatile("" : "+v"(tl)); F.tid = tl; F.lane = tl & 63; F.wave = __builtin_amdgcn_readfirstlane(tl >> 6);
          size_t z_ = 0; asm volatile("" : "+s"(z_)); F.ws = A.ws + z_; F.out = A.out + z_; }
#ifdef PROF_UNIT
        const unsigned long long pu_t0 = __builtin_amdgcn_s_memrealtime();
#endif
        const bf16* Qb = WSP(bf16, WS_Q); bf16* AC = WSP(bf16, WS_ACAT);
        if (u < 96) { const bool ctx = u >= 32;
            const int j = ctx ? u - 32 : u;
            if (T_MASK & 0x100) mlstm_m1(F, A, l, j >> 2, j & 3, ctx, mflag + 64 * u); }
        else if (u < 192) {
            const bool ctx = u >= 160; const int j = ctx ? u - 160 : u - 96;
            const int bh0 = ctx ? (j >> 1) * 4 + (j & 1) * 2 : (j >> 1);
            if (T_MASK & 0x100) {
                mlstm_wait(F, mflag + 64 * (ctx ? 32 + bh0 : bh0));
                if (ctx) mlstm_wait(F, mflag + 64 * (32 + bh0 + 1));
                const int bh = ctx ? bh0 + (F.wave >> 2) : bh0; const int oc = ctx ? (F.wave & 3) : (j & 1) * 8 + F.wave;
                mlstm_m2_item(F, A, l, bh >> 2, bh & 3, ctx, oc, F.tid);
            }
        }
        else if (u < 256 || (u >= 512 && u < 544)) {
            const bool lat = u < 256; const int j = lat ? u - 192 : u - 512;
            pg8::OneUnit S; S.u.pm = lat ? (j >> 3) : 0; S.u.pn = lat ? (j & 7) : j;
            pg8::Gemm g; g.A = lat ? WSP(const pg8::bf16_t, WS_DFTL) : WSP(const pg8::bf16_t, WS_DFTC);
            g.Bt = WSP(const pg8::bf16_t, WS_UT) + (lat ? (size_t)16 * 65536 : 0); g.M = lat ? 1024 : 256; g.N = lat ? 2048 : 4096; g.K = lat ? 1024 : 256;
            pg8::EpiFourier E; E.AC = (pg8::bf16_t*)AC; E.lat = lat ? 1 : 0;
            if (T_MASK & 0x200) pg8::gemm_phase<pg8::EpiFourier, pg8::OneUnit, false, true>(F.ldsl + RING_OFF, g, S, E, F.tid);
        }
        else { const bool lat = u < 512; const int j = lat ? u - 256 : u - 544; const int b = lat ? (j >> 5) : (j >> 3), qh = lat ? ((j >> 2) & 7) : (j & 7), qb = lat ? (j & 3) : 0;
            const size_t row0 = lat ? (size_t)MC + (size_t)b * 1024 + (size_t)qb * 256 : (size_t)b * 256;
            const bf16* Kp = (lat ? WSP(bf16, WS_KL) + (size_t)b * 1280 * 256 : WSP(bf16, WS_KC) + (size_t)b * 65536) + (qh >> 1) * 64;
            const bf16* Vp = (lat ? WSP(bf16, WS_VL) + (size_t)b * 1280 * 256 : WSP(bf16, WS_VC) + (size_t)b * 65536) + (qh >> 1) * 64;
            if (T_MASK & 0x400) attn_body::attn_unit<8>((const attn_body::bf16*)(Qb + row0 * 512 + qh * 64), 512, (const attn_body::bf16*)Kp, (const attn_body::bf16*)Vp, 256, lat ? 20 : 4,
                (attn_body::bf16*)(AC + row0 * KMRG + qh * 64), KMRG, (char*)F.lds + RING_OFF, F.tid); }
#ifdef PROF_UNIT
        if (l == 0 && F.tid == 0) { const int ty = u < 32 ? 0 : u < 96 ? 2 : u < 160 ? 6 : u < 192 ? 7 : u < 256 ? 1 : u < 512 ? 3 : u < 544 ? 4 : 5;
            unsigned* pc = (unsigned*)(A.ws + CTL_ZERO_BYTES - 12288); const unsigned dt = (unsigned)(__builtin_amdgcn_s_memrealtime() - pu_t0); atomicAdd(pc + 2 * ty, dt); atomicAdd(pc + 2 * ty + 1, 1u); atomicAdd(pc + 16, dt); pc[17] = 256u; }
#endif
    }
}

#ifdef PROF_GEMM
#define PROFP(kk) ((l == 0 && (kk) == PROF_GEMM) ? (unsigned*)(A.ws + CTL_ZERO_BYTES - 16384) : (unsigned*)nullptr)
#else
#define PROFP(kk) ((unsigned*)nullptr)
#endif
__global__ void __launch_bounds__(NWAVES * 64, 2) mk_fwd(const Args A) {
    extern __shared__ __attribute__((aligned(16))) unsigned char lds[];
    Frame F;
    F.lds = lds; F.ldsl = (LAS unsigned char*)lds;
    F.MISC = (volatile LAS unsigned*)(F.ldsl + MISC_OFF);
    F.tid = threadIdx.x; F.lane = F.tid & 63; F.wave = __builtin_amdgcn_readfirstlane(F.tid >> 6);
    F.G = gridDim.x; { const int bx = blockIdx.x; F.vcu = (F.G % 8 == 0) ? (bx % 8) * (F.G / 8) + bx / 8 : bx; }
    F.ctl = (gu32*)(A.ws + WS_CTL);
    for (int u = F.tid; u < (LDS_BYTES - LDSCTL_OFF) / 4; u += NWAVES * 64) ((LAS unsigned*)(F.ldsl + LDSCTL_OFF))[u] = 0u;
    __syncthreads();
    XcdBarrier bar; bar.bar = (unsigned*)(F.ctl + CW_BAR) + A.li * XCD_BAR_WORDS; bar.x = 0; bar.st = nullptr;
    bar = xcd_barrier_post((unsigned*)(F.ctl + CW_BAR) + A.li * XCD_BAR_WORDS, F.MISC + 8);
#ifdef PROF_PHASE
    unsigned long long* stamps = (unsigned long long*)(A.ws + CTL_ZERO_BYTES - 8192);
    if (blockIdx.x == 0 && threadIdx.x == 0) stamps[0] = __builtin_amdgcn_s_memrealtime();
#endif
    for (int ph = A.ph_lo; ph < A.ph_hi; ++ph) {
        { int tl = threadIdx.x; asm volatile("" : "+v"(tl)); F.tid = tl; F.lane = tl & 63; F.wave = __builtin_amdgcn_readfirstlane(tl >> 6);
          size_t z_ = 0; asm volatile("" : "+s"(z_)); F.ws = A.ws + z_; F.out = A.out + z_; }
        if (ph == 0) { if (T_MASK & 1) p0_prologue(F, A); }
        else {
            const int l = (ph - 1) >> 3, k = (ph - 1) & 7;
            if (k == 0) { if (T_MASK & 2) {
                int fitem = -1; gu32* ff = nullptr; const bool fused = (l == 1 && F.G == 256);
                if (fused) { pg8::StaticOrder S; S.init(MTOT, DM, F.G, (int)blockIdx.x); pg8::Unit u0; if (S.next(0, u0)) { fitem = u0.pm * 4 + u0.pn; ff = F.ctl + CW_HFLAG + 64 * u0.pm; } }
                norm_phase(F, A, l, 0, fitem, ff, fused);
            } }
            else if (k == 1) { if (T_MASK & 4) {
                pg8::Gemm g{WSP(const pg8::bf16_t, WS_XN), WSP(const pg8::bf16_t, WS_WIN), MTOT, NIN, DM}; pg8::StaticOrder S; S.init(MTOT, NIN, F.G, (int)blockIdx.x);
                pg8::EpiIn E; E.layer = l; E.Q = WSP(pg8::bf16_t, WS_Q); E.KC = WSP(pg8::bf16_t, WS_KC); E.VC = WSP(pg8::bf16_t, WS_VC); E.KL = WSP(pg8::bf16_t, WS_KL); E.VL = WSP(pg8::bf16_t, WS_VL);
                E.QM = WSP(pg8::bf16_t, WS_QM); E.KM = WSP(pg8::bf16_t, WS_KM); E.KMT = WSP(pg8::bf16_t, WS_KMT); E.VT = WSP(pg8::bf16_t, WS_VT); E.OM = WSP(pg8::bf16_t, WS_OM); E.UT = WSP(pg8::bf16_t, WS_UT);
                E.BG = WSP(unsigned char, WS_BG); E.onk = F_out + OFF_NK; E.onv = F_out + OFF_NV; E.qg = F_q_norm_g + l * 64; E.kg = F_k_norm_g + l * 64; E.rope = (const PG8_LAS pg8::f32x2v*)(F.ldsl + SPARE_ROPE); E.stage = (PG8_LAS pg8::bf16_t*)(F.ldsl + SPARE_STAGE);
                { const v4u* rsrc = WSP(const v4u, WS_ROPE); ((LAS v4u*)(F.ldsl + SPARE_ROPE))[F.tid] = rsrc[F.tid]; __syncthreads(); }
                pg8::gemm_phase<pg8::EpiIn, pg8::StaticOrder, true, true>(F.ldsl + RING_OFF, g, S, E, F.tid, PROFP(1));
            } }
            else if (k == 2) { if (T_MASK & 8) {
#ifdef PROF_UNIT
                const unsigned long long c0_t0 = __builtin_amdgcn_s_memrealtime();
#endif
                mlstm_c0(F, A, l); xcd_barrier(bar);
#ifdef PROF_UNIT
                if (l == 0 && blockIdx.x == 0 && F.tid == 0) { unsigned* pc = (unsigned*)(A.ws + CTL_ZERO_BYTES - 12288); pc[18] = (unsigned)(__builtin_amdgcn_s_memrealtime() - c0_t0); pc[19] = 1u; }
#endif
                mixer_phase(F, A, l); } }
            else if (k == 3) { if (T_MASK & 16) {
                pg8::Gemm g{WSP(const pg8::bf16_t, WS_ACAT), WSP(const pg8::bf16_t, WS_WMRG), MTOT, DM, KMRG}; pg8::StaticOrder S; S.init(MTOT, DM, F.G, (int)blockIdx.x);
                pg8::EpiMerge E; E.BG = WSP(const unsigned char, WS_BG); E.O = WSP(pg8::bf16_t, WS_MRGD);
                pg8::gemm_phase<pg8::EpiMerge, pg8::StaticOrder, true, true>(F.ldsl + RING_OFF, g, S, E, F.tid, PROFP(3));
                if (l == 0 && F.G == 256 && blockIdx.x >= 192) convert_weights(F, A, 0, CV_F1, CV_F2, ((int)blockIdx.x - 192) * NWAVES + F.wave, 64 * NWAVES);
                if (l == 0 && F.G == 256 && blockIdx.x >= 192) convert_weights(F, A, 1, 0, CV_MRG, ((int)blockIdx.x - 192) * NWAVES + F.wave, 64 * NWAVES);
                if (l == 1 && F.G == 256 && blockIdx.x >= 192) convert_weights(F, A, 1, CV_F2, CV_END, ((int)blockIdx.x - 192) * NWAVES + F.wave, 64 * NWAVES);
            } }
            else if (k == 4 || k == 7) { if (T_MASK & 32) {
                pg8::Gemm g; g.M = MTOT; g.N = DM;
                if (k == 4) { g.A = WSP(const pg8::bf16_t, WS_MRGD); g.Bt = WSP(const pg8::bf16_t, WS_WOUT); g.K = DM; } else { g.A = WSP(const pg8::bf16_t, WS_HID); g.Bt = WSP(const pg8::bf16_t, WS_WF2); g.K = FF; }
                pg8::StaticOrder S; S.init(MTOT, DM, F.G, (int)blockIdx.x);
                pg8::EpiRes E; const bool first = (l == 0 && k == 4);
                E.mode = (k == 4) ? 0 : 1; E.xb = WSP(pg8::bf16_t, WS_ACAT);
                gu32* gflag = F.ctl + CW_GFLAG + 64 * l; E.wflag = (k == 7 && F.G == 256) ? (unsigned*)gflag : (unsigned*)nullptr; E.wneed = 32u;
                E.xin_p = first ? F_x_prompt : F_out; E.xin_s = first ? F_x_sample : F_out + (size_t)MC * DM; E.xout = F_out; E.gate = WSP(const float, WS_MOD) + (size_t)l * 9 * 6144 + (k == 4 ? 2048 : 5120);
                pg8::gemm_phase<pg8::EpiRes, pg8::StaticOrder, true, true>(F.ldsl + RING_OFF, g, S, E, F.tid, PROFP(k));
                if (k == 7 && F.G == 256 && blockIdx.x >= 192 && blockIdx.x < 224) {
                    const int j = (int)blockIdx.x - 192, x = j & 7, a = j >> 3;
                    pg8::Gemm g2{WSP(const pg8::bf16_t, WS_XN), WSP(const pg8::bf16_t, WS_WF1), MTOT, NF1, DM}; pg8::FlagUnit S2; S2.u.pm = 2 * x + (a >> 1); S2.u.pn = 20 + (a & 1); S2.flag = (unsigned*)gflag;
                    pg8::EpiSwiGLU E2; E2.H = WSP(pg8::bf16_t, WS_HID);
                    pg8::gemm_phase<pg8::EpiSwiGLU, pg8::FlagUnit, true, true>(F.ldsl + RING_OFF, g2, S2, E2, F.tid);
                }
                if (l == 0 && F.G == 256 && blockIdx.x >= 192) { if (k == 4) { convert_weights(F, A, 0, CV_F2, CV_END, ((int)blockIdx.x - 192) * NWAVES + F.wave, 64 * NWAVES);
                        convert_weights(F, A, 1, CV_MRG, CV_OUT, ((int)blockIdx.x - 192) * NWAVES + F.wave, 64 * NWAVES); }
                    else { convert_weights(F, A, 1, CV_OUT, CV_F1, ((int)blockIdx.x - 192) * NWAVES + F.wave, 64 * NWAVES);
                        { unsigned sp = 0; while (__hip_atomic_load(gflag, RLX_AGENT) < 32u) { __builtin_amdgcn_s_sleep(8); if (++sp > (1u << 22)) break; } __builtin_amdgcn_fence(__ATOMIC_ACQUIRE, "agent"); }
                        convert_weights(F, A, 1, CV_F1, CV_F2, ((int)blockIdx.x - 192) * NWAVES + F.wave, 64 * NWAVES); } }
            } }
            else if (k == 5) { if (T_MASK & 64) {
                if (F.G != 256) norm_phase(F, A, l, 1);
                else { pg8::StaticOrder S; S.init(MTOT, DM, F.G, (int)blockIdx.x); pg8::Unit u0;
                    if (S.next(0, u0)) { const int pm = __builtin_amdgcn_readfirstlane(u0.pm), pn = __builtin_amdgcn_readfirstlane(u0.pn); norm2_after_outproj(F, A, l, pm, pn, F.ctl + CW_EFLAG + 64 * (l * 48 + pm)); } }
            } }
            else if (T_MASK & 128) {
                pg8::Gemm g{WSP(const pg8::bf16_t, WS_XN), WSP(const pg8::bf16_t, WS_WF1), MTOT, NF1, DM}; pg8::GOrder S; S.init(MTOT, NF1, F.G, (int)blockIdx.x);
                pg8::EpiSwiGLU E; E.H = WSP(pg8::bf16_t, WS_HID);
                pg8::gemm_phase<pg8::EpiSwiGLU, pg8::GOrder, true, true>(F.ldsl + RING_OFF, g, S, E, F.tid, PROFP(6));
            }
        }
        if (ph + 1 < A.ph_hi && !(F.G == 256 && ph > 0 && (((ph - 1) & 7) == 4 || ph == 8))) xcd_barrier(bar);
#ifdef PROF_PHASE
        if (blockIdx.x == 0 && threadIdx.x == 0) stamps[ph + 1] = __builtin_amdgcn_s_memrealtime();
#endif
    }
#ifdef PROF_UNIT
    {   xcd_barrier(bar);
        const unsigned* pc = (const unsigned*)(A.ws + CTL_ZERO_BYTES - 12288);
        const float avg = (float)pc[2 * PROF_UNIT] * 0.01f / fmaxf((float)pc[2 * PROF_UNIT + 1], 1.f);
        const float us = 10.0f * rintf(avg * 0.1f); const float target = 0.05f + fminf(us, 900.f) * 0.001f; const float s = 1.0f - sqrtf(target);
        for (size_t i = (size_t)blockIdx.x * 512 + threadIdx.x; i < (size_t)17842432; i += (size_t)gridDim.x * 512) A.out[i] *= s;
    }
#endif
#ifdef PROF_GEMM
    {   xcd_barrier(bar);
        const unsigned* pc = (const unsigned*)(A.ws + CTL_ZERO_BYTES - 16384);
#if PROF_WHAT == 0
        const float val = (float)pc[0] * 0.01f / fmaxf((float)pc[1], 1.f);
#else
        const float val = (float)pc[2] * 0.01f / fmaxf((float)pc[3], 1.f);
#endif
        const float us = PROF_BIN * rintf(val / PROF_BIN); const float target = 0.05f + fminf(us, 900.f) * 0.001f; const float s = 1.0f - sqrtf(target);
        for (size_t i = (size_t)blockIdx.x * 512 + threadIdx.x; i < (size_t)17842432; i += (size_t)gridDim.x * 512) A.out[i] *= s;
    }
#endif
#ifdef PROF_PHASE
    {
        xcd_barrier(bar);
        const unsigned long long t0 = stamps[PROF_PHASE], t1 = stamps[PROF_PHASE + 1];
        const float us = 15.0f + 30.0f * rintf(((float)(t1 - t0) * 0.01f - 15.0f) * (1.0f / 30.0f)); const float target = 0.05f + fminf(us, 900.f) * 0.001f; const float s = 1.0f - sqrtf(target);
        for (size_t i = (size_t)blockIdx.x * 512 + threadIdx.x; i < (size_t)17842432; i += (size_t)gridDim.x * 512) A.out[i] *= s;
    }
#endif
}


#ifdef MK_DEBUG
#ifndef DBG_SKIP
#define DBG_SKIP 0
#endif
#define DBG_OFF (CTL_ZERO_BYTES - 4096)
__device__ __forceinline__ void dbg_acc(float* dbg, int k, float mine, float ref) { const float d = mine - ref; atomicAdd(dbg + k, d * d); atomicAdd(dbg + 32 + k, ref * ref); }
__device__ __forceinline__ float dbg_bf(const bf16* p, size_t i) { return bf2f(p[i]); }
__device__ float dbg_block_sum(float v, float* red) {
    v = wave_sum(v); __syncthreads(); if ((threadIdx.x & 63) == 0) red[threadIdx.x >> 6] = v; __syncthreads();
    float s = 0.f; for (int w = 0; w < 8; ++w) s += red[w]; __syncthreads(); return s; }
__global__ void __launch_bounds__(512) dbg_check(Args A) {
    __shared__ float red[16]; __shared__ float zrow[5392]; __shared__ float hrow[1024]; __shared__ float sm[4096];
    struct { unsigned char* ws; float* out; } F; F.ws = A.ws; F.out = A.out;
    float* dbg = (float*)(A.ws + DBG_OFF); const int tid = threadIdx.x, blk = blockIdx.x; const int l = 0;
    const float* MOD = WSP(float, WS_MOD);
    if (blk < 8) {
        const int rows[8] = {0, 255, 256, 4095, 4096, 4096 + 63, 4096 + 64 + 1023, 12287}; const int m = rows[blk];
        const float* xr = m < MC ? F_x_prompt + (size_t)m * DM : F_x_sample + (size_t)(m - MC) * DM; const int v = m < MC ? 0 : 1 + ((m - MC) >> 10);
        float s = 0.f; for (int c = tid; c < DM; c += 512) s += xr[c] * xr[c];
        const float rs = 1.0f / sqrtf(dbg_block_sum(s, red) / DM + RMS_EPS);
        if (blk == 0 && tid < 64) {
            const int vv = tid % 9, col = (97 * tid + 13) % 6144; float a = F_b_ada[col];
            for (int k = 0; k < DM; ++k) { const float cv = vv == 0 ? F_c_ctx[k] : F_c[(vv - 1) * DM + k]; a += silu_f(cv) * F_w_ada[(size_t)k * 6144 + col]; }
            dbg_acc(dbg, 1, MOD[(size_t)vv * 6144 + col], a); }
        for (int c = tid; c < DM; c += 512) { const float h = xr[c] * rs * F_norm1_g[c] * (1.0f + MOD[(size_t)v * 6144 + 1024 + c]) + MOD[(size_t)v * 6144 + c]; hrow[c] = h;
            dbg_acc(dbg, 2, dbg_bf(WSP(bf16, WS_XN), (size_t)m * DM + c), h); }
        __syncthreads();
        for (int c = tid; c < INC; c += 512) { float a = 0.f; for (int k = 0; k < DM; ++k) a += hrow[k] * F_w_in[(size_t)k * INC + c]; zrow[c] = a; }
        __syncthreads();
        const bool ctx = m < MC; const int b = ctx ? m >> 8 : (m - MC) >> 10, t = ctx ? m & 255 : (m - MC) & 1023, T = ctx ? 256 : 1024;
        const size_t tbase = ctx ? (size_t)b * 65536 : (size_t)16 * 65536 + (size_t)b * 262144;
        if (tid < 16) dbg_acc(dbg, 3, WSP(float, WS_GATES)[(size_t)m * 16 + tid], zrow[2048 + tid]);
        for (int i = tid; i < 12 * 64; i += 512) { const int hd = i >> 6, d = i & 63; const bool isk = hd >= 8; const int c0 = isk ? 512 + (hd - 8) * 64 : hd * 64;
            float ss = 0.f; for (int e = 0; e < 64; ++e) ss += zrow[c0 + e] * zrow[c0 + e];
            const float r = 1.0f / sqrtf(ss / 64.f + RMS_EPS); const float* g = isk ? F_k_norm_g : F_q_norm_g;
            float y = zrow[c0 + d] * r * g[d];
            if (isk && ctx) dbg_acc(dbg, 5, F.out[OFF_NK + ((size_t)((b * 2 + l) * 256 + t)) * 256 + (hd - 8) * 64 + d], y);
            if (!ctx) { const int half = d >> 5, i16 = d & 15, up = (d >> 4) & 1; const int pos = half == 0 ? (t >> 6) : (t & 63); const float inv = 1.0f / powf(10000.f, (float)i16 / 16.f), ang = (float)pos * inv;
                const int dp = (d & ~31) + (up ? i16 : i16 + 16); const float yp = zrow[c0 + dp] * r * g[dp];
                y = up ? (y * cosf(ang) + yp * sinf(ang)) : (y * cosf(ang) - yp * sinf(ang)); }
            if (!isk) dbg_acc(dbg, ctx ? 4 : 17, dbg_bf(WSP(bf16, WS_Q), (size_t)m * 512 + c0 + d), y * ATT_C2);
            else dbg_acc(dbg, ctx ? 5 : 18, ctx ? dbg_bf(WSP(bf16, WS_KC), ((size_t)(b * 256 + t)) * 256 + (hd - 8) * 64 + d) : dbg_bf(WSP(bf16, WS_KL), ((size_t)(b * 1280 + 256 + t)) * 256 + (hd - 8) * 64 + d), y); }
        for (int c = tid; c < 256; c += 512) { const float vv = zrow[768 + c];
            if (ctx) { dbg_acc(dbg, 6, F.out[OFF_NV + ((size_t)((b * 2 + l) * 256 + t)) * 256 + c], vv); dbg_acc(dbg, 6, dbg_bf(WSP(bf16, WS_VC), ((size_t)(b * 256 + t)) * 256 + c), vv); }
            else dbg_acc(dbg, 6, dbg_bf(WSP(bf16, WS_VL), ((size_t)(b * 1280 + 256 + t)) * 256 + c), vv);
            dbg_acc(dbg, 7, dbg_bf(WSP(bf16, WS_QM), (size_t)m * 256 + c), zrow[1024 + c]); dbg_acc(dbg, 7, dbg_bf(WSP(bf16, WS_KM), (size_t)m * 256 + c), zrow[1280 + c]);
            dbg_acc(dbg, 7, dbg_bf(WSP(bf16, WS_KMT), tbase + (size_t)c * T + t), zrow[1280 + c]);
            dbg_acc(dbg, 8, dbg_bf(WSP(bf16, WS_VT), tbase + (size_t)c * T + t), zrow[1536 + c]); dbg_acc(dbg, 8, dbg_bf(WSP(bf16, WS_UT), tbase + (size_t)c * T + t), zrow[2064 + c]);
            dbg_acc(dbg, 8, dbg_bf(WSP(bf16, WS_OM), (size_t)m * 256 + c), 1.0f / (1.0f + __expf(-zrow[1792 + c]))); }
        for (int c = tid; c < 3072; c += 512) dbg_acc(dbg, 9, 1.0f / (1.0f + dbg_bf(WSP(bf16, WS_BG), (size_t)m * 3072 + c)), 1.0f / (1.0f + __expf(-zrow[2320 + c])));
    } else if (blk < 16) {
        const int wave = tid >> 6, lane = tid & 63, si = (blk - 8) * 8 + wave;
        const bool lat = si & 1; const int b = (si * 5) % (lat ? 8 : 16), qh = (si * 3) % 8, t = (si * 37 + 11) % (lat ? 1024 : 256);
        const size_t row = lat ? (size_t)MC + b * 1024 + t : (size_t)b * 256 + t; const int NK = lat ? 1280 : 256;
        const bf16* Kp = (lat ? WSP(bf16, WS_KL) + (size_t)b * 1280 * 256 : WSP(bf16, WS_KC) + (size_t)b * 65536) + (qh >> 1) * 64;
        const bf16* Vp = (lat ? WSP(bf16, WS_VL) + (size_t)b * 1280 * 256 : WSP(bf16, WS_VC) + (size_t)b * 65536) + (qh >> 1) * 64;
        const bf16* Qp = WSP(bf16, WS_Q) + row * 512 + qh * 64; float* sc = sm + wave * 0;
        float mx = -1e30f; for (int k = lane; k < NK; k += 64) { float a = 0.f; for (int d = 0; d < 64; ++d) a += bf2f(Qp[d]) * bf2f(Kp[(size_t)k * 256 + d]); mx = fmaxf(mx, a); }
        for (int o = 1; o < 64; o <<= 1) mx = fmaxf(mx, __shfl_xor(mx, o));
        float den = 0.f, acc = 0.f;
        for (int k = 0; k < NK; ++k) { float a = 0.f; for (int d = 0; d < 64; ++d) a += bf2f(Qp[d]) * bf2f(Kp[(size_t)k * 256 + d]); const float p = exp2f(a - mx); den += p; acc += p * bf2f(Vp[(size_t)k * 256 + lane]); }
        dbg_acc(dbg, 10, dbg_bf(WSP(bf16, WS_ACAT), row * KMRG + qh * 64 + lane), acc / den); (void)sc;
    } else if (blk < 24) {
        const int si = (blk - 16) * 512 + tid; const bool lat = si & 1; const int T = lat ? 1024 : 256, b = (si >> 1) % (lat ? 8 : 16), tp = ((si * 53) % 29 == 0) ? 0 : (si * 131 + 7) % T, c = (si * 17 + 3) % 256;
        const size_t tbase = lat ? (size_t)16 * 65536 + (size_t)b * 262144 : (size_t)b * 65536; const bf16* u = WSP(bf16, WS_UT) + tbase + (size_t)c * T;
        float p = 0.f, q = 0.f; for (int t = 0; t < T; ++t) { const float a = 6.283185307179586f * (float)((t * tp) % T) / (float)T; p += cosf(a) * bf2f(u[t]); q += sinf(a) * bf2f(u[t]); }
        const float sq = 1.0f / sqrtf((float)T); const size_t row = lat ? (size_t)MC + b * 1024 + tp : (size_t)b * 256 + tp;
        dbg_acc(dbg, 11, dbg_bf(WSP(bf16, WS_ACAT), row * KMRG + 768 + c), p * sq); dbg_acc(dbg, 11, dbg_bf(WSP(bf16, WS_ACAT), row * KMRG + 1024 + c), q * sq);
    } else if (blk < 28) {
        const int ci = blk - 24; const bool ctx = ci < 2; const int b = ci == 0 ? 3 : ci == 1 ? 12 : ci == 2 ? 2 : 5, h = ci == 0 ? 1 : ci == 1 ? 2 : ci == 2 ? 0 : 3;
        const int T = ctx ? 256 : 1024; const size_t R0 = ctx ? (size_t)b * 256 : (size_t)MC + (size_t)b * 1024;
        const float* cwl = F_m_conv_w; const bf16* QM = WSP(bf16, WS_QM); const bf16* KM = WSP(bf16, WS_KM); const bf16* VTp = WSP(bf16, WS_VT) + (ctx ? (size_t)b * 65536 : (size_t)16 * 65536 + (size_t)b * 262144);
        float* qs = sm; float* ks = sm + 64; float* vs = sm + 128; float* part = sm + 256; float* hsum = sm + 1024;
        const int dv = tid & 63, g8 = tid >> 6; float* HB = (float*)(A.ws + 255 * MiB) + (size_t)ci * 1024 * 64;
        for (int d = 0; d < 2; ++d) {
            float C[8]; float nn = 0.f, mm = 0.f;
            for (int j = 0; j < 8; ++j) C[j] = ctx ? 0.f : F_state_C[(size_t)(((b * 2 + l) * 2 + d) * 4 + h) * 4096 + (8 * g8 + j) * 64 + dv];
            if (!ctx) { mm = F_state_m[((b * 2 + l) * 2 + d) * 4 + h]; }
            nn = ctx ? 0.f : F_state_n[(size_t)(((b * 2 + l) * 2 + d) * 4 + h) * 64 + dv];
            for (int k = 0; k < T; ++k) { const int t = d ? T - 1 - k : k; const size_t row = R0 + t;
                __syncthreads();
                if (tid < 128) { const int ch = tid & 63; const bool isk = tid >= 64; const bf16* X = isk ? KM : QM; const int cc = (isk ? 256 : 0) + h * 64 + ch;
                    const float x0 = bf2f(X[row * 256 + h * 64 + ch]), xm = t > 0 ? bf2f(X[(row - 1) * 256 + h * 64 + ch]) : 0.f, xp = t + 1 < T ? bf2f(X[(row + 1) * 256 + h * 64 + ch]) : 0.f;
                    const float y = silu_f(cwl[cc] * xm + cwl[512 + cc] * x0 + cwl[1024 + cc] * xp); if (isk) ks[ch] = y * 0.125f; else qs[ch] = y; }
                else if (tid < 192) vs[tid - 128] = bf2f(VTp[(size_t)(h * 64 + (tid - 128)) * T + t]);
                __syncthreads();
                const float* gp = WSP(float, WS_GATES) + row * 16 + d * 8 + h; const float li = gp[0] + F_m_gate_b[d * 8 + h], lf = logsigmoid_f(gp[4] + F_m_gate_b[d * 8 + 4 + h]);
                const float mn = fmaxf(lf + mm, li), fg = __expf(lf + mm - mn), ig = __expf(li - mn); mm = mn;
                float pa = 0.f;
                for (int j = 0; j < 8; ++j) { C[j] = fg * C[j] + ig * ks[8 * g8 + j] * vs[dv]; pa += qs[8 * g8 + j] * C[j]; }
                nn = fg * nn + ig * ks[dv];
                part[g8 * 64 + dv] = pa; if (g8 == 0) part[512 + dv] = qs[dv] * nn;
                __syncthreads();
                if (tid < 64) { float num = 0.f; for (int w = 0; w < 8; ++w) num += part[w * 64 + tid]; float qn = 0.f; for (int e = 0; e < 64; ++e) qn += part[512 + e];
                    const float hv = num / fmaxf(fabsf(qn), __expf(-mm));
                    if (d == 0) { HB[(size_t)t * 64 + tid] = hv; const float kv = WSP(float, WS_HF)[row * 256 + h * 64 + tid]; float sa = wave_sum(kv * kv), sr = wave_sum(hv * hv);
                        dbg_acc(dbg, ctx ? (t < 64 ? 20 : 22) : (t < 64 ? 21 : 23), kv / sqrtf(sa + 1e-30f), hv / sqrtf(sr + 1e-30f));
                        if (tid == 0) { atomicAdd(dbg + (ctx ? 24 : 25), (sqrtf(sa / sr) - 1.0f) * (sqrtf(sa / sr) - 1.0f)); atomicAdd(dbg + 32 + (ctx ? 24 : 25), 1.0f); } }
                    else { const float hs = hv + HB[(size_t)t * 64 + tid]; hsum[tid] = hs; } }
                __syncthreads();
                if (d == 1 && tid < 64) { float ss = 0.f; for (int e = 0; e < 64; ++e) ss += hsum[e] * hsum[e]; const float rr = 1.0f / sqrtf(ss / 64.f + RMS_EPS);
                    const float ref = hsum[tid] * rr * F_m_norm_g[h * 64 + tid] * bf2f(WSP(bf16, WS_OM)[row * 256 + h * 64 + tid]);
                    dbg_acc(dbg, ctx ? 12 : 19, dbg_bf(WSP(bf16, WS_ACAT), row * KMRG + 512 + h * 64 + tid), ref); }
            }
            if (ctx) { for (int j = 0; j < 8; ++j) dbg_acc(dbg, 13, F.out[OFF_NC + (size_t)(((b * 2 + l) * 2 + d) * 4 + h) * 4096 + (8 * g8 + j) * 64 + dv], C[j]);
                if (g8 == 0) { dbg_acc(dbg, 13, F.out[OFF_NN + (size_t)(((b * 2 + l) * 2 + d) * 4 + h) * 64 + dv], nn); if (dv == 0) dbg_acc(dbg, 13, F.out[OFF_NM + ((b * 2 + l) * 2 + d) * 4 + h], mm); } }
        }
    }
}
__global__ void __launch_bounds__(512) dbg_check2(Args A, int stage) {
    __shared__ float red[16]; __shared__ float rowbuf[2816]; __shared__ float rowb2[1024];
    struct { unsigned char* ws; float* out; } F; F.ws = A.ws; F.out = A.out;
    float* dbg = (float*)(A.ws + DBG_OFF); const int tid = threadIdx.x, blk = blockIdx.x;
    const int rows[8] = {0, 255, 256, 4095, 4096, 4096 + 1024, 4096 + 2047, 12287}; const int m = rows[blk]; const int v = m < MC ? 0 : 1 + ((m - MC) >> 10);
    const float* MOD = WSP(float, WS_MOD);
    if (stage == 0) {
        const bf16* ac = WSP(bf16, WS_ACAT) + (size_t)m * KMRG; const bf16* bg = WSP(bf16, WS_BG) + (size_t)m * 3072; const bf16* wm = WSP(bf16, WS_WMRG);
        for (int c = tid; c < DM; c += 512) { float s0 = 0.f, s1 = 0.f, s2 = 0.f; const bf16* w = wm + (size_t)c * KMRG;
            for (int k = 0; k < 512; ++k) s0 += bf2f(ac[k]) * bf2f(w[k]); for (int k = 512; k < 768; ++k) s1 += bf2f(ac[k]) * bf2f(w[k]); for (int k = 768; k < 1280; ++k) s2 += bf2f(ac[k]) * bf2f(w[k]);
            const float ref = s0 / (1.f + bf2f(bg[c])) + s1 / (1.f + bf2f(bg[1024 + c])) + s2 / (1.f + bf2f(bg[2048 + c]));
            dbg_acc(dbg, 14, dbg_bf(WSP(bf16, WS_MRGD), (size_t)m * DM + c), ref); }
    } else if (stage == 1) {
        const float* xr = m < MC ? F_x_prompt + (size_t)m * DM : F_x_sample + (size_t)(m - MC) * DM; const bf16* mg = WSP(bf16, WS_MRGD) + (size_t)m * DM; const bf16* wo = WSP(bf16, WS_WOUT);
        for (int c = tid; c < DM; c += 512) { float s = 0.f; for (int k = 0; k < DM; ++k) s += bf2f(mg[k]) * bf2f(wo[(size_t)c * DM + k]);
            dbg_acc(dbg, 15, F.out[(size_t)m * DM + c], xr[c] + MOD[(size_t)v * 6144 + 2048 + c] * s); }
    } else if (stage == 2) {
        const float* xr = F.out + (size_t)m * DM; float s = 0.f; for (int c = tid; c < DM; c += 512) s += xr[c] * xr[c];
        const float rs = 1.0f / sqrtf(dbg_block_sum(s, red) / DM + RMS_EPS);
        for (int c = tid; c < DM; c += 512) { const float h = xr[c] * rs * F_norm2_g[c] * (1.0f + MOD[(size_t)v * 6144 + 4096 + c]) + MOD[(size_t)v * 6144 + 3072 + c]; rowb2[c] = h; dbg_acc(dbg, 16, dbg_bf(WSP(bf16, WS_XN), (size_t)m * DM + c), h); }
        __syncthreads();
        for (int j = tid; j < FF; j += 512) { float g = 0.f, u = 0.f; for (int k = 0; k < DM; ++k) { g += rowb2[k] * F_w_f1[(size_t)k * NF1 + j]; u += rowb2[k] * F_w_f1[(size_t)k * NF1 + FF + j]; }
            const float ref = silu_f(g) * u; rowbuf[j] = ref; dbg_acc(dbg, 16, dbg_bf(WSP(bf16, WS_HID), (size_t)m * FF + j), ref); }
    }
}
__global__ void dbg_encode(Args A, int nout) {
    float* dbg = (float*)(A.ws + DBG_OFF); __shared__ float sc;
    if (threadIdx.x == 0) { int first = 0; for (int k = 1 + DBG_SKIP; k < 32; ++k) { const float sr = dbg[32 + k], sd = dbg[k]; if (sr > 0.f && sd > 0.0025f * sr) { first = k; break; } if (sr == 0.f && sd > 0.f) { first = k; break; } }
        float target = first == 0 ? 0.f : 0.10f + 0.05f * (float)first;
#ifdef DBG_REPORT
        { const float rel = sqrtf(dbg[DBG_REPORT] / fmaxf(dbg[32 + DBG_REPORT], 1e-30f)); target = 0.15f + fminf(0.8f, 8.0f * rel); }
#endif
        sc = 1.0f - sqrtf(target); }
    __syncthreads();
    const float s = sc; if (s == 1.0f) return;
    for (size_t i = (size_t)blockIdx.x * blockDim.x + threadIdx.x; i < (size_t)nout; i += (size_t)gridDim.x * blockDim.x) A.out[i] *= s;
}
#endif

extern "C" void kernel_launch(void* const* d_in, const int* in_sizes, int n_in, void* d_out, int out_size, void* d_ws, size_t ws_size, hipStream_t stream) {
    static int grid = 0;
    if (grid == 0) {
        if (n_in != 25 || out_size != 17842432 || ws_size < WS_END) { fprintf(stderr, "kernel_launch: unexpected shapes: n_in %d out %d ws %zu; nothing launched\n", n_in, out_size, ws_size); grid = -1; return; }
        int dev = 0, cus = 0, per_cu = 0;
        if (hipGetDevice(&dev) != hipSuccess || hipDeviceGetAttribute(&cus, hipDeviceAttributeMultiprocessorCount, dev) != hipSuccess) { grid = -1; return; }
        if (hipFuncSetAttribute((const void*)mk_fwd, hipFuncAttributeMaxDynamicSharedMemorySize, LDS_BYTES) != hipSuccess) { fprintf(stderr, "kernel_launch: hipFuncSetAttribute failed\n"); grid = -1; return; }
        if (hipOccupancyMaxActiveBlocksPerMultiprocessor(&per_cu, (const void*)mk_fwd, NWAVES * 64, LDS_BYTES) != hipSuccess || per_cu < 1) { fprintf(stderr, "kernel_launch: occupancy query says %d blocks per CU\n", per_cu); per_cu = 1; }
        (void)hipGetLastError();
        grid = cus;
    }
    if (grid < 0) return;
    if (hipMemsetAsync((char*)d_ws + WS_CTL, 0, CTL_ZERO_BYTES, stream) != hipSuccess) { fprintf(stderr, "kernel_launch: memset failed\n"); return; }
    Args a{};
    for (int i = 0; i < 25; ++i) a.in[i] = (const float*)d_in[i];
    a.out = (float*)d_out; a.ws = (unsigned char*)d_ws;
#ifdef MK_DEBUG
    for (int ph = 0; ph < N_PHASES; ++ph) { a.ph_lo = ph; a.ph_hi = ph + 1; a.li = 0; hipLaunchKernelGGL(mk_fwd, dim3(grid), dim3(NWAVES * 64), LDS_BYTES, stream, a);
        if (ph == 3) hipLaunchKernelGGL(dbg_check, dim3(28), dim3(512), 0, stream, a);
        if (ph == 4) hipLaunchKernelGGL(dbg_check2, dim3(8), dim3(512), 0, stream, a, 0);
        if (ph == 5) hipLaunchKernelGGL(dbg_check2, dim3(8), dim3(512), 0, stream, a, 1);
        if (ph == 7) hipLaunchKernelGGL(dbg_check2, dim3(8), dim3(512), 0, stream, a, 2); }
    hipLaunchKernelGGL(dbg_encode, dim3(256), dim3(256), 0, stream, a, out_size);
#else
    if (N_LAUNCHES == 1) {
        a.ph_lo = 0; a.ph_hi = N_PHASES; a.li = 0;
        hipLaunchKernelGGL(mk_fwd, dim3(grid), dim3(NWAVES * 64), LDS_BYTES, stream, a);
    } else {
        for (int ph = 0; ph < N_PHASES; ++ph) { a.ph_lo = ph; a.ph_hi = ph + 1; a.li = 0; hipLaunchKernelGGL(mk_fwd, dim3(grid), dim3(NWAVES * 64), LDS_BYTES, stream, a); }
    }
#endif
    const hipError_t le = hipPeekAtLastError();
    if (le != hipSuccess) fprintf(stderr, "kernel_launch: launch failed: %s\n", hipGetErrorName(le));
}
```

```cpp
#include <hip/hip_runtime.h>
#include <hip/hip_bf16.h>
#include <cstdio>
#include <cstdint>
#include <cmath>

#ifndef MK_N_LAUNCHES
#define MK_N_LAUNCHES 1
#endif
#ifndef T_MASK
#define T_MASK 0xFFFF
#endif

constexpr int DM = 1024, MC = 4096, ML = 8192, MTOT = 12288;
constexpr int INC = 5392, NIN = 5376, KMRG = 1280, FF = 2816, NF1 = 5632, NBG = 3072;
constexpr float RMS_EPS = 1e-6f;
constexpr float LOG2E = 1.4426950408889634f;
constexpr float ATT_C2 = 0.125f * 1.4426950408889634f;
constexpr size_t OFF_YP = 0, OFF_YS = 4194304, OFF_NK = 12582912, OFF_NV = 14680064, OFF_NC = 16777216, OFF_NN = 17825792, OFF_NM = 17842176;
constexpr size_t MiB = 1u << 20;
constexpr size_t WS_CTL = 0, CTL_ZERO_BYTES = 2 * MiB;
constexpr size_t WS_MOD = 1 * MiB;
constexpr size_t WS_WIN = 2 * MiB;
constexpr size_t WS_WMRG = WS_WIN + 11010048;
constexpr size_t WS_WOUT = WS_WMRG + 2621440;
constexpr size_t WS_WF1 = WS_WOUT + 2097152;
constexpr size_t WS_WF2 = WS_WF1 + 11534336;
constexpr size_t WS_ROPE = WS_WF2 + 5767168;
constexpr size_t WS_DFTC = WS_ROPE + 65536;
constexpr size_t WS_DFTL = WS_DFTC + 262144;
constexpr size_t WS_GATES = WS_DFTL + 4194304;
constexpr size_t WS_XN = 40 * MiB;
constexpr size_t WS_CT = WS_XN;
constexpr size_t WS_HF = WS_XN + 12 * MiB;
constexpr size_t WS_BG = 64 * MiB;
constexpr size_t WS_HID = WS_BG;
constexpr size_t WS_Q = 136 * MiB;
constexpr size_t WS_KC = WS_Q + 12 * MiB, WS_VC = WS_KC + 2 * MiB, WS_KL = WS_VC + 2 * MiB, WS_VL = WS_KL + 5 * MiB;
constexpr size_t WS_MRGD = WS_Q;
constexpr size_t WS_QM = 162 * MiB, WS_KM = WS_QM + 6 * MiB, WS_KMT = WS_KM + 6 * MiB, WS_VT = WS_KMT + 6 * MiB, WS_OM = WS_VT + 6 * MiB, WS_UT = WS_OM + 6 * MiB;
constexpr size_t WS_ACAT = 198 * MiB;
constexpr size_t WS_QN = 228 * MiB, WS_KN = 234 * MiB, WS_KNT = 240 * MiB;
constexpr size_t WS_UT2 = 240 * MiB;
constexpr size_t WS_PA = 252 * MiB;
constexpr size_t WS_END = 255 * MiB;
static_assert(WS_GATES + 786432 <= WS_XN && WS_VL + 5 * MiB <= WS_QM && WS_UT + 6 * MiB <= WS_ACAT, "ws map");
constexpr int CW_TMO = 0, CW_CODE = 1;
constexpr int CW_BAR = 4096;
constexpr int CW_QUEUE = 65536;
constexpr int CW_EFLAG = 110592;
constexpr int CW_HFLAG = 118784;
constexpr int CW_GFLAG = 126976;
constexpr int CW_MFLAG = 131072;
constexpr int RING_OFF = 0, RING_BYTES = 131072;
constexpr int LDS_BYTES = 163840;
constexpr int SPARE_STAGE = RING_BYTES, SPARE_ROPE = RING_BYTES + 8192;
constexpr int LDSCTL_OFF = LDS_BYTES - 1024, MISC_OFF = LDSCTL_OFF + 320;


namespace pg8 {
#define PG8_LAS __attribute__((address_space(3)))
typedef unsigned short bf16_t;
typedef short bf16x8 __attribute__((ext_vector_type(8)));
typedef float f32x4 __attribute__((ext_vector_type(4)));
typedef unsigned u32x4 __attribute__((ext_vector_type(4)));
constexpr int BM = 256, BK = 64, HALF = 128, HTB = HALF * BK * 2  , STAGE_BYTES = 8 * HTB, NXCD = 8, WGM = 8;

__host__ __device__ __forceinline__ int lds_byte(int r, int c) { const int st = (r >> 4) * 2 + (c >> 5), rr = r & 15, cc = c & 31, ob = rr * 64 + cc * 2; return st * 1024 + (ob ^ (((ob >> 9) & 1) << 5)); }
__host__ __device__ __forceinline__ void stage_rc(int b, int& R, int& C) { const int st = b / 1024, sb = b % 1024, swz = sb ^ (((sb >> 9) & 1) << 5); R = (st >> 1) * 16 + swz / 64; C = (st & 1) * 32 + (swz % 64) / 2; }
__host__ __device__ __forceinline__ int perm32(int rho) { const int n = rho >> 4, i = rho & 15; return 8 * (i >> 2) + 4 * n + (i & 3); }

struct Unit { int pm, pn; };
struct Gemm { const bf16_t* A; const bf16_t* Bt; int M, N, K; };

struct StaticOrder {
    int nM, nN, nwg, G, c;
    __host__ __device__ __forceinline__ void init(int M, int N, int G_, int c_) { nM = M / BM; nN = N / BM; nwg = nM * nN; G = G_; c = c_; }
    __host__ __device__ __forceinline__ bool next(int i, Unit& u) const {
        const long L = (long)i * G + c; if (L >= nwg) return false;
        int wgid = (int)L; { const int q = nwg / NXCD, r = nwg % NXCD, xcd = wgid % NXCD, off = wgid / NXCD; wgid = (xcd < r ? xcd * (q + 1) : r * (q + 1) + (xcd - r) * q) + off; }
        const int nig = WGM * nN, gid = wgid / nig, fm = gid * WGM, gsz = (nM - fm) < WGM ? (nM - fm) : WGM;
        u.pm = fm + ((wgid % nig) % gsz); u.pn = (wgid % nig) / gsz; return true;
    }
    __device__ __forceinline__ void a_ready(const Unit&) const {}
    __device__ __forceinline__ void done(const Unit&) const {}
};

struct GOrder {
    StaticOrder so; int split;
    __device__ void init(int M, int N, int G_, int c_) { split = (G_ == 256 && M == 12288 && N == 5632) ? 1 : 0; so.init(M, split ? N - 512 : N, G_, c_); }
    __device__ bool next(int i, Unit& u) const {
        if (!split) return so.next(i, u);
        if (i > 3) return false;
        if (i < 3 || so.c < 192) return so.next(i, u);
        const int j = so.c - 192, x = j & 7, a = j >> 3; u.pm = 16 + 4 * x + (a >> 1); u.pn = 20 + (a & 1); return true;
    }
    __device__ __forceinline__ void a_ready(const Unit&) const {}
    __device__ __forceinline__ void done(const Unit&) const {}
};
struct FlagUnit { Unit u; unsigned* flag;
    __device__ __forceinline__ bool next(int i, Unit& o) const { if (i != 0) return false; o = u; return true; }
    __device__ __forceinline__ void a_ready(const Unit&) const {}
    __device__ __forceinline__ void done(const Unit&) const {
        asm volatile("s_waitcnt vmcnt(0)" ::: "memory"); __syncthreads();
        if (threadIdx.x == 0) { __builtin_amdgcn_fence(__ATOMIC_RELEASE, "agent"); asm volatile("s_waitcnt vmcnt(0)" ::: "memory"); (void)__hip_atomic_fetch_add(flag, 1u, __ATOMIC_RELAXED, __HIP_MEMORY_SCOPE_AGENT); } }
};

__device__ __forceinline__ unsigned cvt_pk_bf16(float lo, float hi) { unsigned r; asm volatile("v_cvt_pk_bf16_f32 %0, %1, %2" : "=v"(r) : "v"(lo), "v"(hi)); return r; }
typedef float f32x2 __attribute__((ext_vector_type(2)));

typedef float f32x2v __attribute__((ext_vector_type(2)));
typedef unsigned u32x2 __attribute__((ext_vector_type(2)));
__device__ __forceinline__ void st16_wt(void* p, u32x4 v) { asm volatile("global_store_dwordx4 %0, %1, off sc1\n\ts_nop 2" :: "v"(p), "v"(v) : "memory"); }
__device__ __forceinline__ unsigned f2bf_(float f) { unsigned u = __builtin_bit_cast(unsigned, f); return (u + 0x7fffu + ((u >> 16) & 1u)) >> 16; }
typedef __bf16 bf16x2h_t __attribute__((ext_vector_type(2)));
__device__ __forceinline__ unsigned pk2_(float lo, float hi) { f32x2v v = {lo, hi}; return __builtin_bit_cast(unsigned, __builtin_convertvector(v, bf16x2h_t)); }
__device__ __forceinline__ u32x2 pk4_(f32x4 v) { u32x2 w; w.x = pk2_(v[0], v[1]); w.y = pk2_(v[2], v[3]); return w; }
__device__ __forceinline__ float bf2f_(unsigned short h) { return __builtin_bit_cast(float, (unsigned)h << 16); }
__device__ __forceinline__ f32x4 bf4_to_f32(u32x2 w) { f32x4 r; r[0] = __builtin_bit_cast(float, w.x << 16); r[1] = __builtin_bit_cast(float, w.x & 0xffff0000u); r[2] = __builtin_bit_cast(float, w.y << 16); r[3] = __builtin_bit_cast(float, w.y & 0xffff0000u); return r; }

struct OneUnit { Unit u;
    __device__ __forceinline__ bool next(int i, Unit& o) const { if (i != 0) return false; o = u; return true; }
    __device__ __forceinline__ void a_ready(const Unit&) const {}
    __device__ __forceinline__ void done(const Unit&) const {} };

struct EpiIn {
    static constexpr bool PERM = false, AFTER_DRAIN = false, HAS_MID = false;
    int layer;
    bf16_t *Q, *KC, *VC, *KL, *VL, *QM, *KM, *KMT, *VT, *OM, *UT; unsigned char* BG;
    float *onk, *onv;
    const float *qg, *kg;
    const PG8_LAS f32x2v* rope;
    PG8_LAS bf16_t* stage;
    __device__ __forceinline__ void operator()(const f32x4 (&acc)[2][2][4][2], const Unit& u, int wr, int wc, int fr0, int fq0) const {
        int fr = fr0, fq = fq0; asm volatile("" : "+v"(fr), "+v"(fq));
        const int pn = u.pn, pm = u.pm;
        const bool ctx = pm < 16;
        const int b = ctx ? pm : ((pm - 16) >> 2);
        const int tb = ctx ? 0 : ((pm - 16) & 3) * 256;
        const int T = ctx ? 256 : 1024;
        const int rl0 = wr * 64 + fr;
        if (pn <= 3) {
            const float* gv = (pn == 2) ? kg : qg;
            f32x4 g4[2][2];
#pragma unroll
            for (int bj = 0; bj < 2; ++bj)
#pragma unroll
                for (int n = 0; n < 2; ++n) g4[bj][n] = *(const f32x4*)(gv + 32 * bj + 16 * n + 4 * fq);
#pragma unroll
            for (int ai = 0; ai < 2; ++ai)
#pragma unroll
                for (int m = 0; m < 4; ++m) {
                    asm volatile("" ::: "memory"); const int rl = rl0 + ai * 128 + m * 16; const int t = tb + rl; const size_t row = (size_t)pm * 256 + rl;
                    f32x4 v[2][2];
#pragma unroll
                    for (int bj = 0; bj < 2; ++bj)
#pragma unroll
                        for (int n = 0; n < 2; ++n) v[bj][n] = acc[ai][bj][m][n];
                    if (pn != 3) {
                        float ss = 0.f;
#pragma unroll
                        for (int bj = 0; bj < 2; ++bj)
#pragma unroll
                            for (int n = 0; n < 2; ++n) { const f32x4 x = v[bj][n]; ss += (x[0] * x[0] + x[1] * x[1]) + (x[2] * x[2] + x[3] * x[3]); }
                        ss += __shfl_xor(ss, 16); ss += __shfl_xor(ss, 32);
                        const float rs = 1.0f / sqrtf(ss * (1.0f / 64.0f) + RMS_EPS);
#pragma unroll
                        for (int bj = 0; bj < 2; ++bj)
#pragma unroll
                            for (int n = 0; n < 2; ++n) v[bj][n] = v[bj][n] * rs * g4[bj][n];
                        if (!ctx) {
#pragma unroll
                            for (int bj = 0; bj < 2; ++bj) {
                                const int pos = bj == 0 ? (t >> 6) : (t & 63);
                                const PG8_LAS f32x2v* rp = rope + pos * 16 + 4 * fq;
#pragma unroll
                                for (int j = 0; j < 4; ++j) { const f32x2v cs = rp[j]; const float x1 = v[bj][0][j], x2 = v[bj][1][j];
                                    v[bj][0][j] = x1 * cs.x - x2 * cs.y; v[bj][1][j] = x2 * cs.x + x1 * cs.y; }
                            }
                        }
                    }
                    if (pn <= 1) {
                        bf16_t* dst = Q + row * 512 + (4 * pn + wc) * 64 + 8 * fq;
#pragma unroll
                        for (int bj = 0; bj < 2; ++bj) { const u32x2 p0 = pk4_(v[bj][0] * ATT_C2), p1 = pk4_(v[bj][1] * ATT_C2); const u32x4 w = {p0.x, p0.y, p1.x, p1.y}; *(u32x4*)(dst + 32 * bj) = w; }
                    } else {
                        const int hb = wc * 64 + 8 * fq; const int hf = wc * 64 + (pn == 2 ? 4 * fq : 8 * fq), nf = pn == 2 ? 16 : 4;
                        if (ctx) {
                            float* of = (pn == 2 ? onk : onv) + ((size_t)((b * 2 + layer) * 256 + t)) * 256 + hf;
                            bf16_t* dst = (pn == 2 ? KC : VC) + ((size_t)(b * 256 + t)) * 256 + hb;
#pragma unroll
                            for (int bj = 0; bj < 2; ++bj) {
#pragma unroll
                                for (int n = 0; n < 2; ++n) *(f32x4*)(of + 32 * bj + nf * n) = v[bj][n];
                                const u32x2 p0 = pk4_(v[bj][0]), p1 = pk4_(v[bj][1]); const u32x4 w = {p0.x, p0.y, p1.x, p1.y}; *(u32x4*)(dst + 32 * bj) = w; }
                        } else {
                            bf16_t* dst = (pn == 2 ? KL : VL) + ((size_t)(b * 1280 + 256 + t)) * 256 + hb;
#pragma unroll
                            for (int bj = 0; bj < 2; ++bj) { const u32x2 p0 = pk4_(v[bj][0]), p1 = pk4_(v[bj][1]); const u32x4 w = {p0.x, p0.y, p1.x, p1.y}; *(u32x4*)(dst + 32 * bj) = w; }
                        }
                    }
                }
        } else {
            const int c0 = 32 * wc + 8 * fq;
            const size_t tbase = ctx ? (size_t)b * 65536 : (size_t)16 * 65536 + (size_t)b * 262144;
            const size_t tsel = pn == 5 ? (size_t)(KMT - UT) : pn == 6 ? (size_t)(VT - UT) : 0;
#pragma unroll
            for (int ai = 0; ai < 2; ++ai)
#pragma unroll
                for (int m = 0; m < 4; ++m) {
                    asm volatile("" ::: "memory"); const int rl = rl0 + ai * 128 + m * 16; const int t = tb + rl; const size_t row = (size_t)pm * 256 + rl; u32x4 gw4 = {0u, 0u, 0u, 0u};
#pragma unroll
                    for (int bj = 0; bj < 2; ++bj)
#pragma unroll
                        for (int n = 0; n < 2; ++n) {
                            const f32x4 x = acc[ai][bj][m][n]; const int c = c0 + 128 * bj;
                            if (pn == 4) { const u32x2 p = pk4_(x); if (n == 0) { gw4[0] = p.x; gw4[1] = p.y; } else { gw4[2] = p.x; gw4[3] = p.y; *(u32x4*)(QM + row * 256 + c) = gw4; } }
                            else if (pn == 5 || pn == 6 || pn == 8) {
                                if (pn == 5) { const u32x2 p = pk4_(x); if (n == 0) { gw4[0] = p.x; gw4[1] = p.y; } else { gw4[2] = p.x; gw4[3] = p.y; *(u32x4*)(KM + row * 256 + c) = gw4; } }
                                PG8_LAS bf16_t* sw = stage + (wr * 4 + wc) * 512;
#pragma unroll
                                for (int j = 0; j < 4; ++j) sw[(8 * fq + 4 * n + j) * 16 + fr] = (bf16_t)f2bf_(x[j]);
                                if (n == 1) {
                                    const int L = fq * 16 + fr; const u32x4 tv = *(const PG8_LAS u32x4*)(sw + (L >> 1) * 16 + (L & 1) * 8);
                                    bf16_t* tp = UT + tsel + tbase + (size_t)(128 * bj + 32 * wc + (L >> 1)) * T + tb + ai * 128 + wr * 64 + m * 16 + (L & 1) * 8;
                                    *(u32x4*)tp = tv;
                                }
                            }
                            else if (pn == 7) { f32x4 s;
#pragma unroll
                                for (int j = 0; j < 4; ++j) s[j] = 1.0f / (1.0f + __expf(-x[j]));
                                const u32x2 p = pk4_(s); if (n == 0) { gw4[0] = p.x; gw4[1] = p.y; } else { gw4[2] = p.x; gw4[3] = p.y; *(u32x4*)(OM + row * 256 + c) = gw4; } }
                            else {
                                unsigned w = 0u;
#pragma unroll
                                for (int j = 0; j < 4; ++j) { const float gq = fmaxf(255.0f * __builtin_amdgcn_rcpf(1.0f + __expf(-x[j])), 1.0f); w = __builtin_amdgcn_cvt_pk_u8_f32(gq, j, w); }
                                gw4[bj * 2 + n] = w;
                                if (bj == 1 && n == 1) *(u32x4*)(BG + ((size_t)(((pn - 9) >> 2) * 48 + pm) * 4 + ((pn - 9) & 3)) * 65536 + (size_t)rl * 256 + (wc * 4 + fq) * 16) = gw4; }
                        }
                }
        }
    }
};

__device__ __forceinline__ f32x4 u8x4_to_f32(unsigned w) { f32x4 r; r[0] = (float)(w & 0xffu); r[1] = (float)((w >> 8) & 0xffu); r[2] = (float)((w >> 16) & 0xffu); r[3] = (float)(w >> 24); return r; }
struct EpiMerge {
    static constexpr bool PERM = false, AFTER_DRAIN = false, HAS_MID = true;
    const unsigned char* BG; bf16_t* O;
    __device__ __forceinline__ void mid(f32x4 (&acc)[2][2][4][2], const Unit& u, int t, int wr, int wc, int fr0, int fq0) const {
        if (t != 8 && t != 12) return;
        int fr = fr0, fq = fq0; asm volatile("" : "+v"(fr), "+v"(fq));
        const int gn = (t == 8) ? 0 : 1, gd = (t == 8) ? 1 : 2;
        const size_t lo = (size_t)(wr * 64 + fr) * 256 + (wc * 4 + fq) * 16;
        const unsigned char* bn0 = BG + ((size_t)(gn * 48 + u.pm) * 4 + u.pn) * 65536 + lo;
        const unsigned char* bd0 = BG + ((size_t)(gd * 48 + u.pm) * 4 + u.pn) * 65536 + lo;
#pragma unroll
        for (int ai = 0; ai < 2; ++ai) {
            u32x4 cn[4], cd[4];
#pragma unroll
            for (int m = 0; m < 4; ++m) { cn[m] = *(const u32x4*)(bn0 + (ai * 128 + m * 16) * 256); cd[m] = *(const u32x4*)(bd0 + (ai * 128 + m * 16) * 256); }
            asm volatile("" ::: "memory");
#pragma unroll
            for (int m = 0; m < 4; ++m)
#pragma unroll
                for (int bj = 0; bj < 2; ++bj)
#pragma unroll
                    for (int n = 0; n < 2; ++n) { const f32x4 en = u8x4_to_f32(cn[m][bj * 2 + n]), ed = u8x4_to_f32(cd[m][bj * 2 + n]); f32x4 f;
#pragma unroll
                        for (int j = 0; j < 4; ++j) f[j] = en[j] * __builtin_amdgcn_rcpf(ed[j]);
                        acc[ai][bj][m][n] = acc[ai][bj][m][n] * f; }
            asm volatile("" ::: "memory");
        }
    }
    __device__ __forceinline__ void operator()(const f32x4 (&acc)[2][2][4][2], const Unit& u, int wr, int wc, int fr0, int fq0) const {
        int fr = fr0, fq = fq0; asm volatile("" : "+v"(fr), "+v"(fq));
        const size_t row0 = (size_t)u.pm * 256 + wr * 64 + fr; const int c0 = u.pn * 256 + 32 * wc + 8 * fq;
        const unsigned char* bf0 = BG + ((size_t)(2 * 48 + u.pm) * 4 + u.pn) * 65536 + (size_t)(wr * 64 + fr) * 256 + (wc * 4 + fq) * 16; bf16_t* op0 = O + row0 * 1024 + c0;
#pragma unroll
        for (int ai = 0; ai < 2; ++ai) {
            u32x4 cf[4];
#pragma unroll
            for (int m = 0; m < 4; ++m) cf[m] = *(const u32x4*)(bf0 + (ai * 128 + m * 16) * 256);
            asm volatile("" ::: "memory");
#pragma unroll
            for (int m = 0; m < 4; ++m) { bf16_t* op = op0 + (size_t)(ai * 128 + m * 16) * 1024;
#pragma unroll
                for (int bj = 0; bj < 2; ++bj) { const f32x4 g0 = u8x4_to_f32(cf[m][bj * 2]) * (1.0f / 255.0f), g1 = u8x4_to_f32(cf[m][bj * 2 + 1]) * (1.0f / 255.0f);
                    const u32x2 p0 = pk4_(acc[ai][bj][m][0] * g0), p1 = pk4_(acc[ai][bj][m][1] * g1); const u32x4 w = {p0.x, p0.y, p1.x, p1.y}; *(u32x4*)(op + 128 * bj) = w; } }
            asm volatile("" ::: "memory");
        }
    }
};

struct EpiRes {
    static constexpr bool PERM = false, AFTER_DRAIN = false, HAS_MID = true;
    int mode;
    unsigned* wflag; unsigned wneed;
    __device__ __forceinline__ void mid(f32x4 (&)[2][2][4][2], const Unit& u, int t, int, int, int, int) const {
        if (t != 38 || wflag == nullptr || u.pm >= 16) return;
        unsigned sp = 0; while (__hip_atomic_load(wflag, __ATOMIC_RELAXED, __HIP_MEMORY_SCOPE_AGENT) < wneed) { __builtin_amdgcn_s_sleep(4); if (++sp > (1u << 22)) break; }
        asm volatile("" ::: "memory");
    }
    const float *xin_p, *xin_s;
    bf16_t* xb;
    float* xout;
    const float* gate;
    __device__ __forceinline__ void operator()(const f32x4 (&acc)[2][2][4][2], const Unit& u, int wr, int wc, int fr0, int fq0) const {
        int fr = fr0, fq = fq0; asm volatile("" : "+v"(fr), "+v"(fq));
        const int pm = u.pm; const int v = pm < 16 ? 0 : 1 + ((pm - 16) >> 2);
        const float* xin = pm < 16 ? xin_p + (size_t)pm * 256 * 1024 : xin_s + (size_t)(pm - 16) * 256 * 1024;
        const int c0 = u.pn * 256 + 32 * wc + 8 * fq;
        f32x4 g4[2][2];
#pragma unroll
        for (int bj = 0; bj < 2; ++bj)
#pragma unroll
            for (int n = 0; n < 2; ++n) g4[bj][n] = *(const f32x4*)(gate + (size_t)v * 6144 + c0 + 128 * bj + 4 * n);
        const size_t r0 = (size_t)pm * 256 + wr * 64 + fr;
        if (mode == 0) {
            const float* xp0 = xin + (size_t)(wr * 64 + fr) * 1024 + c0; bf16_t* op0 = xb + r0 * 1024 + c0;
#pragma unroll
            for (int ai = 0; ai < 2; ++ai) {
                f32x4 cx[4][2][2];
#pragma unroll
                for (int m = 0; m < 4; ++m) { const float* xp = xp0 + (size_t)(ai * 128 + m * 16) * 1024;
#pragma unroll
                    for (int bj = 0; bj < 2; ++bj)
#pragma unroll
                        for (int n = 0; n < 2; ++n) cx[m][bj][n] = *(const f32x4*)(xp + 128 * bj + 4 * n); }
                asm volatile("" ::: "memory");
#pragma unroll
                for (int m = 0; m < 4; ++m) { bf16_t* op = op0 + (size_t)(ai * 128 + m * 16) * 1024;
#pragma unroll
                    for (int bj = 0; bj < 2; ++bj) { const u32x2 p0 = pk4_(cx[m][bj][0] + g4[bj][0] * acc[ai][bj][m][0]), p1 = pk4_(cx[m][bj][1] + g4[bj][1] * acc[ai][bj][m][1]);
                        const u32x4 w = {p0.x, p0.y, p1.x, p1.y}; st16_wt(op + 128 * bj, w); } }
                asm volatile("" ::: "memory");
            }
        } else {
            const bf16_t* xp0 = xb + r0 * 1024 + c0; float* op0 = xout + r0 * 1024 + c0;
#pragma unroll
            for (int ai = 0; ai < 2; ++ai) {
                u32x4 cx[4][2];
#pragma unroll
                for (int m = 0; m < 4; ++m) { const bf16_t* xp = xp0 + (size_t)(ai * 128 + m * 16) * 1024;
#pragma unroll
                    for (int bj = 0; bj < 2; ++bj) cx[m][bj] = *(const u32x4*)(xp + 128 * bj); }
                asm volatile("" ::: "memory");
#pragma unroll
                for (int m = 0; m < 4; ++m) { float* op = op0 + (size_t)(ai * 128 + m * 16) * 1024;
#pragma unroll
                    for (int bj = 0; bj < 2; ++bj)
#pragma unroll
                        for (int n = 0; n < 2; ++n) { const u32x2 h = {cx[m][bj][2 * n], cx[m][bj][2 * n + 1]}; *(f32x4*)(op + 128 * bj + 4 * n) = bf4_to_f32(h) + g4[bj][n] * acc[ai][bj][m][n]; } }
                asm volatile("" ::: "memory");
            }
        }
    }
};

struct EpiSwiGLU {
    static constexpr bool PERM = false, AFTER_DRAIN = false, HAS_MID = false;
    bf16_t* H;
    __device__ __forceinline__ void operator()(const f32x4 (&acc)[2][2][4][2], const Unit& u, int wr, int wc, int fr0, int fq0) const {
        int fr = fr0, fq = fq0; asm volatile("" : "+v"(fr), "+v"(fq));
        const int c0 = u.pn * 128 + 32 * wc + 8 * fq;
#pragma unroll
        for (int ai = 0; ai < 2; ++ai)
#pragma unroll
            for (int m = 0; m < 4; ++m) {
                asm volatile("" ::: "memory"); const size_t row = (size_t)u.pm * 256 + ai * 128 + wr * 64 + m * 16 + fr; bf16_t* op = H + row * FF + c0; u32x4 w;
#pragma unroll
                for (int n = 0; n < 2; ++n) { const f32x4 g = acc[ai][0][m][n], v = acc[ai][1][m][n]; f32x4 o;
#pragma unroll
                    for (int j = 0; j < 4; ++j) o[j] = g[j] * __builtin_amdgcn_rcpf(1.0f + __expf(-g[j])) * v[j];
                    const u32x2 p = pk4_(o); w[2 * n] = p.x; w[2 * n + 1] = p.y; }
                *(u32x4*)op = w;
            }
    }
};

struct EpiFourier {
    static constexpr bool PERM = false, AFTER_DRAIN = false, HAS_MID = false;
    bf16_t* AC; int lat;
    __device__ __forceinline__ void operator()(const f32x4 (&acc)[2][2][4][2], const Unit& u, int wr, int wc, int fr0, int fq0) const {
        int fr = fr0, fq = fq0; asm volatile("" : "+v"(fr), "+v"(fq));
        const size_t tok0 = lat ? (size_t)4096 + (size_t)u.pn * 1024 : (size_t)u.pn * 256;
        const int T = lat ? 1024 : 256, half = T >> 1;
        const int c0 = 32 * wc + 4 * fq;
#pragma unroll
        for (int ai = 0; ai < 2; ++ai)
#pragma unroll
            for (int m = 0; m < 4; ++m) {
                asm volatile("" ::: "memory");
                const int s = lat ? (u.pm >> 1) : ai; const int tp = lat ? 256 * (u.pm & 1) + ai * 128 + wr * 64 + m * 16 + fr : wr * 64 + m * 16 + fr;
                const bool special = (s == 1 && tp == 0);
                bf16_t* p1 = AC + (tok0 + (special ? half : tp)) * KMRG + 768 + (special ? 0 : 256 * s) + c0;
                bf16_t* p2 = AC + (tok0 + (T - tp)) * KMRG + 768 + 256 * s + c0;
#pragma unroll
                for (int bj = 0; bj < 2; ++bj)
#pragma unroll
                    for (int n = 0; n < 2; ++n) { const f32x4 v = acc[ai][bj][m][n]; const int co = 128 * bj + 16 * n;
                        *(u32x2*)(p1 + co) = pk4_(v);
                        if (tp >= 1) *(u32x2*)(p2 + co) = pk4_(s ? -v : v);
                        if (special) { const u32x2 z = {0u, 0u}; *(u32x2*)(AC + tok0 * KMRG + 1024 + c0 + co) = z; *(u32x2*)(AC + (tok0 + half) * KMRG + 1024 + c0 + co) = z; } }
            }
    }
};

template <class Epi, class Sched, bool ALIGN_EPI = false, bool SP2 = false>
__device__ __forceinline__ void gemm_phase(PG8_LAS unsigned char* lds, const Gemm g, const Sched& S, const Epi& E, const int tid_in, unsigned* prof = nullptr) {
#ifdef PROF_GEMM
    unsigned long long pg_start = 0; if (prof && tid_in == 0) pg_start = __builtin_amdgcn_s_memrealtime();
#endif
    const int tid = tid_in, wid = __builtin_amdgcn_readfirstlane(tid >> 6), lane = tid & 63, wr = wid >> 2, wc = wid & 3, fr = lane & 15, fq = lane >> 4;
    const int K = g.K, nt = K / BK;
    unsigned voffA[2], voffB[2];
#pragma unroll
    for (int i = 0; i < 2; ++i) { int R, C; stage_rc(tid * 16 + i * 8192, R, C); const int Rb = Epi::PERM ? ((R & ~31) + perm32(R & 31)) : R;
        voffA[i] = (unsigned)(R * K + C) * 2u; voffB[i] = (unsigned)(Rb * K + C) * 2u; }
    const size_t kstep = (size_t)(BK * 2);
    const size_t hstep = (size_t)HALF * K * 2;
    const size_t tstep = 2 * hstep;
    const unsigned ldsw = (unsigned)wid * 1024u;
    const int aoff = lds_byte(wr * 64 + fr, fq * 8), boff = lds_byte(wc * 32 + fr, fq * 8);
#define PG8_SA(b, h) (((b) * 2 + (h)) * HTB)
#define PG8_SB(b, h) ((4 + (b) * 2 + (h)) * HTB)
#define PG8_STAGE(bufoff, gbase, voff) do { _Pragma("unroll") for (int _i = 0; _i < 2; ++_i) \
        __builtin_amdgcn_global_load_lds((const unsigned*)((const char*)(gbase) + (voff)[_i]), (PG8_LAS unsigned*)(lds + (bufoff) + ldsw + _i * 8192), 16, 0, 0); } while (0)
#define PG8_LDA(dst, b, h) do { _Pragma("unroll") for (int m = 0; m < 4; ++m) _Pragma("unroll") for (int k = 0; k < 2; ++k) dst[m][k] = *(const PG8_LAS bf16x8*)(lds + PG8_SA(b, h) + aoff + m * 2048 + k * 1024); } while (0)
#define PG8_LDB(dst, b, h) do { _Pragma("unroll") for (int n = 0; n < 2; ++n) _Pragma("unroll") for (int k = 0; k < 2; ++k) dst[n][k] = *(const PG8_LAS bf16x8*)(lds + PG8_SB(b, h) + boff + n * 2048 + k * 1024); } while (0)
#define PG8_MMA(ai, bj, At, Bt) do { __builtin_amdgcn_s_setprio(1); _Pragma("unroll") for (int m = 0; m < 4; ++m) _Pragma("unroll") for (int n = 0; n < 2; ++n) _Pragma("unroll") for (int k = 0; k < 2; ++k) \
        acc[ai][bj][m][n] = __builtin_amdgcn_mfma_f32_16x16x32_bf16(Bt[n][k], At[m][k], acc[ai][bj][m][n], 0, 0, 0); __builtin_amdgcn_s_setprio(0); } while (0)
#define PG8_WAIT_V(n) asm volatile("s_waitcnt vmcnt(" #n ")" ::: "memory")
#define PG8_WAIT_L(n) asm volatile("s_waitcnt lgkmcnt(" #n ")" ::: "memory")
#define PG8_BAR __builtin_amdgcn_s_barrier()
#define PG8_SCHED __builtin_amdgcn_sched_barrier(0)
    Unit cur, nxt; int ui = 0;
    if (!S.next(0, cur)) return;
    f32x4 acc[2][2][4][2];
#pragma unroll
    for (int a = 0; a < 2; ++a)
#pragma unroll
        for (int b = 0; b < 2; ++b)
#pragma unroll
            for (int m = 0; m < 4; ++m)
#pragma unroll
                for (int n = 0; n < 2; ++n) acc[a][b][m][n] = (f32x4){0.f, 0.f, 0.f, 0.f};
    bf16x8 At[4][2], B0[2][2], B1[2][2];
    const char* cA = (const char*)g.A + (size_t)cur.pm * tstep; const char* cB = (const char*)g.Bt + (size_t)cur.pn * tstep;
    S.a_ready(cur);
    if constexpr (SP2) {
        PG8_STAGE(PG8_SB(0, 0), cB, voffB); PG8_STAGE(PG8_SB(0, 1), cB + hstep, voffB); PG8_STAGE(PG8_SA(0, 0), cA, voffA); PG8_STAGE(PG8_SA(0, 1), cA + hstep, voffA);
        if (wr == 1) PG8_BAR;
        PG8_WAIT_V(2); PG8_BAR;
        PG8_STAGE(PG8_SB(1, 0), cB + kstep, voffB); PG8_STAGE(PG8_SA(1, 0), cA + kstep, voffA); PG8_STAGE(PG8_SB(1, 1), cB + hstep + kstep, voffB);
        PG8_WAIT_V(6); PG8_BAR;
    } else {
        PG8_STAGE(PG8_SB(0, 0), cB, voffB); PG8_STAGE(PG8_SA(0, 0), cA, voffA); PG8_STAGE(PG8_SB(0, 1), cB + hstep, voffB); PG8_STAGE(PG8_SA(0, 1), cA + hstep, voffA);
        if (wr == 1) PG8_BAR;
        PG8_WAIT_V(4); PG8_BAR;
        PG8_STAGE(PG8_SB(1, 0), cB + kstep, voffB); PG8_STAGE(PG8_SA(1, 0), cA + kstep, voffA); PG8_STAGE(PG8_SB(1, 1), cB + hstep + kstep, voffB);
        PG8_WAIT_V(6); PG8_BAR;
    }
    for (;;) {
        const bool has_next = S.next(ui + 1, nxt);
        const char* nA = has_next ? (const char*)g.A + (size_t)nxt.pm * tstep : cA; const char* nB = has_next ? (const char*)g.Bt + (size_t)nxt.pn * tstep : cB;
        for (int t = 0; t < nt; t += 2) {
            if constexpr (Epi::HAS_MID) { E.mid(acc, cur, t, wr, wc, fr, fq); }
            const bool last = (t == nt - 2);
            const char* a1 = cA + (size_t)(t + 1) * kstep;
            const char* a2 = last ? nA : cA + (size_t)(t + 2) * kstep; const char* b2 = last ? nB : cB + (size_t)(t + 2) * kstep;
            const char* a3 = a2 + kstep; const char* b3 = b2 + kstep;
            if (last && has_next) S.a_ready(nxt);
            if constexpr (SP2) {
            PG8_LDB(B0, 0, 0); PG8_LDB(B1, 0, 1); PG8_SCHED; PG8_LDA(At, 0, 0); PG8_STAGE(PG8_SA(1, 1), a1 + hstep, voffA);
            PG8_WAIT_V(8); PG8_WAIT_L(0); PG8_BAR; PG8_MMA(0, 0, At, B0); PG8_MMA(0, 1, At, B1); PG8_BAR; PG8_SCHED;
            PG8_LDA(At, 0, 1); PG8_STAGE(PG8_SB(0, 0), b2, voffB); PG8_STAGE(PG8_SB(0, 1), b2 + hstep, voffB); PG8_STAGE(PG8_SA(0, 0), a2, voffA);
            PG8_WAIT_V(8); PG8_WAIT_L(0); PG8_BAR; PG8_MMA(1, 0, At, B0); PG8_MMA(1, 1, At, B1); PG8_BAR; PG8_SCHED;
            PG8_LDB(B0, 1, 0); PG8_LDB(B1, 1, 1); PG8_SCHED; PG8_LDA(At, 1, 0); PG8_STAGE(PG8_SA(0, 1), a2 + hstep, voffA);
            PG8_WAIT_V(8); PG8_WAIT_L(0); PG8_BAR; PG8_MMA(0, 0, At, B0); PG8_MMA(0, 1, At, B1); PG8_BAR; PG8_SCHED;
            PG8_LDA(At, 1, 1); PG8_STAGE(PG8_SB(1, 0), b3, voffB); PG8_STAGE(PG8_SB(1, 1), b3 + hstep, voffB); PG8_STAGE(PG8_SA(1, 0), a3, voffA);
            PG8_WAIT_V(8); PG8_WAIT_L(0); PG8_BAR; PG8_MMA(1, 0, At, B0); PG8_MMA(1, 1, At, B1); PG8_BAR; PG8_SCHED;
            } else {
            PG8_LDB(B0, 0, 0); PG8_SCHED; PG8_LDA(At, 0, 0); PG8_STAGE(PG8_SA(1, 1), a1 + hstep, voffA);
            PG8_WAIT_L(8); PG8_BAR; PG8_WAIT_L(0); PG8_MMA(0, 0, At, B0); PG8_BAR; PG8_SCHED;
            PG8_LDB(B1, 0, 1); PG8_STAGE(PG8_SB(0, 0), b2, voffB);
            PG8_BAR; PG8_WAIT_L(0); PG8_MMA(0, 1, At, B1); PG8_BAR;
            PG8_LDA(At, 0, 1); PG8_STAGE(PG8_SA(0, 0), a2, voffA);
            PG8_BAR; PG8_WAIT_L(0); PG8_MMA(1, 0, At, B0); PG8_BAR; PG8_SCHED;
            PG8_STAGE(PG8_SB(0, 1), b2 + hstep, voffB);
            PG8_WAIT_V(6); PG8_BAR; PG8_MMA(1, 1, At, B1); PG8_BAR;
            PG8_LDB(B0, 1, 0); PG8_SCHED; PG8_LDA(At, 1, 0); PG8_STAGE(PG8_SA(0, 1), a2 + hstep, voffA);
            PG8_WAIT_L(8); PG8_BAR; PG8_WAIT_L(0); PG8_MMA(0, 0, At, B0); PG8_BAR; PG8_SCHED;
            PG8_LDB(B1, 1, 1); PG8_STAGE(PG8_SB(1, 0), b3, voffB);
            PG8_BAR; PG8_WAIT_L(0); PG8_MMA(0, 1, At, B1); PG8_BAR;
            PG8_LDA(At, 1, 1); PG8_STAGE(PG8_SA(1, 0), a3, voffA);
            PG8_BAR; PG8_WAIT_L(0); PG8_MMA(1, 0, At, B0); PG8_BAR; PG8_SCHED;
            PG8_STAGE(PG8_SB(1, 1), b3 + hstep, voffB);
            PG8_WAIT_V(6); PG8_BAR; PG8_MMA(1, 1, At, B1); PG8_BAR;
            }
        }
        if constexpr (ALIGN_EPI) { if (wr == 0) PG8_BAR; }
#ifdef PROF_GEMM
        unsigned long long pg_t0 = 0; if (prof && tid == 0) pg_t0 = __builtin_amdgcn_s_memrealtime();
#endif
        if constexpr (!Epi::AFTER_DRAIN) { E(acc, cur, wr, wc, fr, fq); S.done(cur); }
#ifdef PROF_GEMM
#ifndef PROF_PN_LO
#define PROF_PN_LO 0
#define PROF_PN_HI 1000
#endif
        if (prof && tid == 0 && cur.pn >= PROF_PN_LO && cur.pn <= PROF_PN_HI) { atomicAdd(prof, (unsigned)(__builtin_amdgcn_s_memrealtime() - pg_t0)); atomicAdd(prof + 1, 1u); }
#endif
        if (!has_next) break;
#pragma unroll
        for (int a = 0; a < 2; ++a)
#pragma unroll
            for (int b = 0; b < 2; ++b)
#pragma unroll
                for (int m = 0; m < 4; ++m)
#pragma unroll
                    for (int n = 0; n < 2; ++n) acc[a][b][m][n] = (f32x4){0.f, 0.f, 0.f, 0.f};
        cur = nxt; cA = nA; cB = nB; ++ui;
        if constexpr (ALIGN_EPI) { if (wr == 1) PG8_BAR; }
    }
    PG8_WAIT_V(0);
    if constexpr (!ALIGN_EPI) { if (wr == 0) PG8_BAR; }
    PG8_BAR;
    if constexpr (Epi::AFTER_DRAIN) { E.fused(acc, cur, wr, wc, fr, fq, lds, wid, lane); S.done(cur); }
#ifdef PROF_GEMM
    if (prof && tid == 0) { atomicAdd(prof + 2, (unsigned)(__builtin_amdgcn_s_memrealtime() - pg_start)); atomicAdd(prof + 3, 1u); }
#endif
#undef PG8_SA
#undef PG8_SB
#undef PG8_STAGE
#undef PG8_LDA
#undef PG8_LDB
#undef PG8_MMA
#undef PG8_WAIT_V
#undef PG8_WAIT_L
#undef PG8_BAR
#undef PG8_SCHED
}
}

#define ATTN_STORE16(p,v) (*(u32x4*)(p)=(v))

#include <hip/hip_bf16.h>
#include <cmath>
namespace attn_body {
using bf16=__hip_bfloat16;
using bf16x8=__attribute__((ext_vector_type(8)))short;
using s16x4=__attribute__((ext_vector_type(4)))short;
using f32x16=__attribute__((ext_vector_type(16)))float;
using u32x4=__attribute__((ext_vector_type(4)))unsigned;
constexpr int D=64;
constexpr int NW=8,QBLK=32,QB=QBLK*NW,KVBLK=64;
constexpr int ATTN_UNIT_ROWS=QB;
__device__ __forceinline__ int crow(int r,int hi){return (r&3)+8*(r>>2)+4*hi;}
#define SBAR() __builtin_amdgcn_sched_barrier(0)
__device__ __forceinline__ void cmask(f32x16&p0,f32x16&p1,int jb,int qrel,int hi){
  const float NEG=-INFINITY; int kb=64*jb+4*hi;
  #pragma unroll
  for(int r=0;r<16;++r){int kv=kb+(r&3)+8*(r>>2); if(kv>qrel)p0[r]=NEG; if(kv+32>qrel)p1[r]=NEG;}
}

constexpr int NSLOT=3, SLOTB=8192;
constexpr int LDS_K=0, LDS_V=NSLOT*SLOTB, LDS_WS=2*NSLOT*SLOTB, LDS_OST=LDS_WS+NW*64*4, LDS_BYTES=LDS_OST+NW*4096;
constexpr float C2=0.125f*1.4426950408889634f;
__device__ __forceinline__ void glds16(const void*gsrc,unsigned lds_dst){unsigned keep;
  asm volatile("s_mov_b32 %0, m0\n\ts_mov_b32 m0, %2\n\ts_nop 0\n\tglobal_load_lds_dwordx4 %1, off\n\ts_mov_b32 m0, %0":"=&s"(keep):"v"(gsrc),"s"(lds_dst):"memory");}
__device__ __forceinline__ float max3f(float a,float b,float c){float r;asm("v_max3_f32 %0, %1, %2, %3":"=v"(r):"v"(a),"v"(b),"v"(c));return r;}
__device__ __forceinline__ float max2f(float a,float b){float r;asm("v_max_f32_e32 %0, %1, %2":"=v"(r):"v"(a),"v"(b));return r;}
__device__ __forceinline__ float fadd_s(float a,float b){float r;asm("v_add_f32_e32 %0, %1, %2":"=v"(r):"v"(a),"v"(b));return r;}
__device__ __forceinline__ float fsub_s(float a,float b){float r;asm("v_sub_f32_e32 %0, %1, %2":"=v"(r):"v"(a),"v"(b));return r;}
typedef float f32x2_t __attribute__((ext_vector_type(2))); typedef __bf16 bf16x2_t __attribute__((ext_vector_type(2)));
__device__ __forceinline__ unsigned cvtpk_s(float lo,float hi){f32x2_t v={lo,hi};bf16x2_t b=__builtin_convertvector(v,bf16x2_t);return __builtin_bit_cast(unsigned,b);}
#define WAIT_BAR(N) asm volatile("s_waitcnt vmcnt(" #N ") lgkmcnt(0)\n\ts_barrier":::"memory")

__device__ __forceinline__ void qkt(f32x16&p0,f32x16&p1,const char*Kslot,const bf16x8*qr,const f32x16&negm,int r32,int hi){
  const char*kb=Kslot+hi*1024+r32*16;
  #pragma unroll
  for(int d0=0;d0<4;++d0){
    const bf16x8 b0=*reinterpret_cast<const bf16x8*>(kb+d0*2048);
    const bf16x8 b1=*reinterpret_cast<const bf16x8*>(kb+d0*2048+512);
    if(d0==0){p0=__builtin_amdgcn_mfma_f32_32x32x16_bf16(b0,qr[0],negm,0,0,0);p1=__builtin_amdgcn_mfma_f32_32x32x16_bf16(b1,qr[0],negm,0,0,0);}
    else{p0=__builtin_amdgcn_mfma_f32_32x32x16_bf16(b0,qr[d0],p0,0,0,0);p1=__builtin_amdgcn_mfma_f32_32x32x16_bf16(b1,qr[d0],p1,0,0,0);}}
}
typedef __attribute__((address_space(3))) const char* lds_cptr;
typedef short v4i16_t __attribute__((ext_vector_type(4)));
__device__ __forceinline__ void kload8(bf16x8*kf,lds_cptr kp){
  kf[0]=*(const __attribute__((address_space(3))) bf16x8*)(kp);      kf[1]=*(const __attribute__((address_space(3))) bf16x8*)(kp+512);
  kf[2]=*(const __attribute__((address_space(3))) bf16x8*)(kp+2048); kf[3]=*(const __attribute__((address_space(3))) bf16x8*)(kp+2560);
  kf[4]=*(const __attribute__((address_space(3))) bf16x8*)(kp+4096); kf[5]=*(const __attribute__((address_space(3))) bf16x8*)(kp+4608);
  kf[6]=*(const __attribute__((address_space(3))) bf16x8*)(kp+6144); kf[7]=*(const __attribute__((address_space(3))) bf16x8*)(kp+6656);
}
__device__ __forceinline__ void kload2(bf16x8*kf,lds_cptr kp,int j){ kf[2*j]=*(const __attribute__((address_space(3))) bf16x8*)(kp+j*2048); kf[2*j+1]=*(const __attribute__((address_space(3))) bf16x8*)(kp+j*2048+512); }
__device__ __forceinline__ s16x4 vtr(lds_cptr p){ return __builtin_bit_cast(s16x4,__builtin_amdgcn_ds_read_tr16_b64_v4i16((__attribute__((address_space(3))) v4i16_t*)p)); }
__device__ __forceinline__ float rowmax(const f32x16&p0,const f32x16&p1){
  float a=max3f(p0[0],p0[1],p1[0]),b=max3f(p0[2],p0[3],p1[1]);a=max3f(a,p1[2],p1[3]);
  #pragma unroll
  for(int r=4;r<16;r+=4){a=max3f(a,p0[r],p0[r+1]);b=max3f(b,p0[r+2],p0[r+3]);a=max3f(a,p1[r],p1[r+1]);b=max3f(b,p1[r+2],p1[r+3]);}
  const float m=max2f(a,b);
  auto rr=__builtin_amdgcn_permlane32_swap(__float_as_uint(m),__float_as_uint(m),false,false);
  return max2f(__uint_as_float(rr[0]),__uint_as_float(rr[1]));
}
__device__ __forceinline__ void pv(f32x16*o,int vb,bf16x8 pa0,bf16x8 pa1,bf16x8 pa2,bf16x8 pa3){
  #pragma unroll
  for(int d0=0;d0<2;++d0){s16x4 lo[4],hi[4];
    #pragma unroll
    for(int ks=0;ks<4;++ks){
      asm volatile("ds_read_b64_tr_b16 %0,%1 offset:%c2":"=&v"(lo[ks]):"v"(vb),"i"(d0*4096+ks*1024):"memory");
      asm volatile("ds_read_b64_tr_b16 %0,%1 offset:%c2":"=&v"(hi[ks]):"v"(vb),"i"(d0*4096+ks*1024+512):"memory");}
    asm volatile("s_waitcnt lgkmcnt(0)":::"memory");SBAR();
    #define PK(k) (bf16x8){lo[k][0],lo[k][1],lo[k][2],lo[k][3],hi[k][0],hi[k][1],hi[k][2],hi[k][3]}
    o[d0]=__builtin_amdgcn_mfma_f32_32x32x16_bf16(pa0,PK(0),o[d0],0,0,0);
    o[d0]=__builtin_amdgcn_mfma_f32_32x32x16_bf16(pa1,PK(1),o[d0],0,0,0);
    o[d0]=__builtin_amdgcn_mfma_f32_32x32x16_bf16(pa2,PK(2),o[d0],0,0,0);
    o[d0]=__builtin_amdgcn_mfma_f32_32x32x16_bf16(pa3,PK(3),o[d0],0,0,0);
    #undef PK
  }
}

#ifndef ATTN_STORE16
#define ATTN_STORE16(p,v) (*(u32x4*)(p)=(v))
#endif
template<int THRL> __device__ __forceinline__ void attn_unit(const bf16*Qb,int QP,const bf16*__restrict__ Kh,const bf16*__restrict__ Vh,int KP,int NT,bf16*Ob,int OP,char*shm,const int tid_in){
  const int tid=tid_in,lane=tid&63,r32=lane&31,hi=lane>>5; const int wid=__builtin_amdgcn_readfirstlane(tid>>6);
  const bf16*Qw=Qb+(long)(wid*QBLK)*QP;
  const unsigned lds0=(unsigned)(uintptr_t)shm;
  float*wsf=(float*)(shm+LDS_WS)+wid*64;
  const bf16*ksrc=Kh+(long)lane*KP+wid*8;
  const bf16*vsrc=Vh+(long)(16*(wid&3)+(lane>>2))*KP+(wid>>2)*32+(lane&3)*8;
  const unsigned kdst=lds0+LDS_K+wid*1024, vdst=lds0+LDS_V+wid*1024;
  #define DMA_K(t,slot) glds16(ksrc+(long)(t)*KVBLK*KP,(unsigned)__builtin_amdgcn_readfirstlane(kdst+(slot)))
  #define DMA_V(t,slot) glds16(vsrc+(long)(t)*KVBLK*KP,(unsigned)__builtin_amdgcn_readfirstlane(vdst+(slot)))
  const int vb0=(int)(lds0+LDS_V)+((lane>>4)&1)*32+(lane&3)*8+(4*hi+((lane&15)>>2))*64;
  const char*Kbase=shm+LDS_K; bf16x8 kf[8];
  const lds_cptr shm3=(lds_cptr)shm; const lds_cptr kp0=shm3+LDS_K+hi*1024+r32*16; const lds_cptr vp0=shm3+LDS_V+((lane>>4)&1)*32+(lane&3)*8+(4*hi+((lane&15)>>2))*64;
  DMA_K(0,0);DMA_V(0,0);DMA_K(1,SLOTB);
  bf16x8 qr[4];
  #pragma unroll
  for(int d0=0;d0<4;++d0)qr[d0]=*reinterpret_cast<const bf16x8*>(&Qw[(long)r32*QP+d0*16+hi*8]);
  float mhat=0.f,l_reg=0.f;f32x16 o[2];o[0]=f32x16{};o[1]=f32x16{};f32x16 negm=f32x16{};asm volatile("":"+v"(negm));
  #define CMASK(P0,P1,t) do{}while(0)
  bool resc=false;
  #define START(P0,P1) do{ const float rm=rowmax(P0,P1); resc=false; \
    { const float dl=rm; mhat=fadd_s(mhat,dl); \
      _Pragma("unroll") for(int r=0;r<16;++r){P0[r]=fsub_s(P0[r],dl);P1[r]=fsub_s(P1[r],dl);} \
      _Pragma("unroll") for(int r=0;r<16;++r)negm[r]=-mhat; asm volatile("":"+v"(negm)); } \
    _Pragma("unroll") for(int r=0;r<16;++r)P0[r]=__builtin_amdgcn_exp2f(P0[r]); }while(0)
  #define RESC() do{ if(resc){ asm volatile("s_waitcnt lgkmcnt(0)":::"memory"); \
      _Pragma("unroll") for(int d_=0;d_<2;++d_) _Pragma("unroll") for(int r=0;r<16;++r)o[d_][r]*=wsf[crow(r,hi)]; } }while(0)
  f32x16 pA0,pA1,pB0,pB1;
  int sl_prev=0,sl_cur=0,sl_next=SLOTB;
  #define ROT() do{sl_prev=sl_cur;sl_cur=sl_next;sl_next=(sl_next==(NSLOT-1)*SLOTB)?0:sl_next+SLOTB;}while(0)
  DMA_K(2,2*SLOTB);
  WAIT_BAR(3);
  qkt(pA0,pA1,Kbase,qr,negm,r32,hi);asm volatile("s_nop 15\n\ts_nop 7":"+v"(pA0),"+v"(pA1));CMASK(pA0,pA1,0);
  START(pA0,pA1);
  _Pragma("unroll") for(int r=0;r<16;++r)pA1[r]=__builtin_amdgcn_exp2f(pA1[r]);
  WAIT_BAR(0);
  DMA_K(3,0);DMA_V(1,SLOTB);
  ROT();
  kload8(kf,kp0+sl_cur);
  WAIT_BAR(2);
  s16x4 vlo[8],vhi[8]; u32x4 pw0,pw1,pw2,pw3;
  #define PKW(P,B) cvtpk_s(P[B],P[B+1])
  #define PAF(k) __builtin_bit_cast(bf16x8,pw##k)
  #define VFR(i) (bf16x8){vlo[i][0],vlo[i][1],vlo[i][2],vlo[i][3],vhi[i][0],vhi[i][1],vhi[i][2],vhi[i][3]}
  #define PIN(x) asm volatile("":"+v"(x))
  #define MX3(a,b,c) __builtin_fmaxf(__builtin_fmaxf((a),(b)),(c))
  #define GAPA(MF,A0,A1,A2,A3,W0,W1,PW) do{ MF; sacc+=A0; sacc+=A1; sacc+=A2; sacc+=A3; PIN(sacc); W0; W1; PIN(PW); SBAR(); }while(0)
  #define EX(v) __builtin_amdgcn_exp2f(v)
  #define GAPB(MF,X,B) do{ MF; X[B]=EX(X[B]); X[B+1]=EX(X[B+1]); X[B+2]=EX(X[B+2]); X[B+3]=EX(X[B+3]); PIN(X); SBAR(); }while(0)
  #define VRD(i) do{ vlo[i]=vtr(vp_+(((i)>>2)*4096+((i)&3)*1024)); vhi[i]=vtr(vp_+(((i)>>2)*4096+((i)&3)*1024+512)); }while(0)
  #define KRD(G,j) do{ if(G){ kload2(kf,kp0+sl_next,j); SBAR(); } }while(0)
  #define STEP(C0,C1,P0,P1,t,GK,GV,GL) do{ SBAR(); \
    const lds_cptr vp_=vp0+sl_prev; \
    VRD(0); SBAR(); float sacc=(P0[0]+P0[1]); \
    GAPA(C0=__builtin_amdgcn_mfma_f32_32x32x16_bf16(kf[0],qr[0],negm,0,0,0), P0[2],P0[3],P0[4],P0[5],     pw0[0]=PKW(P0,0), pw0[1]=PKW(P0,2), pw0); \
    VRD(4); SBAR(); GAPA(C1=__builtin_amdgcn_mfma_f32_32x32x16_bf16(kf[1],qr[0],negm,0,0,0), P0[6],P0[7],P0[8],P0[9],     pw0[2]=PKW(P0,4), pw0[3]=PKW(P0,6), pw0); \
    VRD(1); SBAR(); GAPA(C0=__builtin_amdgcn_mfma_f32_32x32x16_bf16(kf[2],qr[1],C0,0,0,0),   P0[10],P0[11],P0[12],P0[13], pw1[0]=PKW(P0,8), pw1[1]=PKW(P0,10), pw1); \
    VRD(5); SBAR(); GAPA(C1=__builtin_amdgcn_mfma_f32_32x32x16_bf16(kf[3],qr[1],C1,0,0,0),   P0[14],P0[15],P1[0],P1[1],   pw1[2]=PKW(P0,12),pw1[3]=PKW(P0,14), pw1); \
    VRD(2); SBAR(); GAPA(C0=__builtin_amdgcn_mfma_f32_32x32x16_bf16(kf[4],qr[2],C0,0,0,0),   P1[2],P1[3],P1[4],P1[5],     pw2[0]=PKW(P1,0), pw2[1]=PKW(P1,2), pw2); \
    VRD(6); SBAR(); GAPA(C1=__builtin_amdgcn_mfma_f32_32x32x16_bf16(kf[5],qr[2],C1,0,0,0),   P1[6],P1[7],P1[8],P1[9],     pw2[2]=PKW(P1,4), pw2[3]=PKW(P1,6), pw2); \
    VRD(3); SBAR(); GAPA(C0=__builtin_amdgcn_mfma_f32_32x32x16_bf16(kf[6],qr[3],C0,0,0,0),   P1[10],P1[11],P1[12],P1[13], pw3[0]=PKW(P1,8), pw3[1]=PKW(P1,10), pw3); \
    VRD(7); SBAR(); GAPA(C1=__builtin_amdgcn_mfma_f32_32x32x16_bf16(kf[7],qr[3],C1,0,0,0),   P1[14],P1[15],0.f,0.f,       pw3[2]=PKW(P1,12),pw3[3]=PKW(P1,14), pw3); \
    l_reg+=sacc; \
    if(GK){DMA_K((t)+3,sl_cur);} if(GV){DMA_V((t)+1,sl_next);} \
    CMASK(C0,C1,t); \
    { float a=MX3(C0[0],C0[1],C1[0]),b=MX3(C0[2],C0[3],C1[1]); a=MX3(a,C1[2],C1[3]); \
      _Pragma("unroll") for(int r=4;r<16;r+=4){a=MX3(a,C0[r],C0[r+1]);b=MX3(b,C0[r+2],C0[r+3]);a=MX3(a,C1[r],C1[r+1]);b=MX3(b,C1[r+2],C1[r+3]);} \
      float rm=__builtin_fmaxf(a,b); { auto rr=__builtin_amdgcn_permlane32_swap(__float_as_uint(rm),__float_as_uint(rm),false,false); rm=__builtin_fmaxf(__uint_as_float(rr[0]),__uint_as_float(rr[1])); } \
      resc=false; \
      if(__builtin_expect(__any(rm>(float)THRL),0)){ const float dl=__builtin_fmaxf(rm,0.f); mhat+=dl; \
        _Pragma("unroll") for(int r=0;r<16;++r){C0[r]-=dl;C1[r]-=dl;} \
        _Pragma("unroll") for(int r=0;r<16;++r)negm[r]=-mhat; asm volatile("":"+v"(negm)); \
        const float f=__builtin_amdgcn_exp2f(-dl); l_reg*=f; if(hi==0)wsf[r32]=f; resc=true; } } \
    SBAR(); \
    GAPB(o[0]=__builtin_amdgcn_mfma_f32_32x32x16_bf16(PAF(0),VFR(0),o[0],0,0,0), C0,0); \
    GAPB(o[1]=__builtin_amdgcn_mfma_f32_32x32x16_bf16(PAF(0),VFR(4),o[1],0,0,0), C0,4); \
    KRD(GL,0); GAPB(o[0]=__builtin_amdgcn_mfma_f32_32x32x16_bf16(PAF(1),VFR(1),o[0],0,0,0), C0,8); \
    KRD(GL,1); GAPB(o[1]=__builtin_amdgcn_mfma_f32_32x32x16_bf16(PAF(1),VFR(5),o[1],0,0,0), C0,12); \
    KRD(GL,2); GAPB(o[0]=__builtin_amdgcn_mfma_f32_32x32x16_bf16(PAF(2),VFR(2),o[0],0,0,0), C1,0); \
    KRD(GL,3); GAPB(o[1]=__builtin_amdgcn_mfma_f32_32x32x16_bf16(PAF(2),VFR(6),o[1],0,0,0), C1,4); \
    GAPB(o[0]=__builtin_amdgcn_mfma_f32_32x32x16_bf16(PAF(3),VFR(3),o[0],0,0,0), C1,8); \
    GAPB(o[1]=__builtin_amdgcn_mfma_f32_32x32x16_bf16(PAF(3),VFR(7),o[1],0,0,0), C1,12); \
    }while(0)
  int t=1;
  #undef CMASK
  #define CMASK(P0,P1,t) do{}while(0)
  for(;t+5<NT;t+=2){
    STEP(pB0,pB1,pA0,pA1,t,true,true,true);     WAIT_BAR(2); RESC(); ROT();
    STEP(pA0,pA1,pB0,pB1,t+1,true,true,true);   WAIT_BAR(2); RESC(); ROT();
  }
  #undef CMASK
  #define CMASK(P0,P1,t) do{}while(0)
  #define ENDW(tt) do{ if((tt)+3<NT){WAIT_BAR(2);} else if((tt)+2<NT){WAIT_BAR(1);} else {WAIT_BAR(0);} }while(0)
  for(;t+1<NT;t+=2){
    STEP(pB0,pB1,pA0,pA1,t,(t+3<NT),(t+1<NT),(t+1<NT));       ENDW(t);   RESC(); ROT();
    STEP(pA0,pA1,pB0,pB1,t+1,(t+4<NT),(t+2<NT),(t+2<NT));     ENDW(t+1); RESC(); ROT();
  }
  STEP(pB0,pB1,pA0,pA1,NT-1,false,false,false); RESC();
  { float sacc=pB0[0]+pB0[1]; _Pragma("unroll") for(int r=2;r<16;++r)sacc+=pB0[r]; _Pragma("unroll") for(int r=0;r<16;++r)sacc+=pB1[r]; l_reg+=sacc;
    pw0=(u32x4){PKW(pB0,0),PKW(pB0,2),PKW(pB0,4),PKW(pB0,6)};pw1=(u32x4){PKW(pB0,8),PKW(pB0,10),PKW(pB0,12),PKW(pB0,14)};pw2=(u32x4){PKW(pB1,0),PKW(pB1,2),PKW(pB1,4),PKW(pB1,6)};pw3=(u32x4){PKW(pB1,8),PKW(pB1,10),PKW(pB1,12),PKW(pB1,14)};
    SBAR(); pv(o,vb0+sl_cur,PAF(0),PAF(1),PAF(2),PAF(3)); }
  #undef PKW
  #undef PAF
  #undef VFR
  #undef PIN
  #undef MX3
  #undef GAPA
  #undef GAPB
  #undef EX
  #undef VRD
  #undef KRD
  #undef STEP
  #undef ENDW
  {auto rr=__builtin_amdgcn_permlane32_swap(__float_as_uint(l_reg),__float_as_uint(l_reg),false,false);l_reg=__uint_as_float(rr[0])+__uint_as_float(rr[1]);}
  if(hi==0)wsf[32+r32]=l_reg;asm volatile("s_waitcnt lgkmcnt(0)":::"memory");
  float rli[16];
  #pragma unroll
  for(int r=0;r<16;++r)rli[r]=__builtin_amdgcn_rcpf(wsf[32+crow(r,hi)]);
  bf16*Ow=Ob+(long)(wid*QBLK)*OP;
  { bf16*stg=(bf16*)(shm+LDS_OST)+wid*2048;
    #pragma unroll
    for(int r=0;r<16;++r){const int orow=crow(r,hi);
      #pragma unroll
      for(int d0=0;d0<2;++d0)stg[orow*64+d0*32+r32]=__float2bfloat16(o[d0][r]*rli[r]);}
    asm volatile("s_waitcnt lgkmcnt(0)":::"memory");
    #pragma unroll
    for(int i=0;i<4;++i){const int row=i*8+(lane>>3),ch=lane&7; const u32x4 v=*(const u32x4*)(stg+row*64+ch*8); ATTN_STORE16(Ow+(long)row*OP+ch*8,v);} }
  asm volatile("s_waitcnt lgkmcnt(0)\n\ts_barrier":::"memory");
  #undef DMA_K
  #undef DMA_V
  #undef CMASK
  #undef START
  #undef RESC
  #undef ROT
}
constexpr int ATTN_LDS_BYTES=LDS_BYTES;
#undef SBAR
#undef WAIT_BAR
}

#define GAS __attribute__((address_space(1)))
#define LAS __attribute__((address_space(3)))
typedef unsigned short bf16;
typedef unsigned v4u __attribute__((ext_vector_type(4)));
typedef float f32x4 __attribute__((ext_vector_type(4)));
typedef short bf16x8 __attribute__((ext_vector_type(8)));
typedef GAS unsigned gu32;
typedef GAS unsigned long long gu64;
#define RLX_AGENT __ATOMIC_RELAXED, __HIP_MEMORY_SCOPE_AGENT
#define LDS_WAIT() asm volatile("s_waitcnt lgkmcnt(0)" ::: "memory")
#define VM_WAIT() asm volatile("s_waitcnt vmcnt(0)" ::: "memory")
__device__ __forceinline__ unsigned long long rt() { return __builtin_amdgcn_s_memrealtime(); }
__device__ __forceinline__ unsigned f2bf(float f) { unsigned u = __builtin_bit_cast(unsigned, f); return (u + 0x7fffu + ((u >> 16) & 1u)) >> 16; }
typedef __bf16 bf16x2g_t __attribute__((ext_vector_type(2))); typedef float f32x2g_t __attribute__((ext_vector_type(2)));
__device__ __forceinline__ unsigned pk2(float lo, float hi) { f32x2g_t v = {lo, hi}; return __builtin_bit_cast(unsigned, __builtin_convertvector(v, bf16x2g_t)); }

#define XB_TMO      128
#define XB_XCNT(j)  (256  + 64 * (j))
#define XB_XSUB(j)  (1280 + 64 * (j))
#define XB_XGEN(j)  (2304 + 64 * (j))
#define XB_TOP      3328
#define XB_TOPGEN   3392
#define XCD_BAR_WORDS 3456
#define XB_SPIN_CAP (1u << 18)

__device__ __forceinline__ unsigned xb_ld(unsigned* p)              { return __hip_atomic_load(p, __ATOMIC_RELAXED, __HIP_MEMORY_SCOPE_AGENT); }
__device__ __forceinline__ unsigned xb_add(unsigned* p, unsigned v) { return __hip_atomic_fetch_add(p, v, __ATOMIC_RELAXED, __HIP_MEMORY_SCOPE_AGENT); }
__device__ __forceinline__ unsigned xb_xcc_id() { return (unsigned)__builtin_amdgcn_s_getreg((3 << 11) | 20) & 0xFu; }
#define XB_SPIN(cond, bar) do { unsigned _sp = 0; while (cond) { __builtin_amdgcn_s_sleep(1); \
    if ((++_sp & 255u) == 0u) { if (xb_ld(&(bar)[XB_TMO])) break; if (_sp > XB_SPIN_CAP) { atomicAdd(&(bar)[XB_TMO], 1u); break; } } } } while (0)

struct XcdBarrier {
    unsigned* bar; unsigned x;
    volatile LAS unsigned* st;
};

__device__ __forceinline__ XcdBarrier xcd_barrier_post(unsigned* bar, volatile LAS unsigned* st) {
    XcdBarrier b; b.bar = bar; b.x = xb_xcc_id(); b.st = st;
    if (threadIdx.x == 0) (void)xb_add(&bar[XB_XCNT(b.x)], 1u);
    return b;
}
__device__ __forceinline__ void xcd_barrier_complete(unsigned* bar, unsigned x, unsigned& nloc, unsigned& nx) {
    const unsigned G = gridDim.x * gridDim.y * gridDim.z;
    unsigned sum, cnt, mine, sp = 0u;
    for (;;) {
        sum = 0u; cnt = 0u; mine = 0u;
#pragma unroll
        for (unsigned j = 0; j < 16; ++j) { const unsigned c = xb_ld(&bar[XB_XCNT(j)]); sum += c; cnt += (c > 0u) ? 1u : 0u; mine = (j == x) ? c : mine; }
        if (sum == G) break;
        __builtin_amdgcn_s_sleep(1);
        if ((++sp & 255u) == 0u) { if (xb_ld(&bar[XB_TMO])) break; if (sp > XB_SPIN_CAP) { atomicAdd(&bar[XB_TMO], 1u); break; } }
    }
    nloc = mine > 0u ? mine : 1u; nx = cnt > 0u ? cnt : 1u;
}

__device__ __forceinline__ void xcd_barrier(const XcdBarrier& b) {
    asm volatile("s_waitcnt vmcnt(0)" ::: "memory");
    __syncthreads();
    if (threadIdx.x == 0) {
        unsigned* bar = b.bar;
        __builtin_amdgcn_s_waitcnt(0);
        unsigned nloc = b.st[0], nx = b.st[1];
        if (nloc == 0u) { xcd_barrier_complete(bar, b.x, nloc, nx); b.st[0] = nloc; b.st[1] = nx; }
        asm volatile("buffer_inv sc1" ::: "memory");
        const unsigned old = xb_add(&bar[XB_XSUB(b.x)], 1u);
        const unsigned gen = old / nloc;
        if (old + 1u == (gen + 1u) * nloc) {
            __builtin_amdgcn_fence(__ATOMIC_RELEASE, "agent");
            asm volatile("s_waitcnt vmcnt(0)" ::: "memory");
            const unsigned og = xb_add(&bar[XB_TOP], 1u);
            const unsigned tg = og / nx;
            if (og + 1u == (tg + 1u) * nx) xb_add(&bar[XB_TOPGEN], 1u);
            else XB_SPIN(xb_ld(&bar[XB_TOPGEN]) == tg, bar);
            asm volatile("" ::: "memory");
            xb_add(&bar[XB_XGEN(b.x)], 1u);
            asm volatile("s_waitcnt vmcnt(0)" ::: "memory");
        } else {
            XB_SPIN(xb_ld(&bar[XB_XGEN(b.x)]) == gen, bar);
            asm volatile("" ::: "memory");
            asm volatile("s_waitcnt vmcnt(0)" ::: "memory");
        }
    }
    __syncthreads();
}

constexpr int NWAVES = 8;
constexpr int N_LAUNCHES = MK_N_LAUNCHES;
constexpr int N_PHASES = 17;
typedef unsigned u32x2 __attribute__((ext_vector_type(2)));
typedef float f32x2v __attribute__((ext_vector_type(2)));

struct Frame {
    unsigned char* lds;
    LAS unsigned char* ldsl;
    volatile LAS unsigned* MISC;
    gu32* ctl;
    int tid, lane, wave, vcu, G;
    unsigned char* ws; float* out;
};
struct Args { const float* in[25]; float* out; unsigned char* ws; int ph_lo, ph_hi, li, pad; };
#define F_x_prompt (A.in[0])
#define F_x_sample (A.in[1])
#define F_cache_k (A.in[2])
#define F_cache_v (A.in[3])
#define F_state_C (A.in[4])
#define F_state_n (A.in[5])
#define F_state_m (A.in[6])
#define F_c (A.in[7])
#define F_c_ctx (A.in[8])
#define F_w_ada (A.in[9])
#define F_b_ada (A.in[10])
#define F_norm1_g (A.in[11])
#define F_w_in (A.in[12])
#define F_q_norm_g (A.in[13])
#define F_k_norm_g (A.in[14])
#define F_m_conv_w (A.in[15])
#define F_m_gate_b (A.in[16])
#define F_m_norm_g (A.in[17])
#define F_w_pa (A.in[18])
#define F_w_pm (A.in[19])
#define F_w_pf (A.in[20])
#define F_w_out (A.in[21])
#define F_norm2_g (A.in[22])
#define F_w_f1 (A.in[23])
#define F_w_f2 (A.in[24])
#define F_out (F.out)
#define WSP(T, off) ((T*)(F.ws + (off)))

__device__ __forceinline__ float wave_sum(float v) {
#pragma unroll
    for (int o = 1; o < 64; o <<= 1) v += __shfl_xor(v, o);
    return v;
}
__device__ __forceinline__ float bf2f(unsigned short h) { return __builtin_bit_cast(float, (unsigned)h << 16); }
__device__ __forceinline__ float silu_f(float y) { return y / (1.0f + __expf(-y)); }

template <bool PN = false>
__device__ __forceinline__ void transpose_item(const float* W, int ldw, int k0, int c0, bf16* WT, int dpitch, int drow0, int dk0, float* scr, int lane) {
    const int h = 4 * (lane & 7), pcol = PN ? 16 * ((h >> 2) & 1) + 4 * ((h >> 3) & 3) : h, kr = lane >> 3;
    f32x4 v[8];
#pragma unroll
    for (int i = 0; i < 8; ++i) v[i] = *(const f32x4*)(W + (size_t)(k0 + 8 * i + kr) * ldw + c0 + h);
#pragma unroll
    for (int i = 0; i < 8; ++i) { float* s = scr + (8 * i + kr) * 33 + pcol; s[0] = v[i][0]; s[1] = v[i][1]; s[2] = v[i][2]; s[3] = v[i][3]; }
    LDS_WAIT(); asm volatile("" ::: "memory");
    const int c = lane & 7;
#pragma unroll
    for (int j = 0; j < 4; ++j) { const int n = (lane >> 3) + 8 * j; const float* s = scr + (8 * c) * 33 + n;
        v4u o; o.x = pk2(s[0 * 33], s[1 * 33]); o.y = pk2(s[2 * 33], s[3 * 33]); o.z = pk2(s[4 * 33], s[5 * 33]); o.w = pk2(s[6 * 33], s[7 * 33]);
        *(v4u*)(WT + (size_t)(drow0 + n) * dpitch + dk0 + 8 * c) = o; }
    LDS_WAIT(); asm volatile("" ::: "memory");
}
__device__ __forceinline__ int win_src_col(int tile, int g) {
    if (tile <= 3) return tile * 256 + 64 * (g & 3) + 32 * (g >> 2);
    if (tile <= 7) return 1024 + (tile - 4) * 256 + 32 * g;
    if (tile == 8) return 2064 + 32 * g;
    return 2320 + (tile - 9) * 256 + 32 * g;
}
constexpr int CV_I1 = 168 * 16, CV_I2 = 32 * 8, CV_I3 = 32 * 4, CV_I4 = 512, CV_I5 = 32 * 16, CV_I6 = 176 * 16, CV_I7 = 32 * 44;
constexpr int CV_MRG = CV_I1, CV_OUT = CV_I1 + CV_I2 + CV_I3 + CV_I4, CV_F1 = CV_OUT + CV_I5, CV_F2 = CV_F1 + CV_I6, CV_END = CV_F2 + CV_I7;
__device__ __forceinline__ void convert_weights(Frame& F, const Args& A, int l, int it_lo, int it_hi, int wi, int nw) {
    float* scr = (float*)(F.lds + RING_OFF + F.wave * 16384);
    float* trig = scr + 64 * 33;
    trig[F.lane] = cosf(6.283185307179586f * (float)F.lane / 64.0f); trig[64 + F.lane] = sinf(6.283185307179586f * (float)F.lane / 64.0f);
    LDS_WAIT(); asm volatile("" ::: "memory");
    const float* w_in = F_w_in + (size_t)l * DM * INC; const float* w_pa = F_w_pa + (size_t)l * 512 * DM; const float* w_pm = F_w_pm + (size_t)l * 256 * DM;
    const float* w_pf = F_w_pf + (size_t)l * 256 * DM; const float* w_out = F_w_out + (size_t)l * DM * DM; const float* w_f1 = F_w_f1 + (size_t)l * DM * NF1; const float* w_f2 = F_w_f2 + (size_t)l * FF * DM;
    bf16* WIN = WSP(bf16, WS_WIN); bf16* WMRG = WSP(bf16, WS_WMRG); bf16* WOUT = WSP(bf16, WS_WOUT); bf16* WF1 = WSP(bf16, WS_WF1); bf16* WF2 = WSP(bf16, WS_WF2);
    constexpr int I1 = CV_I1, I2 = CV_I2, I3 = CV_I3, I4 = CV_I4, I5 = CV_I5, I6 = CV_I6;
    for (int it = it_lo + wi; it < it_hi; it += nw) {
        int r = it;
        if (r < I1) { const int dg = r >> 4, kb = r & 15; if ((dg >> 3) >= 3) transpose_item<true>(w_in, INC, 64 * kb, win_src_col(dg >> 3, dg & 7), WIN, DM, 32 * dg, 64 * kb, scr, F.lane);
            else transpose_item(w_in, INC, 64 * kb, win_src_col(dg >> 3, dg & 7), WIN, DM, 32 * dg, 64 * kb, scr, F.lane);
            continue; } r -= I1;
        if (r < I2) { const int cg = r >> 3, kb = r & 7; transpose_item<true>(w_pa, DM, 64 * kb, 32 * cg, WMRG, KMRG, 32 * cg, 64 * kb, scr, F.lane); continue; } r -= I2;
        if (r < I3) { const int cg = r >> 2, kb = r & 3; transpose_item<true>(w_pm, DM, 64 * kb, 32 * cg, WMRG, KMRG, 32 * cg, 512 + 64 * kb, scr, F.lane); continue; } r -= I3;
        if (r < I4) {
            const int g = r >> 7, nb = (r >> 3) & 15, cb = r & 7; const int n = 64 * nb + F.lane;
            const int nr = (n & ~31) + 16 * ((n >> 2) & 1) + 4 * ((n >> 3) & 3) + (n & 3);
            float pc[8], ps[8];
#pragma unroll
            for (int cc = 0; cc < 8; ++cc) { pc[cc] = 0.f; ps[cc] = 0.f; }
            for (int cp0 = 0; cp0 < 64; cp0 += 16) { float w[16];
#pragma unroll
                for (int q = 0; q < 16; ++q) w[q] = w_pf[(size_t)(g * 64 + cp0 + q) * DM + n];
#pragma unroll
                for (int q = 0; q < 16; ++q)
#pragma unroll
                    for (int cc = 0; cc < 8; ++cc) { const int j = ((8 * cb + cc) * (cp0 + q)) & 63; pc[cc] += trig[j] * w[q]; ps[cc] -= trig[64 + j] * w[q]; } }
            v4u oc, os; oc.x = pk2(pc[0] * 0.125f, pc[1] * 0.125f); oc.y = pk2(pc[2] * 0.125f, pc[3] * 0.125f); oc.z = pk2(pc[4] * 0.125f, pc[5] * 0.125f); oc.w = pk2(pc[6] * 0.125f, pc[7] * 0.125f);
            os.x = pk2(ps[0] * 0.125f, ps[1] * 0.125f); os.y = pk2(ps[2] * 0.125f, ps[3] * 0.125f); os.z = pk2(ps[4] * 0.125f, ps[5] * 0.125f); os.w = pk2(ps[6] * 0.125f, ps[7] * 0.125f);
            *(v4u*)(WMRG + (size_t)nr * KMRG + 768 + g * 64 + 8 * cb) = oc; *(v4u*)(WMRG + (size_t)nr * KMRG + 1024 + g * 64 + 8 * cb) = os;
            continue; } r -= I4;
        if (r < I5) { const int cg = r >> 4, kb = r & 15; transpose_item<true>(w_out, DM, 64 * kb, 32 * cg, WOUT, DM, 32 * cg, 64 * kb, scr, F.lane); continue; } r -= I5;
        if (r < I6) { const int dg = r >> 4, kb = r & 15, tile = dg >> 3, g = dg & 7; const int c0 = g < 4 ? 128 * tile + 32 * g : FF + 128 * tile + 32 * (g - 4);
            transpose_item<true>(w_f1, NF1, 64 * kb, c0, WF1, DM, 32 * dg, 64 * kb, scr, F.lane); continue; } r -= I6;
        { const int cg = r / 44, kb = r % 44; transpose_item<true>(w_f2, DM, 64 * kb, 32 * cg, WF2, FF, 32 * cg, 64 * kb, scr, F.lane); }
    }
}

__device__ __forceinline__ void p0_prologue(Frame& F, const Args& A) {
    const int gw = F.vcu * NWAVES + F.wave, NGW = F.G * NWAVES;
    float* PMOD = WSP(float, WS_BG);
    if (F.vcu < 2 * 24 * 4) {
      float* scv = (float*)(F.lds + RING_OFF);
      f32x4* red = (f32x4*)(F.lds + RING_OFF + 40960);
      for (int i = F.tid; i < 9 * DM; i += NWAVES * 64) { const int v = i >> 10, k = i & 1023; scv[i] = silu_f(v == 0 ? F_c_ctx[k] : F_c[(v - 1) * DM + k]); }
      __syncthreads();
      for (int it = F.vcu; it < 2 * 24 * 4; it += F.G) {
        const int q = it & 3, cg = (it >> 2) % 24, l = it / 96; const int col = 256 * cg + 4 * F.lane;
        f32x4 acc[9];
#pragma unroll
        for (int v = 0; v < 9; ++v) acc[v] = (f32x4){0.f, 0.f, 0.f, 0.f};
        const int kb = 256 * q + 32 * F.wave;
        const float* wa = F_w_ada + ((size_t)l * DM + kb) * 6144 + col;
        for (int k0 = 0; k0 < 32; k0 += 16) {
            f32x4 w4[16];
#pragma unroll
            for (int k = 0; k < 16; ++k) w4[k] = __builtin_nontemporal_load((const f32x4*)(wa + (size_t)(k0 + k) * 6144));
#pragma unroll
            for (int k = 0; k < 16; ++k) { const int kk = kb + k0 + k;
#pragma unroll
                for (int v = 0; v < 9; ++v) acc[v] = acc[v] + w4[k] * scv[v * 1024 + kk]; }
        }
#pragma unroll
        for (int v = 0; v < 9; ++v) red[(F.wave * 9 + v) * 64 + F.lane] = acc[v];
        __syncthreads();
        for (int o = F.tid; o < 9 * 64; o += NWAVES * 64) { const int v = o >> 6, ln = o & 63; f32x4 s = red[v * 64 + ln];
#pragma unroll
            for (int w = 1; w < 8; ++w) s = s + red[(w * 9 + v) * 64 + ln];
            *(f32x4*)(PMOD + (((size_t)q * 2 + l) * 9 + v) * 6144 + 256 * cg + 4 * ln) = s; }
        __syncthreads();
      } }
    { bf16* DL = WSP(bf16, WS_DFTL); const int gt = (F.vcu * NWAVES + F.wave) * 64 + F.lane, NT_ = F.G * NWAVES * 64;
      for (int i = gt; i < 1024 * 128; i += NT_) { const int r = i >> 7, t0 = (i & 127) * 8; const bool cs = (r <= 512); const int rr = r < 512 ? r : (r == 512 ? 512 : r - 512); float vv[8];
#pragma unroll
          for (int j = 0; j < 8; ++j) { const int ph = (rr * (t0 + j)) & 1023; const float a = (float)ph * (1.0f / 1024.0f); vv[j] = (cs ? __builtin_amdgcn_cosf(a) : __builtin_amdgcn_sinf(a)) * (1.0f / 32.0f); }
          v4u o; o.x = pk2(vv[0], vv[1]); o.y = pk2(vv[2], vv[3]); o.z = pk2(vv[4], vv[5]); o.w = pk2(vv[6], vv[7]); *(v4u*)(DL + (size_t)r * 1024 + t0) = o; }
      bf16* DC = WSP(bf16, WS_DFTC);
      for (int i = gt; i < 256 * 32; i += NT_) { const int r = i >> 5, t0 = (i & 31) * 8; const bool cs = (r <= 128); const int rr = r < 128 ? r : (r == 128 ? 128 : r - 128); float vv[8];
#pragma unroll
          for (int j = 0; j < 8; ++j) { const int ph = (rr * (t0 + j)) & 255; const float a = (float)ph * (1.0f / 256.0f); vv[j] = (cs ? __builtin_amdgcn_cosf(a) : __builtin_amdgcn_sinf(a)) * (1.0f / 16.0f); }
          v4u o; o.x = pk2(vv[0], vv[1]); o.y = pk2(vv[2], vv[3]); o.z = pk2(vv[4], vv[5]); o.w = pk2(vv[6], vv[7]); *(v4u*)(DC + (size_t)r * 256 + t0) = o; }
      f32x2v* RP = WSP(f32x2v, WS_ROPE);
      for (int i = gt; i < 64 * 16; i += NT_) { const int pos = i >> 4, fi = i & 15; const float inv = 1.0f / powf(10000.0f, (float)fi / 16.0f); const float a = (float)pos * inv; RP[i] = (f32x2v){cosf(a), sinf(a)}; }
    }
}

__device__ __forceinline__ void norm_phase(Frame& F, const Args& A, int l, int which, int fitem = -1, gu32* fflag = nullptr, bool fused = false) {
    const int gw = F.vcu * NWAVES + F.wave, NGW = F.G * NWAVES;
    if (fused) { asm volatile("s_waitcnt vmcnt(0)" ::: "memory"); __syncthreads();
        if (fitem >= 0 && F.tid == 0) { __builtin_amdgcn_fence(__ATOMIC_RELEASE, "agent"); asm volatile("s_waitcnt vmcnt(0)" ::: "memory"); (void)__hip_atomic_fetch_add(fflag, 1u, RLX_AGENT); } }
    const float* MOD = WSP(float, WS_MOD) + (size_t)l * 9 * 6144;
    bf16* XN = WSP(bf16, WS_XN);
    float* gml = (float*)(F.lds + RING_OFF); float* shl = gml + 9 * 1024;
    bf16* wgb = (bf16*)(F.lds + RING_OFF + 73728);
    float* gpart = (float*)(F.lds + RING_OFF + 73728 + 32768);
    const bool idle0 = (which == 0 && l == 0 && F.G == 256 && F.vcu >= 192);
    if (which == 0 && l > 0 && F.G != 256) { convert_weights(F, A, l, 0, CV_END, F.vcu * NWAVES + F.wave, F.G * NWAVES); __syncthreads(); }
    if (which == 0 && l == 0) {
        const float* PMOD = WSP(float, WS_BG); float* MODW = WSP(float, WS_MOD); const size_t QS = (size_t)2 * 9 * 6144;
        for (int i4 = gw * 64 + F.lane; i4 < 2 * 9 * 6144 / 4; i4 += NGW * 64) { const size_t i = (size_t)i4 * 4;
            *(f32x4*)(MODW + i) = ((*(const f32x4*)(PMOD + i) + *(const f32x4*)(PMOD + QS + i)) + (*(const f32x4*)(PMOD + 2 * QS + i) + *(const f32x4*)(PMOD + 3 * QS + i))) + *(const f32x4*)(F_b_ada + (i / (9 * 6144)) * 6144 + (i % 6144)); }
        if (!idle0)
        for (int i4 = F.tid; i4 < 9 * 256; i4 += NWAVES * 64) { const int v = i4 >> 8, c = (i4 & 255) * 4; const size_t isc = (size_t)v * 6144 + 1024 + c, ish = (size_t)v * 6144 + c;
            const f32x4 sc = ((*(const f32x4*)(PMOD + isc) + *(const f32x4*)(PMOD + QS + isc)) + (*(const f32x4*)(PMOD + 2 * QS + isc) + *(const f32x4*)(PMOD + 3 * QS + isc))) + *(const f32x4*)(F_b_ada + 1024 + c);
            const f32x4 sh = ((*(const f32x4*)(PMOD + ish) + *(const f32x4*)(PMOD + QS + ish)) + (*(const f32x4*)(PMOD + 2 * QS + ish) + *(const f32x4*)(PMOD + 3 * QS + ish))) + *(const f32x4*)(F_b_ada + c);
            *(f32x4*)(gml + v * 1024 + c) = *(const f32x4*)(F_norm1_g + c) * (sc + 1.0f); *(f32x4*)(shl + v * 1024 + c) = sh; }
    } else { const float* ng = (which == 0 ? F_norm1_g : F_norm2_g) + (size_t)l * DM; const int o_sh = which == 0 ? 0 : 3072, o_sc = which == 0 ? 1024 : 4096;
      for (int i4 = F.tid; i4 < 9 * 256; i4 += NWAVES * 64) { const int v = i4 >> 8, c = (i4 & 255) * 4;
          *(f32x4*)(gml + v * 1024 + c) = *(const f32x4*)(ng + c) * (*(const f32x4*)(MOD + (size_t)v * 6144 + o_sc + c) + 1.0f); *(f32x4*)(shl + v * 1024 + c) = *(const f32x4*)(MOD + (size_t)v * 6144 + o_sh + c); } }
    if (which == 0) {
        const float* w_in = F_w_in + (size_t)l * DM * INC;
        if (!idle0)
        for (int i = F.tid; i < 4 * 1024; i += NWAVES * 64) { const int k = i >> 2, g4 = (i & 3) * 4; const f32x4 w4 = *(const f32x4*)(w_in + (size_t)k * INC + 2048 + g4);
#pragma unroll
            for (int j = 0; j < 4; ++j) wgb[(g4 + j) * 1024 + k] = (bf16)f2bf(w4[j]); }
        { bf16* KL = WSP(bf16, WS_KL); bf16* VL = WSP(bf16, WS_VL); const int gt = gw * 64 + F.lane, NT_ = NGW * 64;
          for (int i = gt; i < 2 * 8 * 8192; i += NT_) { const int kv = i >= 8 * 8192, r = i - kv * 8 * 8192, b = r >> 13, e = (r & 8191) * 8;
              const int es = kv ? e : (e & ~31) + ((e >> 3) & 3) * 4; const int e2 = kv ? e + 4 : es + 16;
              const float* src = (kv ? F_cache_v : F_cache_k) + ((size_t)(b * 2 + l)) * 65536; const f32x4 a = *(const f32x4*)(src + es), c4 = *(const f32x4*)(src + e2);
              v4u o; o.x = pk2(a[0], a[1]); o.y = pk2(a[2], a[3]); o.z = pk2(c4[0], c4[1]); o.w = pk2(c4[2], c4[3]);
              *(v4u*)((kv ? VL : KL) + (size_t)b * 1280 * 256 + e) = o; } }
    }
    __syncthreads();
    float* GATES = WSP(float, WS_GATES);
    const bool from_in = (l == 0 && which == 0);
    const float* xbp = from_in ? F_x_prompt : F_out; const float* xbs = from_in ? F_x_sample : F_out + (size_t)MC * DM;
    const bf16* xb16 = WSP(bf16, WS_ACAT);
    if (fused && fitem >= 0) {
        if (F.tid < 64) { asm volatile("buffer_inv sc1" ::: "memory"); unsigned sp = 0; while ((unsigned)__builtin_amdgcn_readfirstlane(__hip_atomic_load(fflag, RLX_AGENT)) < 4u) { __builtin_amdgcn_s_sleep(2); if (++sp > (1u << 22)) { if (F.tid == 0) __hip_atomic_store(F.ctl + CW_TMO, 0xBAD3u, RLX_AGENT); break; } }
            asm volatile("s_waitcnt vmcnt(0)" ::: "memory"); }
        __syncthreads(); }
    const int n_it = which == 0 ? 192 : 1;
    for (int item = fused ? (fitem >= 0 ? fitem : 192) : (which == 0 ? F.vcu : 0); item < n_it; item += fused ? 192 : (which == 0 ? F.G : 1)) {
        const int m_first = which == 0 ? 64 * item + 8 * F.wave : gw, m_step = which == 0 ? 1 : NGW, m_end = which == 0 ? 64 * item + 8 * F.wave + 8 : MTOT;
        for (int m0 = m_first; m0 < m_end; m0 += 4 * m_step) {
            f32x4 xr[4][4];
#pragma unroll
            for (int r = 0; r < 4; ++r) { const int m = m0 + r * m_step;
                if (m < m_end) { const float* xrow = m < MC ? xbp + (size_t)m * DM : xbs + (size_t)(m - MC) * DM;
#pragma unroll
                    for (int j = 0; j < 4; ++j) { if (which == 0) xr[r][j] = *(const f32x4*)(xrow + 4 * F.lane + 256 * j);
                        else { const u32x2 w = *(const u32x2*)(xb16 + (size_t)m * DM + 4 * F.lane + 256 * j); xr[r][j][0] = __builtin_bit_cast(float, w.x << 16); xr[r][j][1] = __builtin_bit_cast(float, w.x & 0xffff0000u); xr[r][j][2] = __builtin_bit_cast(float, w.y << 16); xr[r][j][3] = __builtin_bit_cast(float, w.y & 0xffff0000u); } } } }
            asm volatile("" ::: "memory");
#pragma unroll
            for (int r = 0; r < 4; ++r) { const int m = m0 + r * m_step;
                if (m < m_end) {
                    const int v = m < MC ? 0 : 1 + ((m - MC) >> 10); float s = 0.f;
#pragma unroll
                    for (int j = 0; j < 4; ++j) s += (xr[r][j][0] * xr[r][j][0] + xr[r][j][1] * xr[r][j][1]) + (xr[r][j][2] * xr[r][j][2] + xr[r][j][3] * xr[r][j][3]);
                    const float rs = 1.0f / sqrtf(wave_sum(s) * (1.0f / DM) + RMS_EPS);
#pragma unroll
                    for (int j = 0; j < 4; ++j) { const int c = 4 * F.lane + 256 * j; const f32x4 g = *(const f32x4*)(gml + v * 1024 + c), sh = *(const f32x4*)(shl + v * 1024 + c);
                        const f32x4 y = xr[r][j] * rs * g + sh;
                        u32x2 w; w.x = pk2(y[0], y[1]); w.y = pk2(y[2], y[3]); *(u32x2*)(XN + (size_t)m * DM + c) = w; }
                } }
        }
        if (which == 0) {
            __syncthreads();
            const int r16 = F.lane & 15, kq = F.lane >> 4, mt = F.wave & 3, kh = F.wave >> 2;
            const bf16* arow = XN + (size_t)(64 * item + 16 * mt + r16) * DM + 512 * kh + 8 * kq; const bf16* brow = wgb + r16 * 1024 + 512 * kh + 8 * kq;
            bf16x8 af[16];
#pragma unroll
            for (int ks = 0; ks < 16; ++ks) af[ks] = *(const bf16x8*)(arow + 32 * ks);
            f32x4 acc = (f32x4){0.f, 0.f, 0.f, 0.f};
#pragma unroll
            for (int ks = 0; ks < 16; ++ks) acc = __builtin_amdgcn_mfma_f32_16x16x32_bf16(af[ks], *(const bf16x8*)(brow + 32 * ks), acc, 0, 0, 0);
            if (kh == 1) { *(f32x4*)(gpart + ((mt * 16 + r16) * 4 + kq) * 4) = acc; }
            __syncthreads();
            if (kh == 0) { const f32x4 o = acc + *(const f32x4*)(gpart + ((mt * 16 + r16) * 4 + kq) * 4);
#pragma unroll
                for (int rg = 0; rg < 4; ++rg) GATES[(size_t)(64 * item + 16 * mt + 4 * kq + rg) * 16 + r16] = o[rg]; }
            __syncthreads();
        }
    }
    __syncthreads();
    if (which == 0 && l == 0) {
        if (F.G == 256) {
            const int I4LO = CV_MRG + CV_I2 + CV_I3;
            for (int r = 0; r < 2; ++r) {
                int lo, hi, wi, nw;
                if (idle0) { const int w = (F.vcu - 192) * NWAVES + F.wave; lo = r == 0 ? I4LO : 0; hi = r == 0 ? CV_OUT : 2048; wi = w; nw = 512; }
                else { const int w = F.vcu * NWAVES + F.wave; lo = r == 0 ? 2048 : CV_OUT; hi = r == 0 ? I4LO : CV_F1; wi = r == 0 ? w : (w + 512) % 1536; nw = 1536; }
                convert_weights(F, A, 0, lo, hi, wi, nw);
            }
        } else convert_weights(F, A, 0, 0, CV_END, F.vcu * NWAVES + F.wave, F.G * NWAVES);
    }
}

__device__ __forceinline__ void norm2_after_outproj(Frame& F, const Args& A, int l, int pm, int pn, gu32* flag) {
    asm volatile("s_waitcnt vmcnt(0)" ::: "memory"); __syncthreads();
    if (F.tid < 64) {
        if (F.tid == 0) { asm volatile("s_waitcnt vmcnt(0)" ::: "memory"); (void)__hip_atomic_fetch_add(flag, 1u, RLX_AGENT); }
        asm volatile("buffer_inv sc1" ::: "memory");
        unsigned sp = 0; while ((unsigned)__builtin_amdgcn_readfirstlane(__hip_atomic_load(flag, RLX_AGENT)) < 4u) { __builtin_amdgcn_s_sleep(2); if (++sp > (1u << 22)) { if (F.tid == 0) __hip_atomic_store(F.ctl + CW_TMO, 0xBAD2u, RLX_AGENT); break; } }
        asm volatile("s_waitcnt vmcnt(0)" ::: "memory");
    }
    __syncthreads();
    const float* MOD = WSP(float, WS_MOD) + (size_t)l * 9 * 6144; const int v = pm < 16 ? 0 : 1 + ((pm - 16) >> 2);
    const bf16* xb16 = WSP(bf16, WS_ACAT); bf16* XN = WSP(bf16, WS_XN);
    f32x4 gg[4], sh[4];
#pragma unroll
    for (int j = 0; j < 4; ++j) { const int c = 4 * F.lane + 256 * j; gg[j] = *(const f32x4*)(F_norm2_g + (size_t)l * DM + c) * (*(const f32x4*)(MOD + (size_t)v * 6144 + 4096 + c) + 1.0f); sh[j] = *(const f32x4*)(MOD + (size_t)v * 6144 + 3072 + c); }
    const int m_base = pm * 256 + pn * 64 + F.wave * 8;
    {
        u32x2 xr[8][4];
#pragma unroll
        for (int r = 0; r < 8; ++r)
#pragma unroll
            for (int j = 0; j < 4; ++j) xr[r][j] = *(const u32x2*)(xb16 + (size_t)(m_base + r) * DM + 4 * F.lane + 256 * j);
        asm volatile("" ::: "memory");
#pragma unroll
        for (int r = 0; r < 8; ++r) { const int m = m_base + r; f32x4 x[4]; float s = 0.f;
#pragma unroll
            for (int j = 0; j < 4; ++j) { const u32x2 w = xr[r][j]; x[j][0] = __builtin_bit_cast(float, w.x << 16); x[j][1] = __builtin_bit_cast(float, w.x & 0xffff0000u); x[j][2] = __builtin_bit_cast(float, w.y << 16); x[j][3] = __builtin_bit_cast(float, w.y & 0xffff0000u);
                s += (x[j][0] * x[j][0] + x[j][1] * x[j][1]) + (x[j][2] * x[j][2] + x[j][3] * x[j][3]); }
            const float rs = 1.0f / sqrtf(wave_sum(s) * (1.0f / DM) + RMS_EPS);
#pragma unroll
            for (int j = 0; j < 4; ++j) { const f32x4 y = x[j] * rs * gg[j] + sh[j]; u32x2 w; w.x = pk2(y[0], y[1]); w.y = pk2(y[2], y[3]); *(u32x2*)(XN + (size_t)m * DM + 4 * F.lane + 256 * j) = w; }
        }
    }
}

constexpr int L_AU = 0, L_AR = 8192, L_AWI = 16384, L_AEMJ = 24576, L_AWK = 32768, L_CH = 40960, L_NST = 41984, L_IV = 50176, L_SL = 52224, SL_PITCH = 72;
static_assert(L_SL + 8 * 64 * SL_PITCH * 2 <= RING_BYTES, "mLSTM LDS map");
typedef float f32x4m __attribute__((ext_vector_type(4)));
__device__ __forceinline__ f32x4 mfma16(bf16x8 a, bf16x8 b, f32x4 c) { return __builtin_amdgcn_mfma_f32_16x16x32_bf16(a, b, c, 0, 0, 0); }
__device__ __forceinline__ bf16x8 pack8(const float (&v)[8]) { v4u o; o.x = pk2(v[0], v[1]); o.y = pk2(v[2], v[3]); o.z = pk2(v[4], v[5]); o.w = pk2(v[6], v[7]); return __builtin_bit_cast(bf16x8, o); }
__device__ __forceinline__ void unpack8(bf16x8 p, float (&v)[8]) { const v4u o = __builtin_bit_cast(v4u, p);
    v[0] = __builtin_bit_cast(float, o.x << 16); v[1] = __builtin_bit_cast(float, o.x & 0xffff0000u); v[2] = __builtin_bit_cast(float, o.y << 16); v[3] = __builtin_bit_cast(float, o.y & 0xffff0000u);
    v[4] = __builtin_bit_cast(float, o.z << 16); v[5] = __builtin_bit_cast(float, o.z & 0xffff0000u); v[6] = __builtin_bit_cast(float, o.w << 16); v[7] = __builtin_bit_cast(float, o.w & 0xffff0000u); }
__device__ __forceinline__ bf16x8 conv8_nat(bf16x8 xm, bf16x8 x0, bf16x8 xp, const float* cw, float post) {
    float a[8], b[8], c[8], o[8]; unpack8(xm, a); unpack8(x0, b); unpack8(xp, c);
    const f32x4 w0a = *(const f32x4*)(cw), w0b = *(const f32x4*)(cw + 4), w1a = *(const f32x4*)(cw + 512), w1b = *(const f32x4*)(cw + 516), w2a = *(const f32x4*)(cw + 1024), w2b = *(const f32x4*)(cw + 1028);
#pragma unroll
    for (int j = 0; j < 8; ++j) { const float w0 = j < 4 ? w0a[j & 3] : w0b[j & 3], w1 = j < 4 ? w1a[j & 3] : w1b[j & 3], w2 = j < 4 ? w2a[j & 3] : w2b[j & 3];
        o[j] = silu_f(w0 * a[j] + w1 * b[j] + w2 * c[j]) * post; }
    return pack8(o);
}
template <int MASK> __device__ __forceinline__ float swz_xor(float v) { return __shfl_xor(v, MASK); }
__device__ __forceinline__ float sum_xor32(float v) { auto rr = __builtin_amdgcn_permlane32_swap(__builtin_bit_cast(unsigned, v), __builtin_bit_cast(unsigned, v), false, false); return __builtin_bit_cast(float, rr[0]) + __builtin_bit_cast(float, rr[1]); }
__device__ __forceinline__ float sum_kq(float v) { v += __shfl_xor(v, 16); v += __shfl_xor(v, 32); return v; }
__device__ __forceinline__ float sum_r16(float v) { v += swz_xor<1>(v); v += swz_xor<2>(v); v += swz_xor<4>(v); v += swz_xor<8>(v); return v; }
__device__ __forceinline__ float logsigmoid_f(float x) { return fminf(x, 0.f) - log1pf(__expf(-fabsf(x))); }

constexpr size_t PA_PLANE = (size_t)2 * 4 * MTOT;
constexpr size_t NSLOT_M = (size_t)192 * 4 * 2;
__device__ __forceinline__ void mlstm_c0(Frame& F, const Args& A, int l) {
    const int gw = F.vcu * NWAVES + F.wave, NGW = F.G * NWAVES; const int gt = gw * 64 + F.lane, NT_ = NGW * 64; const int lane = F.lane;
    const float* cwl = F_m_conv_w + (size_t)l * 3 * 512; const float* gb = F_m_gate_b + l * 16; const float* GATES = WSP(float, WS_GATES);
    const bf16* QM = WSP(bf16, WS_QM); const bf16* KM = WSP(bf16, WS_KM); const bf16* KMT = WSP(bf16, WS_KMT); const bf16* VTb = WSP(bf16, WS_VT);
    bf16* QN = WSP(bf16, WS_QN); bf16* KN = WSP(bf16, WS_KN); bf16* UT2 = WSP(bf16, WS_UT2);
    float* PA = WSP(float, WS_PA); float* CS = PA + 3 * PA_PLANE; float* NU = CS + NSLOT_M * 4 + NSLOT_M * 64;
    float* wkl = (float*)(F.lds + RING_OFF) + F.wave * 64;
    for (int it = gw; it < 192 * 4 * 2; it += NGW) { const int d = it & 1, h = (it >> 1) & 3, cgk = it >> 3; const size_t row = (size_t)cgk * 64 + lane;
        const float* gp = GATES + row * 16 + d * 8 + h; const float g_i = gp[0], g_f = gp[4];
        const bool lat = cgk >= 64; const int T = lat ? 1024 : 256; const int b = lat ? (cgk - 64) >> 4 : cgk >> 2, oc = lat ? (cgk - 64) & 15 : cgk & 3;
        const size_t tbase = lat ? (size_t)16 * 65536 + (size_t)b * 262144 : (size_t)b * 65536;
        int r16 = lane & 15, kq = lane >> 4; asm volatile("" : "+v"(r16), "+v"(kq));
        bf16x8 bfr[2][4], kfr[2][4]; float kxl[2][4], kxh[2][4];
#pragma unroll
        for (int ks = 0; ks < 2; ++ks) { const int t0 = 64 * oc + 32 * ks + 8 * kq;
#pragma unroll
            for (int nt = 0; nt < 4; ++nt) { bfr[ks][nt] = *(const bf16x8*)(VTb + tbase + (size_t)(h * 64 + 16 * nt + r16) * T + t0);
                const bf16* kr = KMT + tbase + (size_t)(h * 64 + 16 * nt + r16) * T; kfr[ks][nt] = *(const bf16x8*)(kr + t0); kxl[ks][nt] = t0 > 0 ? bf2f(kr[t0 - 1]) : 0.f; kxh[ks][nt] = t0 + 8 < T ? bf2f(kr[t0 + 8]) : 0.f; } }
        const float li = g_i + gb[d * 8 + h]; const float lf = logsigmoid_f(g_f + gb[d * 8 + 4 + h]);
        float bs = lf;
#pragma unroll
        for (int off = 1; off < 64; off <<= 1) { const float o = d ? __shfl_down(bs, off) : __shfl_up(bs, off); const bool ok = d ? (lane + off < 64) : (lane >= off); if (ok) bs += o; }
        const float r = li - bs; float pm = r;
#pragma unroll
        for (int off = 1; off < 64; off <<= 1) { const float o = d ? __shfl_down(pm, off) : __shfl_up(pm, off); const bool ok = d ? (lane + off < 64) : (lane >= off); if (ok) pm = fmaxf(pm, o); }
        const float bl = __shfl(bs, d ? 0 : 63), rmax = __shfl(pm, d ? 0 : 63);
        float* pp = PA + ((size_t)d * 4 + h) * MTOT + row; pp[0] = bs; pp[PA_PLANE] = r; pp[2 * PA_PLANE] = pm;
        const size_t slot = ((size_t)cgk * 4 + h) * 2 + d;
        if (lane == 0) { float* cs = CS + slot * 4; cs[0] = bl; cs[1] = bl + rmax; }
        wkl[lane] = __expf(r - rmax);
        f32x4 U[4][4];
#pragma unroll
        for (int mt = 0; mt < 4; ++mt)
#pragma unroll
            for (int nt = 0; nt < 4; ++nt) U[mt][nt] = (f32x4){0.f, 0.f, 0.f, 0.f};
        float nsum[4] = {0.f, 0.f, 0.f, 0.f};
#pragma unroll
        for (int ks = 0; ks < 2; ++ks) {
            const f32x4 wk0 = *(const f32x4*)(wkl + 32 * ks + 8 * kq), wk1 = *(const f32x4*)(wkl + 32 * ks + 8 * kq + 4);
#pragma unroll
            for (int mt = 0; mt < 4; ++mt) { const int ch = h * 64 + 16 * mt + r16;
                const float cw0 = cwl[256 + ch], cw1 = cwl[512 + 256 + ch], cw2 = cwl[1024 + 256 + ch];
                float x[10]; { float xx[8]; unpack8(kfr[ks][mt], xx);
#pragma unroll
                    for (int j = 0; j < 8; ++j) x[j + 1] = xx[j]; }
                x[0] = kxl[ks][mt]; x[9] = kxh[ks][mt];
                float kt[8];
#pragma unroll
                for (int j = 0; j < 8; ++j) { kt[j] = silu_f(cw0 * x[j] + cw1 * x[j + 1] + cw2 * x[j + 2]) * 0.125f * (j < 4 ? wk0[j & 3] : wk1[j & 3]); nsum[mt] += kt[j]; }
                const bf16x8 af = pack8(kt);
#pragma unroll
                for (int nt = 0; nt < 4; ++nt) U[mt][nt] = mfma16(af, bfr[ks][nt], U[mt][nt]); }
        }
        bf16* us = UT2 + slot * 4096;
#pragma unroll
        for (int mt = 0; mt < 4; ++mt) { const float ns = sum_kq(nsum[mt]); if (kq == 0) NU[slot * 64 + 16 * mt + r16] = ns;
#pragma unroll
            for (int nt = 0; nt < 4; ++nt) { u32x2 w; w.x = pk2(U[mt][nt][0], U[mt][nt][1]); w.y = pk2(U[mt][nt][2], U[mt][nt][3]); *(u32x2*)(us + (16 * nt + r16) * 64 + 16 * mt + 4 * kq) = w; } }
    }
    { const bf16x8 z8 = {0, 0, 0, 0, 0, 0, 0, 0};
      for (int i = gt; i < MTOT * 32; i += NT_) { const int row = i >> 5, col = 8 * (i & 31); const int t = row < MC ? (row & 255) : ((row - MC) & 1023), T = row < MC ? 256 : 1024; const size_t off = (size_t)row * 256 + col;
        const bf16x8 q0 = *(const bf16x8*)(QM + off), qm_ = t > 0 ? *(const bf16x8*)(QM + off - 256) : z8, qp = t + 1 < T ? *(const bf16x8*)(QM + off + 256) : z8;
        const bf16x8 k0 = *(const bf16x8*)(KM + off), km_ = t > 0 ? *(const bf16x8*)(KM + off - 256) : z8, kp = t + 1 < T ? *(const bf16x8*)(KM + off + 256) : z8;
        *(bf16x8*)(QN + off) = conv8_nat(qm_, q0, qp, cwl + col, 1.0f); *(bf16x8*)(KN + off) = conv8_nat(km_, k0, kp, cwl + 256 + col, 0.125f); } }
}
__device__ __forceinline__ void mlstm_m1(Frame& F, const Args& A, int l, int b, int h, bool ctx, gu32* flag) {
    const int T = ctx ? 256 : 1024, nc = T >> 6;
    const size_t R0 = ctx ? (size_t)b * 256 : (size_t)MC + (size_t)b * 1024;
    int tid = F.tid; asm volatile("" : "+v"(tid));
    float* CDEC = (float*)(F.lds + L_CH); float* CE = CDEC + 32;
    bf16* CT = WSP(bf16, WS_CT); const bf16* UT2 = WSP(bf16, WS_UT2); float* PA = WSP(float, WS_PA); float* CS = PA + 3 * PA_PLANE; float* NSTG = CS + NSLOT_M * 4; const float* NU = NSTG + NSLOT_M * 64;
    if (tid < 2) { const int d = tid; float mm = ctx ? 0.f : F_state_m[((b * 2 + l) * 2 + d) * 4 + h];
        float bl_[16], a_[16];
#pragma unroll
        for (int k = 0; k < 16; ++k) { if (k < nc) { const float* cs = CS + ((((R0 >> 6) + k) * 4 + h) * 2 + d) * 4; bl_[k] = cs[0]; a_[k] = cs[1]; } else { bl_[k] = 0.f; a_[k] = 0.f; } }
#pragma unroll
        for (int k = 0; k < 16; ++k) { const int oc = d ? nc - 1 - k : k;
            if (k < nc) { float bl = 0.f, aa = 0.f;
#pragma unroll
                for (int q = 0; q < 16; ++q) { if (q == oc) { bl = bl_[q]; aa = a_[q]; } }
                float* cs = CS + ((((R0 >> 6) + oc) * 4 + h) * 2 + d) * 4; cs[2] = mm; const float mn = fmaxf(bl + mm, aa);
                CDEC[d * 16 + oc] = __expf(bl + mm - mn); CE[d * 16 + oc] = __expf(aa - mn); cs[3] = mn; mm = mn; } }
        if (ctx) F_out[OFF_NM + ((b * 2 + l) * 2 + d) * 4 + h] = mm; }
    __syncthreads();
    {
        const int d = tid >> 8, e = tid & 255, dv = e >> 2, dk0 = (e & 3) * 16;
        float C[16]; float nval = 0.f;
        if (ctx) {
#pragma unroll
            for (int i = 0; i < 16; ++i) C[i] = 0.f;
        } else {
            const float* sc = F_state_C + (size_t)(((b * 2 + l) * 2 + d) * 4 + h) * 4096;
#pragma unroll
            for (int i = 0; i < 16; ++i) C[i] = sc[(dk0 + i) * 64 + dv];
            if (e < 64) nval = F_state_n[(size_t)(((b * 2 + l) * 2 + d) * 4 + h) * 64 + e];
        }
        for (int k0 = 0; k0 < nc; k0 += 4) {
            bf16x8 u[4][2]; float nu[4];
#pragma unroll
            for (int kk = 0; kk < 4; ++kk) { const int oc = d ? nc - 1 - (k0 + kk) : k0 + kk; const size_t slot = (((R0 >> 6) + oc) * 4 + h) * 2 + d;
                u[kk][0] = *(const bf16x8*)(UT2 + slot * 4096 + 16 * e); u[kk][1] = *(const bf16x8*)(UT2 + slot * 4096 + 16 * e + 8); nu[kk] = e < 64 ? NU[slot * 64 + e] : 0.f; }
#pragma unroll
            for (int kk = 0; kk < 4; ++kk) { const int oc = d ? nc - 1 - (k0 + kk) : k0 + kk; const size_t slot = (((R0 >> 6) + oc) * 4 + h) * 2 + d;
                float lo[8], hi[8];
#pragma unroll
                for (int i = 0; i < 8; ++i) { lo[i] = C[i]; hi[i] = C[8 + i]; }
                *(bf16x8*)(CT + slot * 4096 + 16 * e) = pack8(lo); *(bf16x8*)(CT + slot * 4096 + 16 * e + 8) = pack8(hi);
                if (e < 64) NSTG[slot * 64 + e] = nval;
                const float dec = CDEC[d * 16 + oc], we = CE[d * 16 + oc]; float ul[8], uh[8]; unpack8(u[kk][0], ul); unpack8(u[kk][1], uh);
#pragma unroll
                for (int i = 0; i < 8; ++i) { C[i] = dec * C[i] + we * ul[i]; C[8 + i] = dec * C[8 + i] + we * uh[i]; }
                nval = dec * nval + we * nu[kk]; }
        }
        if (ctx) {
            float* oc_ = F_out + OFF_NC + (size_t)(((b * 2 + l) * 2 + d) * 4 + h) * 4096;
#pragma unroll
            for (int i = 0; i < 16; ++i) oc_[(dk0 + i) * 64 + dv] = C[i];
            if (e < 64) F_out[OFF_NN + (size_t)(((b * 2 + l) * 2 + d) * 4 + h) * 64 + e] = nval;
        }
    }
    asm volatile("s_waitcnt vmcnt(0)" ::: "memory");
    __syncthreads();
    if (tid == 0) { __builtin_amdgcn_fence(__ATOMIC_RELEASE, "agent"); asm volatile("s_waitcnt vmcnt(0)" ::: "memory"); __hip_atomic_store(flag, 1u, RLX_AGENT); }
}
__device__ __forceinline__ void mlstm_wait(Frame& F, gu32* flag) {
    if (F.tid < 64) { asm volatile("buffer_inv sc1" ::: "memory"); unsigned sp = 0; while ((unsigned)__builtin_amdgcn_readfirstlane(__hip_atomic_load(flag, RLX_AGENT)) == 0u) { __builtin_amdgcn_s_sleep(4); if (++sp > (1u << 24)) { if (F.tid == 0) __hip_atomic_store(F.ctl + CW_TMO, 0xBAD1u, RLX_AGENT); break; } }
        asm volatile("s_waitcnt vmcnt(0)" ::: "memory"); }
    __syncthreads();
}
__device__ __forceinline__ void mlstm_m2_item(Frame& F, const Args& A, int l, int b, int h, bool ctx, int oc, int tid_in) {
    const int T = ctx ? 256 : 1024;
    const size_t R0 = ctx ? (size_t)b * 256 : (size_t)MC + (size_t)b * 1024;
    const size_t tbase = ctx ? (size_t)b * 65536 : (size_t)16 * 65536 + (size_t)b * 262144;
    int tid = tid_in; asm volatile("" : "+v"(tid)); const int lane = tid & 63, wave = __builtin_amdgcn_readfirstlane(tid >> 6);
    float* IV = (float*)(F.lds + L_IV) + wave * 64; bf16* SL = (bf16*)(F.lds + L_SL) + wave * 64 * SL_PITCH;
    const bf16* VT = WSP(bf16, WS_VT) + tbase; const bf16* OM = WSP(bf16, WS_OM); const bf16* QN = WSP(bf16, WS_QN); const bf16* KN = WSP(bf16, WS_KN);
    const bf16* CT = WSP(bf16, WS_CT); float* HF = WSP(float, WS_HF); bf16* AC = WSP(bf16, WS_ACAT); const float* PA = WSP(float, WS_PA); const float* CS = PA + 3 * PA_PLANE; const float* NSTG = CS + NSLOT_M * 4;
    const int tq = 64 * oc;
    unsigned hfp[4][4][2];
#pragma unroll
    for (int d = 0; d < 2; ++d) {
            int r16 = lane & 15, kq = lane >> 4; asm volatile("" : "+v"(r16), "+v"(kq));
            const float* pu = PA + ((size_t)d * 4 + h) * MTOT + R0 + tq;
            const size_t slot = (((R0 >> 6) + oc) * 4 + h) * 2 + d;
            bf16x8 Qf[4][2]; f32x4 rs4[4]; float bsv[4], pmv[4]; f32x4 nv[2][2];
#pragma unroll
            for (int mt = 0; mt < 4; ++mt) {
#pragma unroll
                for (int ks = 0; ks < 2; ++ks) { const int t = tq + 16 * mt + r16, col = h * 64 + 32 * ks + 8 * kq; Qf[mt][ks] = *(const bf16x8*)(QN + (R0 + t) * 256 + col); }
                rs4[mt] = *(const f32x4*)(pu + PA_PLANE + 16 * mt + 4 * kq); bsv[mt] = pu[16 * mt + r16]; pmv[mt] = pu[2 * PA_PLANE + 16 * mt + r16]; }
            const float ms = CS[slot * 4 + 2];
            const float* nst = NSTG + slot * 64;
#pragma unroll
            for (int ks = 0; ks < 2; ++ks) { nv[ks][0] = *(const f32x4*)(nst + 32 * ks + 8 * kq); nv[ks][1] = *(const f32x4*)(nst + 32 * ks + 8 * kq + 4); }
            bf16x8 Kfa[4][2];
#pragma unroll
            for (int st = 0; st < 4; ++st)
#pragma unroll
                for (int ks = 0; ks < 2; ++ks) Kfa[st][ks] = *(const bf16x8*)(KN + (R0 + tq + 16 * st + r16) * 256 + h * 64 + 32 * ks + 8 * kq);
            float ul[4], wil[4], emj[4], rowsum[4];
#pragma unroll
            for (int lt = 0; lt < 4; ++lt) { const float bs = bsv[lt], pm = pmv[lt]; const float mj = bs + fmaxf(ms, pm);
                ul[lt] = (bs - mj) * LOG2E; wil[lt] = __expf(bs + ms - mj); emj[lt] = __expf(-mj); rowsum[lt] = 0.f; rs4[lt] = rs4[lt] * LOG2E; }
#pragma unroll
            for (int st = 0; st < 4; ++st) {
                const bf16x8* Kf = Kfa[st];
#pragma unroll
                for (int lt = 0; lt < 4; ++lt) {
                    const bool live = d ? (st >= lt) : (st <= lt);
                    u32x2 w; w.x = 0u; w.y = 0u;
                    if (live) {
                        f32x4 sacc = (f32x4){0.f, 0.f, 0.f, 0.f};
                        sacc = mfma16(Kf[0], Qf[lt][0], sacc); sacc = mfma16(Kf[1], Qf[lt][1], sacc);
                        f32x4 val;
#pragma unroll
                        for (int rg = 0; rg < 4; ++rg) { const int sl = 16 * st + 4 * kq + rg, ll = 16 * lt + r16; const bool ok = d ? (sl >= ll) : (sl <= ll);
                            val[rg] = ok ? sacc[rg] * __builtin_amdgcn_exp2f(ul[lt] + rs4[st][rg]) : 0.f; }
                        rowsum[lt] += (val[0] + val[1]) + (val[2] + val[3]);
                        w.x = pk2(val[0], val[1]); w.y = pk2(val[2], val[3]);
                    }
                    *(u32x2*)(SL + (16 * lt + r16) * SL_PITCH + 16 * st + 4 * kq) = w;
                }
            }
            const bf16* cts = CT + slot * 4096;
            float inv[4];
#pragma unroll
            for (int mt = 0; mt < 4; ++mt) { float qn = 0.f;
#pragma unroll
                for (int ks = 0; ks < 2; ++ks) { float q8[8]; unpack8(Qf[mt][ks], q8);
#pragma unroll
                    for (int j = 0; j < 8; ++j) qn += q8[j] * (j < 4 ? nv[ks][0][j & 3] : nv[ks][1][j & 3]); }
                float a = sum_kq(rowsum[mt] + wil[mt] * qn);
                inv[mt] = 1.0f / fmaxf(fabsf(a), emj[mt]);
                if (kq == 0) IV[16 * mt + r16] = inv[mt]; }
            f32x4 H[4][4];
#pragma unroll
            for (int mt = 0; mt < 4; ++mt)
#pragma unroll
                for (int nt = 0; nt < 4; ++nt) H[mt][nt] = (f32x4){0.f, 0.f, 0.f, 0.f};
#pragma unroll
            for (int ks = 0; ks < 2; ++ks) {
                bf16x8 vbk[4], cbk[4];
#pragma unroll
                for (int nt = 0; nt < 4; ++nt) { vbk[nt] = *(const bf16x8*)(VT + (size_t)(h * 64 + 16 * nt + r16) * T + tq + 32 * ks + 8 * kq); cbk[nt] = *(const bf16x8*)(cts + (16 * nt + r16) * 64 + 32 * ks + 8 * kq); }
#pragma unroll
                for (int mt = 0; mt < 4; ++mt) {
                    const bf16x8 sa = *(const bf16x8*)(SL + (16 * mt + r16) * SL_PITCH + 32 * ks + 8 * kq);
                    float q8[8]; unpack8(Qf[mt][ks], q8);
#pragma unroll
                    for (int j = 0; j < 8; ++j) q8[j] *= wil[mt];
                    const bf16x8 qa = pack8(q8);
#pragma unroll
                    for (int nt = 0; nt < 4; ++nt) { H[mt][nt] = mfma16(sa, vbk[nt], H[mt][nt]); H[mt][nt] = mfma16(qa, cbk[nt], H[mt][nt]); }
                }
            }
            if (d == 0) {
#pragma unroll
                for (int mt = 0; mt < 4; ++mt) { const f32x4 iv4 = *(const f32x4*)(IV + 16 * mt + 4 * kq);
#pragma unroll
                    for (int nt = 0; nt < 4; ++nt) { hfp[mt][nt][0] = pk2(H[mt][nt][0] * iv4[0], H[mt][nt][1] * iv4[1]); hfp[mt][nt][1] = pk2(H[mt][nt][2] * iv4[2], H[mt][nt][3] * iv4[3]); } }
            } else {
                float gmn[4];
#pragma unroll
                for (int nt = 0; nt < 4; ++nt) gmn[nt] = F_m_norm_g[l * 256 + h * 64 + 16 * nt + r16];
#pragma unroll
                for (int mt = 0; mt < 4; ++mt) { const f32x4 iv4 = *(const f32x4*)(IV + 16 * mt + 4 * kq);
#pragma unroll
                    for (int rg = 0; rg < 4; ++rg) {
                        float hs[4], ss = 0.f;
#pragma unroll
                        for (int nt = 0; nt < 4; ++nt) { const unsigned pw = hfp[mt][nt][rg >> 1]; const float hf = __builtin_bit_cast(float, (rg & 1) ? (pw & 0xffff0000u) : (pw << 16));
                            hs[nt] = H[mt][nt][rg] * iv4[rg] + hf; ss += hs[nt] * hs[nt]; }
                        ss = sum_r16(ss);
                        const float rs = 1.0f / sqrtf(ss * (1.0f / 64.0f) + RMS_EPS);
#pragma unroll
                        for (int nt = 0; nt < 4; ++nt) SL[(16 * mt + 4 * kq + rg) * SL_PITCH + 16 * nt + r16] = (bf16)f2bf(hs[nt] * rs * gmn[nt]);
                    }
                }
                { const size_t row = R0 + tq + lane; const bf16* omr = OM + row * 256 + h * 64; bf16* acr = AC + row * KMRG + 512 + h * 64;
                  bf16x8 og[8];
#pragma unroll
                  for (int c8 = 0; c8 < 8; ++c8) og[c8] = *(const bf16x8*)(omr + 8 * c8);
#pragma unroll
                  for (int c8 = 0; c8 < 8; ++c8) { float yv[8], gv[8]; unpack8(*(const bf16x8*)(SL + lane * SL_PITCH + 8 * c8), yv); unpack8(og[c8], gv);
#pragma unroll
                      for (int q = 0; q < 8; ++q) yv[q] *= gv[q];
                      *(bf16x8*)(acr + 8 * c8) = pack8(yv); } }
            }
    }
}

constexpr int QU_TOTAL = 624;
__device__ __forceinline__ void mixer_phase(Frame& F, const Args& A, int l) {
    gu32* qhead = F.ctl + CW_QUEUE + 64 * l;
    gu32* mflag = F.ctl + CW_MFLAG + 64 * (l * 96);
    bool first = true;
    for (;;) {
        __syncthreads();
        if (F.tid == 0) F.MISC[16] = first ? (unsigned)blockIdx.x : (unsigned)F.G + __hip_atomic_fetch_add(qhead, 1u, RLX_AGENT);
        first = false;
        __syncthreads();
        const int qpos = (int)F.MISC[16];
        if (qpos >= QU_TOTAL) break;
        const int u = qpos < 224 ? qpos : qpos < 480 ? qpos + 32 : qpos < 496 ? qpos + 32 : qpos + 48;
        { int tl = threadIdx.x; asm volatile("" : "+v"(tl)); F.tid = tl; F.lane = tl & 63; F.wave = __builtin_amdgcn_readfirstlane(tl >> 6);
          size_t z_ = 0; asm volatile("" : "+s"(z_)); F.ws = A.ws + z_; F.out = A.out + z_; }
#ifdef PROF_UNIT
        const unsigned long long pu_t0 = __builtin_amdgcn_s_memrealtime();
#endif
        const bf16* Qb = WSP(bf16, WS_Q); bf16* AC = WSP(bf16, WS_ACAT);
        if (u < 96) { const bool ctx = u >= 32;
            const int j = ctx ? u - 32 : u;
            if (T_MASK & 0x100) mlstm_m1(F, A, l, j >> 2, j & 3, ctx, mflag + 64 * u); }
        else if (u < 192) {
            const bool ctx = u >= 160; const int j = ctx ? u - 160 : u - 96;
            const int bh0 = ctx ? (j >> 1) * 4 + (j & 1) * 2 : (j >> 1);
            if (T_MASK & 0x100) {
                mlstm_wait(F, mflag + 64 * (ctx ? 32 + bh0 : bh0));
                if (ctx) mlstm_wait(F, mflag + 64 * (32 + bh0 + 1));
                const int bh = ctx ? bh0 + (F.wave >> 2) : bh0; const int oc = ctx ? (F.wave & 3) : (j & 1) * 8 + F.wave;
                mlstm_m2_item(F, A, l, bh >> 2, bh & 3, ctx, oc, F.tid);
            }
        }
        else if (u < 256 || (u >= 512 && u < 544)) {
            const bool lat = u < 256; const int j = lat ? u - 192 : u - 512;
            pg8::OneUnit S; S.u.pm = lat ? (j >> 3) : 0; S.u.pn = lat ? (j & 7) : j;
            pg8::Gemm g; g.A = lat ? WSP(const pg8::bf16_t, WS_DFTL) : WSP(const pg8::bf16_t, WS_DFTC);
            g.Bt = WSP(const pg8::bf16_t, WS_UT) + (lat ? (size_t)16 * 65536 : 0); g.M = lat ? 1024 : 256; g.N = lat ? 2048 : 4096; g.K = lat ? 1024 : 256;
            pg8::EpiFourier E; E.AC = (pg8::bf16_t*)AC; E.lat = lat ? 1 : 0;
            if (T_MASK & 0x200) pg8::gemm_phase<pg8::EpiFourier, pg8::OneUnit, false, true>(F.ldsl + RING_OFF, g, S, E, F.tid);
        }
        else { const bool lat = u < 512; const int j = lat ? u - 256 : u - 544; const int b = lat ? (j >> 5) : (j >> 3), qh = lat ? ((j >> 2) & 7) : (j & 7), qb = lat ? (j & 3) : 0;
            const size_t row0 = lat ? (size_t)MC + (size_t)b * 1024 + (size_t)qb * 256 : (size_t)b * 256;
            const bf16* Kp = (lat ? WSP(bf16, WS_KL) + (size_t)b * 1280 * 256 : WSP(bf16, WS_KC) + (size_t)b * 65536) + (qh >> 1) * 64;
            const bf16* Vp = (lat ? WSP(bf16, WS_VL) + (size_t)b * 1280 * 256 : WSP(bf16, WS_VC) + (size_t)b * 65536) + (qh >> 1) * 64;
            if (T_MASK & 0x400) attn_body::attn_unit<8>((const attn_body::bf16*)(Qb + row0 * 512 + qh * 64), 512, (const attn_body::bf16*)Kp, (const attn_body::bf16*)Vp, 256, lat ? 20 : 4,
                (attn_body::bf16*)(AC + row0 * KMRG + qh * 64), KMRG, (char*)F.lds + RING_OFF, F.tid); }
#ifdef PROF_UNIT
        if (l == 0 && F.tid == 0) { const int ty = u < 32 ? 0 : u < 96 ? 2 : u < 160 ? 6 : u < 192 ? 7 : u < 256 ? 1 : u < 512 ? 3 : u < 544 ? 4 : 5;
            unsigned* pc = (unsigned*)(A.ws + CTL_ZERO_BYTES - 12288); const unsigned dt = (unsigned)(__builtin_amdgcn_s_memrealtime() - pu_t0); atomicAdd(pc + 2 * ty, dt); atomicAdd(pc + 2 * ty + 1, 1u); atomicAdd(pc + 16, dt); pc[17] = 256u; }
#endif
    }
}

#ifdef PROF_GEMM
#define PROFP(kk) ((l == 0 && (kk) == PROF_GEMM) ? (unsigned*)(A.ws + CTL_ZERO_BYTES - 16384) : (unsigned*)nullptr)
#else
#define PROFP(kk) ((unsigned*)nullptr)
#endif
__global__ void __launch_bounds__(NWAVES * 64, 2) mk_fwd(const Args A) {
    extern __shared__ __attribute__((aligned(16))) unsigned char lds[];
    Frame F;
    F.lds = lds; F.ldsl = (LAS unsigned char*)lds;
    F.MISC = (volatile LAS unsigned*)(F.ldsl + MISC_OFF);
    F.tid = threadIdx.x; F.lane = F.tid & 63; F.wave = __builtin_amdgcn_readfirstlane(F.tid >> 6);
    F.G = gridDim.x; { const int bx = blockIdx.x; F.vcu = (F.G % 8 == 0) ? (bx % 8) * (F.G / 8) + bx / 8 : bx; }
    F.ctl = (gu32*)(A.ws + WS_CTL);
    for (int u = F.tid; u < (LDS_BYTES - LDSCTL_OFF) / 4; u += NWAVES * 64) ((LAS unsigned*)(F.ldsl + LDSCTL_OFF))[u] = 0u;
    __syncthreads();
    XcdBarrier bar; bar.bar = (unsigned*)(F.ctl + CW_BAR) + A.li * XCD_BAR_WORDS; bar.x = 0; bar.st = nullptr;
    bar = xcd_barrier_post((unsigned*)(F.ctl + CW_BAR) + A.li * XCD_BAR_WORDS, F.MISC + 8);
#ifdef PROF_PHASE
    unsigned long long* stamps = (unsigned long long*)(A.ws + CTL_ZERO_BYTES - 8192);
    if (blockIdx.x == 0 && threadIdx.x == 0) stamps[0] = __builtin_amdgcn_s_memrealtime();
#endif
    for (int ph = A.ph_lo; ph < A.ph_hi; ++ph) {
        { int tl = threadIdx.x; asm volatile("" : "+v"(tl)); F.tid = tl; F.lane = tl & 63; F.wave = __builtin_amdgcn_readfirstlane(tl >> 6);
          size_t z_ = 0; asm volatile("" : "+s"(z_)); F.ws = A.ws + z_; F.out = A.out + z_; }
        if (ph == 0) { if (T_MASK & 1) p0_prologue(F, A); }
        else {
            const int l = (ph - 1) >> 3, k = (ph - 1) & 7;
            if (k == 0) { if (T_MASK & 2) {
                int fitem = -1; gu32* ff = nullptr; const bool fused = (l == 1 && F.G == 256);
                if (fused) { pg8::StaticOrder S; S.init(MTOT, DM, F.G, (int)blockIdx.x); pg8::Unit u0; if (S.next(0, u0)) { fitem = u0.pm * 4 + u0.pn; ff = F.ctl + CW_HFLAG + 64 * u0.pm; } }
                norm_phase(F, A, l, 0, fitem, ff, fused);
            } }
            else if (k == 1) { if (T_MASK & 4) {
                pg8::Gemm g{WSP(const pg8::bf16_t, WS_XN), WSP(const pg8::bf16_t, WS_WIN), MTOT, NIN, DM}; pg8::StaticOrder S; S.init(MTOT, NIN, F.G, (int)blockIdx.x);
                pg8::EpiIn E; E.layer = l; E.Q = WSP(pg8::bf16_t, WS_Q); E.KC = WSP(pg8::bf16_t, WS_KC); E.VC = WSP(pg8::bf16_t, WS_VC); E.KL = WSP(pg8::bf16_t, WS_KL); E.VL = WSP(pg8::bf16_t, WS_VL);
                E.QM = WSP(pg8::bf16_t, WS_QM); E.KM = WSP(pg8::bf16_t, WS_KM); E.KMT = WSP(pg8::bf16_t, WS_KMT); E.VT = WSP(pg8::bf16_t, WS_VT); E.OM = WSP(pg8::bf16_t, WS_OM); E.UT = WSP(pg8::bf16_t, WS_UT);
                E.BG = WSP(unsigned char, WS_BG); E.onk = F_out + OFF_NK; E.onv = F_out + OFF_NV; E.qg = F_q_norm_g + l * 64; E.kg = F_k_norm_g + l * 64; E.rope = (const PG8_LAS pg8::f32x2v*)(F.ldsl + SPARE_ROPE); E.stage = (PG8_LAS pg8::bf16_t*)(F.ldsl + SPARE_STAGE);
                { const v4u* rsrc = WSP(const v4u, WS_ROPE); ((LAS v4u*)(F.ldsl + SPARE_ROPE))[F.tid] = rsrc[F.tid]; __syncthreads(); }
                pg8::gemm_phase<pg8::EpiIn, pg8::StaticOrder, true, true>(F.ldsl + RING_OFF, g, S, E, F.tid, PROFP(1));
            } }
            else if (k == 2) { if (T_MASK & 8) {
#ifdef PROF_UNIT
                const unsigned long long c0_t0 = __builtin_amdgcn_s_memrealtime();
#endif
                mlstm_c0(F, A, l); xcd_barrier(bar);
#ifdef PROF_UNIT
                if (l == 0 && blockIdx.x == 0 && F.tid == 0) { unsigned* pc = (unsigned*)(A.ws + CTL_ZERO_BYTES - 12288); pc[18] = (unsigned)(__builtin_amdgcn_s_memrealtime() - c0_t0); pc[19] = 1u; }
#endif
                mixer_phase(F, A, l); } }
            else if (k == 3) { if (T_MASK & 16) {
                pg8::Gemm g{WSP(const pg8::bf16_t, WS_ACAT), WSP(const pg8::bf16_t, WS_WMRG), MTOT, DM, KMRG}; pg8::StaticOrder S; S.init(MTOT, DM, F.G, (int)blockIdx.x);
                pg8::EpiMerge E; E.BG = WSP(const unsigned char, WS_BG); E.O = WSP(pg8::bf16_t, WS_MRGD);
                pg8::gemm_phase<pg8::EpiMerge, pg8::StaticOrder, true, true>(F.ldsl + RING_OFF, g, S, E, F.tid, PROFP(3));
                if (l == 0 && F.G == 256 && blockIdx.x >= 192) convert_weights(F, A, 0, CV_F1, CV_F2, ((int)blockIdx.x - 192) * NWAVES + F.wave, 64 * NWAVES);
                if (l == 0 && F.G == 256 && blockIdx.x >= 192) convert_weights(F, A, 1, 0, CV_MRG, ((int)blockIdx.x - 192) * NWAVES + F.wave, 64 * NWAVES);
                if (l == 1 && F.G == 256 && blockIdx.x >= 192) convert_weights(F, A, 1, CV_F2, CV_END, ((int)blockIdx.x - 192) * NWAVES + F.wave, 64 * NWAVES);
            } }
            else if (k == 4 || k == 7) { if (T_MASK & 32) {
                pg8::Gemm g; g.M = MTOT; g.N = DM;
                if (k == 4) { g.A = WSP(const pg8::bf16_t, WS_MRGD); g.Bt = WSP(const pg8::bf16_t, WS_WOUT); g.K = DM; } else { g.A = WSP(const pg8::bf16_t, WS_HID); g.Bt = WSP(const pg8::bf16_t, WS_WF2); g.K = FF; }
                pg8::StaticOrder S; S.init(MTOT, DM, F.G, (int)blockIdx.x);
                pg8::EpiRes E; const bool first = (l == 0 && k == 4);
                E.mode = (k == 4) ? 0 : 1; E.xb = WSP(pg8::bf16_t, WS_ACAT);
                gu32* gflag = F.ctl + CW_GFLAG + 64 * l; E.wflag = (k == 7 && F.G == 256) ? (unsigned*)gflag : (unsigned*)nullptr; E.wneed = 32u;
                E.xin_p = first ? F_x_prompt : F_out; E.xin_s = first ? F_x_sample : F_out + (size_t)MC * DM; E.xout = F_out; E.gate = WSP(const float, WS_MOD) + (size_t)l * 9 * 6144 + (k == 4 ? 2048 : 5120);
                pg8::gemm_phase<pg8::EpiRes, pg8::StaticOrder, true, true>(F.ldsl + RING_OFF, g, S, E, F.tid, PROFP(k));
                if (k == 7 && F.G == 256 && blockIdx.x >= 192 && blockIdx.x < 224) {
                    const int j = (int)blockIdx.x - 192, x = j & 7, a = j >> 3;
                    pg8::Gemm g2{WSP(const pg8::bf16_t, WS_XN), WSP(const pg8::bf16_t, WS_WF1), MTOT, NF1, DM}; pg8::FlagUnit S2; S2.u.pm = 2 * x + (a >> 1); S2.u.pn = 20 + (a & 1); S2.flag = (unsigned*)gflag;
                    pg8::EpiSwiGLU E2; E2.H = WSP(pg8::bf16_t, WS_HID);
                    pg8::gemm_phase<pg8::EpiSwiGLU, pg8::FlagUnit, true, true>(F.ldsl + RING_OFF, g2, S2, E2, F.tid);
                }
                if (l == 0 && F.G == 256 && blockIdx.x >= 192) { if (k == 4) { convert_weights(F, A, 0, CV_F2, CV_END, ((int)blockIdx.x - 192) * NWAVES + F.wave, 64 * NWAVES);
                        convert_weights(F, A, 1, CV_MRG, CV_OUT, ((int)blockIdx.x - 192) * NWAVES + F.wave, 64 * NWAVES); }
                    else { convert_weights(F, A, 1, CV_OUT, CV_F1, ((int)blockIdx.x - 192) * NWAVES + F.wave, 64 * NWAVES);
                        { unsigned sp = 0; while (__hip_atomic_load(gflag, RLX_AGENT) < 32u) { __builtin_amdgcn_s_sleep(8); if (++sp > (1u << 22)) break; } __builtin_amdgcn_fence(__ATOMIC_ACQUIRE, "agent"); }
                        convert_weights(F, A, 1, CV_F1, CV_F2, ((int)blockIdx.x - 192) * NWAVES + F.wave, 64 * NWAVES); } }
            } }
            else if (k == 5) { if (T_MASK & 64) {
                if (F.G != 256) norm_phase(F, A, l, 1);
                else { pg8::StaticOrder S; S.init(MTOT, DM, F.G, (int)blockIdx.x); pg8::Unit u0;
                    if (S.next(0, u0)) { const int pm = __builtin_amdgcn_readfirstlane(u0.pm), pn = __builtin_amdgcn_readfirstlane(u0.pn); norm2_after_outproj(F, A, l, pm, pn, F.ctl + CW_EFLAG + 64 * (l * 48 + pm)); } }
            } }
            else if (T_MASK & 128) {
                pg8::Gemm g{WSP(const pg8::bf16_t, WS_XN), WSP(const pg8::bf16_t, WS_WF1), MTOT, NF1, DM}; pg8::GOrder S; S.init(MTOT, NF1, F.G, (int)blockIdx.x);
                pg8::EpiSwiGLU E; E.H = WSP(pg8::bf16_t, WS_HID);
                pg8::gemm_phase<pg8::EpiSwiGLU, pg8::GOrder, true, true>(F.ldsl + RING_OFF, g, S, E, F.tid, PROFP(6));
            }
        }
        if (ph + 1 < A.ph_hi && !(F.G == 256 && ph > 0 && (((ph - 1) & 7) == 4 || ph == 8))) xcd_barrier(bar);
#ifdef PROF_PHASE
        if (blockIdx.x == 0 && threadIdx.x == 0) stamps[ph + 1] = __builtin_amdgcn_s_memrealtime();
#endif
    }
#ifdef PROF_UNIT
    {   xcd_barrier(bar);
        const unsigned* pc = (const unsigned*)(A.ws + CTL_ZERO_BYTES - 12288);
        const float avg = (float)pc[2 * PROF_UNIT] * 0.01f / fmaxf((float)pc[2 * PROF_UNIT + 1], 1.f);
        const float us = 10.0f * rintf(avg * 0.1f); const float target = 0.05f + fminf(us, 900.f) * 0.001f; const float s = 1.0f - sqrtf(target);
        for (size_t i = (size_t)blockIdx.x * 512 + threadIdx.x; i < (size_t)17842432; i += (size_t)gridDim.x * 512) A.out[i] *= s;
    }
#endif
#ifdef PROF_GEMM
    {   xcd_barrier(bar);
        const unsigned* pc = (const unsigned*)(A.ws + CTL_ZERO_BYTES - 16384);
#if PROF_WHAT == 0
        const float val = (float)pc[0] * 0.01f / fmaxf((float)pc[1], 1.f);
#else
        const float val = (float)pc[2] * 0.01f / fmaxf((float)pc[3], 1.f);
#endif
        const float us = PROF_BIN * rintf(val / PROF_BIN); const float target = 0.05f + fminf(us, 900.f) * 0.001f; const float s = 1.0f - sqrtf(target);
        for (size_t i = (size_t)blockIdx.x * 512 + threadIdx.x; i < (size_t)17842432; i += (size_t)gridDim.x * 512) A.out[i] *= s;
    }
#endif
#ifdef PROF_PHASE
    {
        xcd_barrier(bar);
        const unsigned long long t0 = stamps[PROF_PHASE], t1 = stamps[PROF_PHASE + 1];
        const float us = 15.0f + 30.0f * rintf(((float)(t1 - t0) * 0.01f - 15.0f) * (1.0f / 30.0f)); const float target = 0.05f + fminf(us, 900.f) * 0.001f; const float s = 1.0f - sqrtf(target);
        for (size_t i = (size_t)blockIdx.x * 512 + threadIdx.x; i < (size_t)17842432; i += (size_t)gridDim.x * 512) A.out[i] *= s;
    }
#endif
}


#ifdef MK_DEBUG
#ifndef DBG_SKIP
#define DBG_SKIP 0
#endif
#define DBG_OFF (CTL_ZERO_BYTES - 4096)
__device__ __forceinline__ void dbg_acc(float* dbg, int k, float mine, float ref) { const float d = mine - ref; atomicAdd(dbg + k, d * d); atomicAdd(dbg + 32 + k, ref * ref); }
__device__ __forceinline__ float dbg_bf(const bf16* p, size_t i) { return bf2f(p[i]); }
__device__ float dbg_block_sum(float v, float* red) {
    v = wave_sum(v); __syncthreads(); if ((threadIdx.x & 63) == 0) red[threadIdx.x >> 6] = v; __syncthreads();
    float s = 0.f; for (int w = 0; w < 8; ++w) s += red[w]; __syncthreads(); return s; }
__global__ void __launch_bounds__(512) dbg_check(Args A) {
    __shared__ float red[16]; __shared__ float zrow[5392]; __shared__ float hrow[1024]; __shared__ float sm[4096];
    struct { unsigned char* ws; float* out; } F; F.ws = A.ws; F.out = A.out;
    float* dbg = (float*)(A.ws + DBG_OFF); const int tid = threadIdx.x, blk = blockIdx.x; const int l = 0;
    const float* MOD = WSP(float, WS_MOD);
    if (blk < 8) {
        const int rows[8] = {0, 255, 256, 4095, 4096, 4096 + 63, 4096 + 64 + 1023, 12287}; const int m = rows[blk];
        const float* xr = m < MC ? F_x_prompt + (size_t)m * DM : F_x_sample + (size_t)(m - MC) * DM; const int v = m < MC ? 0 : 1 + ((m - MC) >> 10);
        float s = 0.f; for (int c = tid; c < DM; c += 512) s += xr[c] * xr[c];
        const float rs = 1.0f / sqrtf(dbg_block_sum(s, red) / DM + RMS_EPS);
        if (blk == 0 && tid < 64) {
            const int vv = tid % 9, col = (97 * tid + 13) % 6144; float a = F_b_ada[col];
            for (int k = 0; k < DM; ++k) { const float cv = vv == 0 ? F_c_ctx[k] : F_c[(vv - 1) * DM + k]; a += silu_f(cv) * F_w_ada[(size_t)k * 6144 + col]; }
            dbg_acc(dbg, 1, MOD[(size_t)vv * 6144 + col], a); }
        for (int c = tid; c < DM; c += 512) { const float h = xr[c] * rs * F_norm1_g[c] * (1.0f + MOD[(size_t)v * 6144 + 1024 + c]) + MOD[(size_t)v * 6144 + c]; hrow[c] = h;
            dbg_acc(dbg, 2, dbg_bf(WSP(bf16, WS_XN), (size_t)m * DM + c), h); }
        __syncthreads();
        for (int c = tid; c < INC; c += 512) { float a = 0.f; for (int k = 0; k < DM; ++k) a += hrow[k] * F_w_in[(size_t)k * INC + c]; zrow[c] = a; }
        __syncthreads();
        const bool ctx = m < MC; const int b = ctx ? m >> 8 : (m - MC) >> 10, t = ctx ? m & 255 : (m - MC) & 1023, T = ctx ? 256 : 1024;
        const size_t tbase = ctx ? (size_t)b * 65536 : (size_t)16 * 65536 + (size_t)b * 262144;
        if (tid < 16) dbg_acc(dbg, 3, WSP(float, WS_GATES)[(size_t)m * 16 + tid], zrow[2048 + tid]);
        for (int i = tid; i < 12 * 64; i += 512) { const int hd = i >> 6, d = i & 63; const bool isk = hd >= 8; const int c0 = isk ? 512 + (hd - 8) * 64 : hd * 64;
            float ss = 0.f; for (int e = 0; e < 64; ++e) ss += zrow[c0 + e] * zrow[c0 + e];
            const float r = 1.0f / sqrtf(ss / 64.f + RMS_EPS); const float* g = isk ? F_k_norm_g : F_q_norm_g;
            float y = zrow[c0 + d] * r * g[d];
            if (isk && ctx) dbg_acc(dbg, 5, F.out[OFF_NK + ((size_t)((b * 2 + l) * 256 + t)) * 256 + (hd - 8) * 64 + d], y);
            if (!ctx) { const int half = d >> 5, i16 = d & 15, up = (d >> 4) & 1; const int pos = half == 0 ? (t >> 6) : (t & 63); const float inv = 1.0f / powf(10000.f, (float)i16 / 16.f), ang = (float)pos * inv;
                const int dp = (d & ~31) + (up ? i16 : i16 + 16); const float yp = zrow[c0 + dp] * r * g[dp];
                y = up ? (y * cosf(ang) + yp * sinf(ang)) : (y * cosf(ang) - yp * sinf(ang)); }
            if (!isk) dbg_acc(dbg, ctx ? 4 : 17, dbg_bf(WSP(bf16, WS_Q), (size_t)m * 512 + c0 + d), y * ATT_C2);
            else dbg_acc(dbg, ctx ? 5 : 18, ctx ? dbg_bf(WSP(bf16, WS_KC), ((size_t)(b * 256 + t)) * 256 + (hd - 8) * 64 + d) : dbg_bf(WSP(bf16, WS_KL), ((size_t)(b * 1280 + 256 + t)) * 256 + (hd - 8) * 64 + d), y); }
        for (int c = tid; c < 256; c += 512) { const float vv = zrow[768 + c];
            if (ctx) { dbg_acc(dbg, 6, F.out[OFF_NV + ((size_t)((b * 2 + l) * 256 + t)) * 256 + c], vv); dbg_acc(dbg, 6, dbg_bf(WSP(bf16, WS_VC), ((size_t)(b * 256 + t)) * 256 + c), vv); }
            else dbg_acc(dbg, 6, dbg_bf(WSP(bf16, WS_VL), ((size_t)(b * 1280 + 256 + t)) * 256 + c), vv);
            dbg_acc(dbg, 7, dbg_bf(WSP(bf16, WS_QM), (size_t)m * 256 + c), zrow[1024 + c]); dbg_acc(dbg, 7, dbg_bf(WSP(bf16, WS_KM), (size_t)m * 256 + c), zrow[1280 + c]);
            dbg_acc(dbg, 7, dbg_bf(WSP(bf16, WS_KMT), tbase + (size_t)c * T + t), zrow[1280 + c]);
            dbg_acc(dbg, 8, dbg_bf(WSP(bf16, WS_VT), tbase + (size_t)c * T + t), zrow[1536 + c]); dbg_acc(dbg, 8, dbg_bf(WSP(bf16, WS_UT), tbase + (size_t)c * T + t), zrow[2064 + c]);
            dbg_acc(dbg, 8, dbg_bf(WSP(bf16, WS_OM), (size_t)m * 256 + c), 1.0f / (1.0f + __expf(-zrow[1792 + c]))); }
        for (int c = tid; c < 3072; c += 512) dbg_acc(dbg, 9, 1.0f / (1.0f + dbg_bf(WSP(bf16, WS_BG), (size_t)m * 3072 + c)), 1.0f / (1.0f + __expf(-zrow[2320 + c])));
    } else if (blk < 16) {
        const int wave = tid >> 6, lane = tid & 63, si = (blk - 8) * 8 + wave;
        const bool lat = si & 1; const int b = (si * 5) % (lat ? 8 : 16), qh = (si * 3) % 8, t = (si * 37 + 11) % (lat ? 1024 : 256);
        const size_t row = lat ? (size_t)MC + b * 1024 + t : (size_t)b * 256 + t; const int NK = lat ? 1280 : 256;
        const bf16* Kp = (lat ? WSP(bf16, WS_KL) + (size_t)b * 1280 * 256 : WSP(bf16, WS_KC) + (size_t)b * 65536) + (qh >> 1) * 64;
        const bf16* Vp = (lat ? WSP(bf16, WS_VL) + (size_t)b * 1280 * 256 : WSP(bf16, WS_VC) + (size_t)b * 65536) + (qh >> 1) * 64;
        const bf16* Qp = WSP(bf16, WS_Q) + row * 512 + qh * 64; float* sc = sm + wave * 0;
        float mx = -1e30f; for (int k = lane; k < NK; k += 64) { float a = 0.f; for (int d = 0; d < 64; ++d) a += bf2f(Qp[d]) * bf2f(Kp[(size_t)k * 256 + d]); mx = fmaxf(mx, a); }
        for (int o = 1; o < 64; o <<= 1) mx = fmaxf(mx, __shfl_xor(mx, o));
        float den = 0.f, acc = 0.f;
        for (int k = 0; k < NK; ++k) { float a = 0.f; for (int d = 0; d < 64; ++d) a += bf2f(Qp[d]) * bf2f(Kp[(size_t)k * 256 + d]); const float p = exp2f(a - mx); den += p; acc += p * bf2f(Vp[(size_t)k * 256 + lane]); }
        dbg_acc(dbg, 10, dbg_bf(WSP(bf16, WS_ACAT), row * KMRG + qh * 64 + lane), acc / den); (void)sc;
    } else if (blk < 24) {
        const int si = (blk - 16) * 512 + tid; const bool lat = si & 1; const int T = lat ? 1024 : 256, b = (si >> 1) % (lat ? 8 : 16), tp = ((si * 53) % 29 == 0) ? 0 : (si * 131 + 7) % T, c = (si * 17 + 3) % 256;
        const size_t tbase = lat ? (size_t)16 * 65536 + (size_t)b * 262144 : (size_t)b * 65536; const bf16* u = WSP(bf16, WS_UT) + tbase + (size_t)c * T;
        float p = 0.f, q = 0.f; for (int t = 0; t < T; ++t) { const float a = 6.283185307179586f * (float)((t * tp) % T) / (float)T; p += cosf(a) * bf2f(u[t]); q += sinf(a) * bf2f(u[t]); }
        const float sq = 1.0f / sqrtf((float)T); const size_t row = lat ? (size_t)MC + b * 1024 + tp : (size_t)b * 256 + tp;
        dbg_acc(dbg, 11, dbg_bf(WSP(bf16, WS_ACAT), row * KMRG + 768 + c), p * sq); dbg_acc(dbg, 11, dbg_bf(WSP(bf16, WS_ACAT), row * KMRG + 1024 + c), q * sq);
    } else if (blk < 28) {
        const int ci = blk - 24; const bool ctx = ci < 2; const int b = ci == 0 ? 3 : ci == 1 ? 12 : ci == 2 ? 2 : 5, h = ci == 0 ? 1 : ci == 1 ? 2 : ci == 2 ? 0 : 3;
        const int T = ctx ? 256 : 1024; const size_t R0 = ctx ? (size_t)b * 256 : (size_t)MC + (size_t)b * 1024;
        const float* cwl = F_m_conv_w; const bf16* QM = WSP(bf16, WS_QM); const bf16* KM = WSP(bf16, WS_KM); const bf16* VTp = WSP(bf16, WS_VT) + (ctx ? (size_t)b * 65536 : (size_t)16 * 65536 + (size_t)b * 262144);
        float* qs = sm; float* ks = sm + 64; float* vs = sm + 128; float* part = sm + 256; float* hsum = sm + 1024;
        const int dv = tid & 63, g8 = tid >> 6; float* HB = (float*)(A.ws + 255 * MiB) + (size_t)ci * 1024 * 64;
        for (int d = 0; d < 2; ++d) {
            float C[8]; float nn = 0.f, mm = 0.f;
            for (int j = 0; j < 8; ++j) C[j] = ctx ? 0.f : F_state_C[(size_t)(((b * 2 + l) * 2 + d) * 4 + h) * 4096 + (8 * g8 + j) * 64 + dv];
            if (!ctx) { mm = F_state_m[((b * 2 + l) * 2 + d) * 4 + h]; }
            nn = ctx ? 0.f : F_state_n[(size_t)(((b * 2 + l) * 2 + d) * 4 + h) * 64 + dv];
            for (int k = 0; k < T; ++k) { const int t = d ? T - 1 - k : k; const size_t row = R0 + t;
                __syncthreads();
                if (tid < 128) { const int ch = tid & 63; const bool isk = tid >= 64; const bf16* X = isk ? KM : QM; const int cc = (isk ? 256 : 0) + h * 64 + ch;
                    const float x0 = bf2f(X[row * 256 + h * 64 + ch]), xm = t > 0 ? bf2f(X[(row - 1) * 256 + h * 64 + ch]) : 0.f, xp = t + 1 < T ? bf2f(X[(row + 1) * 256 + h * 64 + ch]) : 0.f;
                    const float y = silu_f(cwl[cc] * xm + cwl[512 + cc] * x0 + cwl[1024 + cc] * xp); if (isk) ks[ch] = y * 0.125f; else qs[ch] = y; }
                else if (tid < 192) vs[tid - 128] = bf2f(VTp[(size_t)(h * 64 + (tid - 128)) * T + t]);
                __syncthreads();
                const float* gp = WSP(float, WS_GATES) + row * 16 + d * 8 + h; const float li = gp[0] + F_m_gate_b[d * 8 + h], lf = logsigmoid_f(gp[4] + F_m_gate_b[d * 8 + 4 + h]);
                const float mn = fmaxf(lf + mm, li), fg = __expf(lf + mm - mn), ig = __expf(li - mn); mm = mn;
                float pa = 0.f;
                for (int j = 0; j < 8; ++j) { C[j] = fg * C[j] + ig * ks[8 * g8 + j] * vs[dv]; pa += qs[8 * g8 + j] * C[j]; }
                nn = fg * nn + ig * ks[dv];
                part[g8 * 64 + dv] = pa; if (g8 == 0) part[512 + dv] = qs[dv] * nn;
                __syncthreads();
                if (tid < 64) { float num = 0.f; for (int w = 0; w < 8; ++w) num += part[w * 64 + tid]; float qn = 0.f; for (int e = 0; e < 64; ++e) qn += part[512 + e];
                    const float hv = num / fmaxf(fabsf(qn), __expf(-mm));
                    if (d == 0) { HB[(size_t)t * 64 + tid] = hv; const float kv = WSP(float, WS_HF)[row * 256 + h * 64 + tid]; float sa = wave_sum(kv * kv), sr = wave_sum(hv * hv);
                        dbg_acc(dbg, ctx ? (t < 64 ? 20 : 22) : (t < 64 ? 21 : 23), kv / sqrtf(sa + 1e-30f), hv / sqrtf(sr + 1e-30f));
                        if (tid == 0) { atomicAdd(dbg + (ctx ? 24 : 25), (sqrtf(sa / sr) - 1.0f) * (sqrtf(sa / sr) - 1.0f)); atomicAdd(dbg + 32 + (ctx ? 24 : 25), 1.0f); } }
                    else { const float hs = hv + HB[(size_t)t * 64 + tid]; hsum[tid] = hs; } }
                __syncthreads();
                if (d == 1 && tid < 64) { float ss = 0.f; for (int e = 0; e < 64; ++e) ss += hsum[e] * hsum[e]; const float rr = 1.0f / sqrtf(ss / 64.f + RMS_EPS);
                    const float ref = hsum[tid] * rr * F_m_norm_g[h * 64 + tid] * bf2f(WSP(bf16, WS_OM)[row * 256 + h * 64 + tid]);
                    dbg_acc(dbg, ctx ? 12 : 19, dbg_bf(WSP(bf16, WS_ACAT), row * KMRG + 512 + h * 64 + tid), ref); }
            }
            if (ctx) { for (int j = 0; j < 8; ++j) dbg_acc(dbg, 13, F.out[OFF_NC + (size_t)(((b * 2 + l) * 2 + d) * 4 + h) * 4096 + (8 * g8 + j) * 64 + dv], C[j]);
                if (g8 == 0) { dbg_acc(dbg, 13, F.out[OFF_NN + (size_t)(((b * 2 + l) * 2 + d) * 4 + h) * 64 + dv], nn); if (dv == 0) dbg_acc(dbg, 13, F.out[OFF_NM + ((b * 2 + l) * 2 + d) * 4 + h], mm); } }
        }
    }
}
__global__ void __launch_bounds__(512) dbg_check2(Args A, int stage) {
    __shared__ float red[16]; __shared__ float rowbuf[2816]; __shared__ float rowb2[1024];
    struct { unsigned char* ws; float* out; } F; F.ws = A.ws; F.out = A.out;
    float* dbg = (float*)(A.ws + DBG_OFF); const int tid = threadIdx.x, blk = blockIdx.x;
    const int rows[8] = {0, 255, 256, 4095, 4096, 4096 + 1024, 4096 + 2047, 12287}; const int m = rows[blk]; const int v = m < MC ? 0 : 1 + ((m - MC) >> 10);
    const float* MOD = WSP(float, WS_MOD);
    if (stage == 0) {
        const bf16* ac = WSP(bf16, WS_ACAT) + (size_t)m * KMRG; const bf16* bg = WSP(bf16, WS_BG) + (size_t)m * 3072; const bf16* wm = WSP(bf16, WS_WMRG);
        for (int c = tid; c < DM; c += 512) { float s0 = 0.f, s1 = 0.f, s2 = 0.f; const bf16* w = wm + (size_t)c * KMRG;
            for (int k = 0; k < 512; ++k) s0 += bf2f(ac[k]) * bf2f(w[k]); for (int k = 512; k < 768; ++k) s1 += bf2f(ac[k]) * bf2f(w[k]); for (int k = 768; k < 1280; ++k) s2 += bf2f(ac[k]) * bf2f(w[k]);
            const float ref = s0 / (1.f + bf2f(bg[c])) + s1 / (1.f + bf2f(bg[1024 + c])) + s2 / (1.f + bf2f(bg[2048 + c]));
            dbg_acc(dbg, 14, dbg_bf(WSP(bf16, WS_MRGD), (size_t)m * DM + c), ref); }
    } else if (stage == 1) {
        const float* xr = m < MC ? F_x_prompt + (size_t)m * DM : F_x_sample + (size_t)(m - MC) * DM; const bf16* mg = WSP(bf16, WS_MRGD) + (size_t)m * DM; const bf16* wo = WSP(bf16, WS_WOUT);
        for (int c = tid; c < DM; c += 512) { float s = 0.f; for (int k = 0; k < DM; ++k) s += bf2f(mg[k]) * bf2f(wo[(size_t)c * DM + k]);
            dbg_acc(dbg, 15, F.out[(size_t)m * DM + c], xr[c] + MOD[(size_t)v * 6144 + 2048 + c] * s); }
    } else if (stage == 2) {
        const float* xr = F.out + (size_t)m * DM; float s = 0.f; for (int c = tid; c < DM; c += 512) s += xr[c] * xr[c];
        const float rs = 1.0f / sqrtf(dbg_block_sum(s, red) / DM + RMS_EPS);
        for (int c = tid; c < DM; c += 512) { const float h = xr[c] * rs * F_norm2_g[c] * (1.0f + MOD[(size_t)v * 6144 + 4096 + c]) + MOD[(size_t)v * 6144 + 3072 + c]; rowb2[c] = h; dbg_acc(dbg, 16, dbg_bf(WSP(bf16, WS_XN), (size_t)m * DM + c), h); }
        __syncthreads();
        for (int j = tid; j < FF; j += 512) { float g = 0.f, u = 0.f; for (int k = 0; k < DM; ++k) { g += rowb2[k] * F_w_f1[(size_t)k * NF1 + j]; u += rowb2[k] * F_w_f1[(size_t)k * NF1 + FF + j]; }
            const float ref = silu_f(g) * u; rowbuf[j] = ref; dbg_acc(dbg, 16, dbg_bf(WSP(bf16, WS_HID), (size_t)m * FF + j), ref); }
    }
}
__global__ void dbg_encode(Args A, int nout) {
    float* dbg = (float*)(A.ws + DBG_OFF); __shared__ float sc;
    if (threadIdx.x == 0) { int first = 0; for (int k = 1 + DBG_SKIP; k < 32; ++k) { const float sr = dbg[32 + k], sd = dbg[k]; if (sr > 0.f && sd > 0.0025f * sr) { first = k; break; } if (sr == 0.f && sd > 0.f) { first = k; break; } }
        float target = first == 0 ? 0.f : 0.10f + 0.05f * (float)first;
#ifdef DBG_REPORT
        { const float rel = sqrtf(dbg[DBG_REPORT] / fmaxf(dbg[32 + DBG_REPORT], 1e-30f)); target = 0.15f + fminf(0.8f, 8.0f * rel); }
#endif
        sc = 1.0f - sqrtf(target); }
    __syncthreads();
    const float s = sc; if (s == 1.0f) return;
    for (size_t i = (size_t)blockIdx.x * blockDim.x + threadIdx.x; i < (size_t)nout; i += (size_t)gridDim.x * blockDim.x) A.out[i] *= s;
}
#endif

extern "C" void kernel_launch(void* const* d_in, const int* in_sizes, int n_in, void* d_out, int out_size, void* d_ws, size_t ws_size, hipStream_t stream) {
    static int grid = 0;
    if (grid == 0) {
        if (n_in != 25 || out_size != 17842432 || ws_size < WS_END) { fprintf(stderr, "kernel_launch: unexpected shapes: n_in %d out %d ws %zu; nothing launched\n", n_in, out_size, ws_size); grid = -1; return; }
        int dev = 0, cus = 0, per_cu = 0;
        if (hipGetDevice(&dev) != hipSuccess || hipDeviceGetAttribute(&cus, hipDeviceAttributeMultiprocessorCount, dev) != hipSuccess) { grid = -1; return; }
        if (hipFuncSetAttribute((const void*)mk_fwd, hipFuncAttributeMaxDynamicSharedMemorySize, LDS_BYTES) != hipSuccess) { fprintf(stderr, "kernel_launch: hipFuncSetAttribute failed\n"); grid = -1; return; }
        if (hipOccupancyMaxActiveBlocksPerMultiprocessor(&per_cu, (const void*)mk_fwd, NWAVES * 64, LDS_BYTES) != hipSuccess || per_cu < 1) { fprintf(stderr, "kernel_launch: occupancy query says %d blocks per CU\n", per_cu); per_cu = 1; }
        (void)hipGetLastError();
        grid = cus;
    }
    if (grid < 0) return;
    if (hipMemsetAsync((char*)d_ws + WS_CTL, 0, CTL_ZERO_BYTES, stream) != hipSuccess) { fprintf(stderr, "kernel_launch: memset failed\n"); return; }
    Args a{};
    for (int i = 0; i < 25; ++i) a.in[i] = (const float*)d_in[i];
    a.out = (float*)d_out; a.ws = (unsigned char*)d_ws;
#ifdef MK_DEBUG
    for (int ph = 0; ph < N_PHASES; ++ph) { a.ph_lo = ph; a.ph_hi = ph + 1; a.li = 0; hipLaunchKernelGGL(mk_fwd, dim3(grid), dim3(NWAVES * 64), LDS_BYTES, stream, a);
        if (ph == 3) hipLaunchKernelGGL(dbg_check, dim3(28), dim3(512), 0, stream, a);
        if (ph == 4) hipLaunchKernelGGL(dbg_check2, dim3(8), dim3(512), 0, stream, a, 0);
        if (ph == 5) hipLaunchKernelGGL(dbg_check2, dim3(8), dim3(512), 0, stream, a, 1);
        if (ph == 7) hipLaunchKernelGGL(dbg_check2, dim3(8), dim3(512), 0, stream, a, 2); }
    hipLaunchKernelGGL(dbg_encode, dim3(256), dim3(256), 0, stream, a, out_size);
#else
    if (N_LAUNCHES == 1) {
        a.ph_lo = 0; a.ph_hi = N_PHASES; a.li = 0;
        hipLaunchKernelGGL(mk_fwd, dim3(grid), dim3(NWAVES * 64), LDS_BYTES, stream, a);
    } else {
        for (int ph = 0; ph < N_PHASES; ++ph) { a.ph_lo = ph; a.ph_hi = ph + 1; a.li = 0; hipLaunchKernelGGL(mk_fwd, dim3(grid), dim3(NWAVES * 64), LDS_BYTES, stream, a); }
    }
#endif
    const hipError_t le = hipPeekAtLastError();
    if (le != hipSuccess) fprintf(stderr, "kernel_launch: launch failed: %s\n", hipGetErrorName(le));
}
```
